# Optimizing an MI355X kernel written in HIP

```python
import math
import jax, jax.numpy as jnp
from jax import lax
import numpy as np

D_MODEL = 2048
BATCH = 1
SEQ = 8192
DEPTH = 2

N_MIXERS = 2
N_ATTN = (DEPTH + 1) // 2
N_HGRN = DEPTH // 2

ATTN_HEAD_DIM = 64
ATTN_HEADS = D_MODEL // ATTN_HEAD_DIM
ATTN_KV_HEADS = ATTN_HEADS // 8
ATTN_GROUP = ATTN_HEADS // ATTN_KV_HEADS
WINDOW = 128
BLOCK = 128
ATTN_Q_DIM = ATTN_HEADS * ATTN_HEAD_DIM
ATTN_KV_DIM = ATTN_KV_HEADS * ATTN_HEAD_DIM
ATTN_IN_DIM = ATTN_Q_DIM + 2 * ATTN_KV_DIM
ATTN_SCALE = 1.0 / math.sqrt(ATTN_HEAD_DIM)

HGRN_EXPAND = 128
HGRN_HEADS = D_MODEL // HGRN_EXPAND
HGRN_DK = HGRN_EXPAND
HGRN_DV = D_MODEL // HGRN_HEADS
HGRN_FDIM = HGRN_HEADS * HGRN_DK
HGRN_IDIM = HGRN_HEADS * HGRN_DV
HGRN_IN_DIM = 2 * HGRN_FDIM + 2 * HGRN_IDIM
HGRN_SCALE = 1.0 / math.sqrt(HGRN_DK)
CHUNK = 64

D_FF = 4 * D_MODEL
N_MOD = 6
EPS = 1e-6

kernel_name = "hybrid_swa_hgrn2_block"


def rms_norm(x, gain):
    xf = x.astype(jnp.float32)
    y = xf * lax.rsqrt(jnp.mean(xf * xf, axis=-1, keepdims=True) + EPS)
    return (y * gain.astype(jnp.float32)).astype(x.dtype)


def modulate(h, shift, scale):
    return h * (1.0 + scale[:, None, :]) + shift[:, None, :]


def alibi_slopes(n_heads):
    return jnp.exp2(-8.0 * jnp.arange(1, n_heads + 1, dtype=jnp.float32) / n_heads)


def swa_sink_attention(h, w_in, w_out, q_gain, k_gain, sinks):
    B, T, _ = h.shape
    nb = T // BLOCK
    proj = h @ w_in
    q, k, v = jnp.split(proj, [ATTN_Q_DIM, ATTN_Q_DIM + ATTN_KV_DIM], axis=-1)
    q = rms_norm(q.reshape(B, T, ATTN_HEADS, ATTN_HEAD_DIM), q_gain)
    k = rms_norm(k.reshape(B, T, ATTN_KV_HEADS, ATTN_HEAD_DIM), k_gain)
    v = v.reshape(B, T, ATTN_KV_HEADS, ATTN_HEAD_DIM)
    q = q.reshape(B, nb, BLOCK, ATTN_KV_HEADS, ATTN_GROUP, ATTN_HEAD_DIM)

    def band(a):
        ap = jnp.pad(a, ((0, 0), (BLOCK, 0), (0, 0), (0, 0)))
        ap = ap.reshape(B, nb + 1, BLOCK, ATTN_KV_HEADS, ATTN_HEAD_DIM)
        return jnp.concatenate([ap[:, :-1], ap[:, 1:]], axis=2)

    kb, vb = band(k), band(v)
    logits = jnp.einsum('bnqkgd,bnskd->bnkgqs', q, kb,
                        preferred_element_type=jnp.float32) * ATTN_SCALE

    kpos = jnp.arange(2 * BLOCK)
    dist = (jnp.arange(BLOCK) + BLOCK)[:, None] - kpos[None, :]
    in_band = (dist >= 0) & (dist < WINDOW)
    s_abs = (jnp.arange(nb) * BLOCK - BLOCK)[:, None, None] + kpos[None, None, :]
    valid = in_band[None] & (s_abs >= 0)
    slopes = alibi_slopes(ATTN_HEADS).reshape(ATTN_KV_HEADS, ATTN_GROUP)
    alibi = -slopes[:, :, None, None] * jnp.abs(dist).astype(jnp.float32)
    logits = jnp.where(valid[None, :, None, None], logits + alibi, -jnp.inf)

    sink = jnp.broadcast_to(
        sinks.astype(jnp.float32).reshape(1, 1, ATTN_KV_HEADS, ATTN_GROUP, 1, 1),
        logits.shape[:-1] + (1,))
    probs = jax.nn.softmax(jnp.concatenate([logits, sink], axis=-1), axis=-1)[..., :-1]
    out = jnp.einsum('bnkgqs,bnskd->bnqkgd', probs.astype(vb.dtype), vb)
    return out.reshape(B, T, ATTN_Q_DIM) @ w_out


def hgrn2_mixer(h, w_in, w_out, o_gain, lower_bound):
    B, T, _ = h.shape
    nc = T // CHUNK
    proj = (h @ w_in).astype(jnp.float32)
    q, f, v, g = jnp.split(proj, [HGRN_FDIM, 2 * HGRN_FDIM, 2 * HGRN_FDIM + HGRN_IDIM], axis=-1)
    q = jax.nn.silu(q) * HGRN_SCALE
    forget = lower_bound + (1.0 - lower_bound) * jax.nn.sigmoid(f)
    k = 1.0 - forget
    logf = jnp.log(forget)

    def to_chunks(a, d):
        return a.reshape(B, nc, CHUNK, HGRN_HEADS, d)

    q, k, logf = to_chunks(q, HGRN_DK), to_chunks(k, HGRN_DK), to_chunks(logf, HGRN_DK)
    v = to_chunks(v, HGRN_DV)
    b = jnp.cumsum(logf, axis=2)
    piv = b[:, :, CHUNK // 2 - 1:CHUNK // 2]

    causal = jnp.tril(jnp.ones((CHUNK, CHUNK), dtype=bool))
    a = jnp.einsum('bnchd,bnshd->bnhcs', q * jnp.exp(b - piv), k * jnp.exp(piv - b))
    a = jnp.where(causal, a, 0.0)
    o_intra = jnp.einsum('bnhcs,bnshv->bnchv', a, v)

    b_last = b[:, :, -1]
    upd = jnp.einsum('bnshd,bnshv->nbhdv', k * jnp.exp(b_last[:, :, None] - b), v)
    decay = jnp.exp(b_last).transpose(1, 0, 2, 3)

    def step(state, inp):
        dec, u = inp
        return dec[..., None] * state + u, state

    s0 = jnp.zeros((B, HGRN_HEADS, HGRN_DK, HGRN_DV), jnp.float32)
    _, s_before = lax.scan(step, s0, (decay, upd))
    o_inter = jnp.einsum('bnchd,nbhdv->bnchv', q * jnp.exp(b), s_before)

    o = (o_intra + o_inter).reshape(B, T, HGRN_HEADS, HGRN_DV)
    o = rms_norm(o, o_gain) * jax.nn.silu(g).reshape(B, T, HGRN_HEADS, HGRN_DV)
    return o.reshape(B, T, HGRN_IDIM).astype(h.dtype) @ w_out


def squared_relu_mlp(h, w1, w2):
    a = jax.nn.relu(h @ w1)
    return (a * a) @ w2


def setup_inputs(seed: int = 0) -> dict:
    key = jax.random.key(seed)
    ks = jax.random.split(key, 17)
    nrm = jax.random.normal
    f32 = jnp.float32
    x = nrm(ks[0], (BATCH, SEQ, D_MODEL), f32)
    c = nrm(ks[1], (BATCH, D_MODEL), f32)
    mod_w = nrm(ks[2], (DEPTH, D_MODEL, N_MOD * D_MODEL), f32) * (0.5 * D_MODEL ** -0.5)
    mod_b = nrm(ks[3], (DEPTH, N_MOD * D_MODEL), f32) * 0.02
    norm_mix = 1.0 + 0.05 * nrm(ks[4], (DEPTH, D_MODEL), f32)
    norm_mlp = 1.0 + 0.05 * nrm(ks[5], (DEPTH, D_MODEL), f32)
    attn_w_in = nrm(ks[6], (N_ATTN, D_MODEL, ATTN_IN_DIM), f32) * D_MODEL ** -0.5
    attn_w_out = nrm(ks[7], (N_ATTN, ATTN_Q_DIM, D_MODEL), f32) * ATTN_Q_DIM ** -0.5
    attn_q_gain = 1.0 + 0.05 * nrm(ks[8], (N_ATTN, ATTN_HEAD_DIM), f32)
    attn_k_gain = 1.0 + 0.05 * nrm(ks[9], (N_ATTN, ATTN_HEAD_DIM), f32)
    attn_sinks = nrm(ks[10], (N_ATTN, ATTN_HEADS), f32)
    hgrn_w_in = nrm(ks[11], (N_HGRN, D_MODEL, HGRN_IN_DIM), f32) * D_MODEL ** -0.5
    hgrn_w_out = nrm(ks[12], (N_HGRN, HGRN_IDIM, D_MODEL), f32) * HGRN_IDIM ** -0.5
    hgrn_o_gain = 1.0 + 0.05 * nrm(ks[13], (N_HGRN, HGRN_HEADS, HGRN_DV), f32)
    hgrn_lb_logits = 0.5 * nrm(ks[14], (DEPTH, HGRN_FDIM), f32)
    mlp_w1 = nrm(ks[15], (DEPTH, D_MODEL, D_FF), f32) * D_MODEL ** -0.5
    mlp_w2 = nrm(ks[16], (DEPTH, D_FF, D_MODEL), f32) * D_FF ** -0.5
    return {"x": x, "c": c, "mod_w": mod_w, "mod_b": mod_b,
            "norm_mix": norm_mix, "norm_mlp": norm_mlp,
            "attn_w_in": attn_w_in, "attn_w_out": attn_w_out,
            "attn_q_gain": attn_q_gain, "attn_k_gain": attn_k_gain, "attn_sinks": attn_sinks,
            "hgrn_w_in": hgrn_w_in, "hgrn_w_out": hgrn_w_out, "hgrn_o_gain": hgrn_o_gain,
            "hgrn_lb_logits": hgrn_lb_logits, "mlp_w1": mlp_w1, "mlp_w2": mlp_w2}


def reference(x, c, mod_w, mod_b, norm_mix, norm_mlp, attn_w_in, attn_w_out,
              attn_q_gain, attn_k_gain, attn_sinks, hgrn_w_in, hgrn_w_out, hgrn_o_gain,
              hgrn_lb_logits, mlp_w1, mlp_w2):
    lb_p = jax.nn.softmax(hgrn_lb_logits.astype(jnp.float32), axis=0)
    lower_bounds = jnp.cumsum(lb_p, axis=0) - lb_p[0]
    cond = jax.nn.silu(c)
    for i in range(DEPTH):
        mod = cond @ mod_w[i] + mod_b[i]
        sh1, sc1, g1, sh2, sc2, g2 = jnp.split(mod, N_MOD, axis=-1)
        h = modulate(rms_norm(x, norm_mix[i]), sh1, sc1)
        j = i // N_MIXERS
        if i % N_MIXERS == 0:
            y = swa_sink_attention(h, attn_w_in[j], attn_w_out[j], attn_q_gain[j],
                                   attn_k_gain[j], attn_sinks[j])
        else:
            y = hgrn2_mixer(h, hgrn_w_in[j], hgrn_w_out[j], hgrn_o_gain[j], lower_bounds[i])
        x = x + g1[:, None, :] * y
        h = modulate(rms_norm(x, norm_mlp[i]), sh2, sc2)
        x = x + g2[:, None, :] * squared_relu_mlp(h, mlp_w1[i], mlp_w2[i])
    return x
```

```cpp
#include <hip/hip_runtime.h>
#include <hip/hip_cooperative_groups.h>
#include <cstdio>
#include <cstdint>
#include <cmath>
namespace pg8 {
#define PG8_LAS __attribute__((address_space(3)))
typedef unsigned short bf16_t;
typedef short bf16x8 __attribute__((ext_vector_type(8)));
typedef float f32x4 __attribute__((ext_vector_type(4)));
typedef unsigned u32x4 __attribute__((ext_vector_type(4)));
constexpr int BM = 256, BK = 64, HALF = 128, HTB = HALF * BK * 2  , STAGE_BYTES = 8 * HTB, NXCD = 8, WGM = 8;

__host__ __device__ __forceinline__ int lds_byte(int r, int c) { const int st = (r >> 4) * 2 + (c >> 5), rr = r & 15, cc = c & 31, ob = rr * 64 + cc * 2; return st * 1024 + (ob ^ (((ob >> 9) & 1) << 5)); }
__host__ __device__ __forceinline__ void stage_rc(int b, int& R, int& C) { const int st = b / 1024, sb = b % 1024, swz = sb ^ (((sb >> 9) & 1) << 5); R = (st >> 1) * 16 + swz / 64; C = (st & 1) * 32 + (swz % 64) / 2; }
__host__ __device__ __forceinline__ int perm32(int rho) { const int n = rho >> 4, i = rho & 15; return 8 * (i >> 2) + 4 * n + (i & 3); }

struct Unit { int pm, pn; };
struct Gemm { const bf16_t* A; const bf16_t* Bt; int M, N, K; };

struct StaticOrder {
    int nM, nN, nwg, G, c;
    __host__ __device__ void init(int M, int N, int G_, int c_) { nM = M / BM; nN = N / BM; nwg = nM * nN; G = G_; c = c_; }
    __host__ __device__ bool next(int i, Unit& u) const {
        const long L = (long)i * G + c; if (L >= nwg) return false;
        int wgid = (int)L; { const int q = nwg / NXCD, r = nwg % NXCD, xcd = wgid % NXCD, off = wgid / NXCD; wgid = (xcd < r ? xcd * (q + 1) : r * (q + 1) + (xcd - r) * q) + off; }
        const int nig = WGM * nN, gid = wgid / nig, fm = gid * WGM, gsz = (nM - fm) < WGM ? (nM - fm) : WGM;
        u.pm = fm + ((wgid % nig) % gsz); u.pn = (wgid % nig) / gsz; return true;
    }
    __device__ __forceinline__ void a_ready(const Unit&) const {}
    __device__ __forceinline__ void done(const Unit&) const {}
};

typedef __bf16 bf16x2_t __attribute__((ext_vector_type(2)));
typedef float f32x2 __attribute__((ext_vector_type(2)));
__device__ __forceinline__ unsigned cvt_pk_bf16(float lo, float hi) { const f32x2 v = {lo, hi}; const bf16x2_t b = __builtin_convertvector(v, bf16x2_t); return __builtin_bit_cast(unsigned, b); }
__device__ __forceinline__ int opaque_tid() { int t = threadIdx.x; asm volatile("" : "+v"(t)); return t; }
typedef unsigned u32x2 __attribute__((ext_vector_type(2)));
__device__ __forceinline__ float fast_rcp(float x) { return __builtin_amdgcn_rcpf(x); }
__device__ __forceinline__ float silu_f(float x) { return x * fast_rcp(1.0f + __expf(-x)); }
template <int ACT> struct EpiStore {
    static constexpr bool PERM = true, AFTER_DRAIN = false;
    bf16_t* O; int ldc;
    __device__ __forceinline__ void operator()(const f32x4 (&acc)[2][2][4][2], const Unit& u, int wr, int wc, int fr, int fq) const {
        const int row0 = u.pm * BM + wr * 64 + fr, col0 = u.pn * BM + wc * 32 + 8 * fq;
#pragma unroll
        for (int ai = 0; ai < 2; ++ai)
#pragma unroll
            for (int m = 0; m < 4; ++m) { bf16_t* rowp = O + (size_t)(row0 + ai * HALF + m * 16) * ldc + col0;
#pragma unroll
                for (int bj = 0; bj < 2; ++bj) { f32x4 v0 = acc[ai][bj][m][0], v1 = acc[ai][bj][m][1];
                    if (ACT == 2) {
#pragma unroll
                        for (int e = 0; e < 4; ++e) { const float a = fmaxf(v0[e], 0.f), b = fmaxf(v1[e], 0.f); v0[e] = a * a; v1[e] = b * b; } }
                    u32x4 w; w.x = cvt_pk_bf16(v0[0], v0[1]); w.y = cvt_pk_bf16(v0[2], v0[3]); w.z = cvt_pk_bf16(v1[0], v1[1]); w.w = cvt_pk_bf16(v1[2], v1[3]);
                    *(u32x4*)(rowp + bj * HALF) = w; } }
    }
};
struct EpiResid {
    static constexpr bool PERM = false, AFTER_DRAIN = false;
    const float* base; float* out; const float* gate; int ldc;
    __device__ __forceinline__ void operator()(const f32x4 (&acc)[2][2][4][2], const Unit& u, int wr, int wc, int fr, int fq) const {
        const int col0 = u.pn * BM + wc * 32 + 4 * fq;
        f32x4 gv[2][2];
#pragma unroll
        for (int bj = 0; bj < 2; ++bj)
#pragma unroll
            for (int n = 0; n < 2; ++n) gv[bj][n] = *(const f32x4*)(gate + col0 + bj * HALF + n * 16);
#pragma unroll
        for (int ai = 0; ai < 2; ++ai)
#pragma unroll
            for (int m = 0; m < 4; ++m) { const size_t off = (size_t)(u.pm * BM + ai * HALF + wr * 64 + m * 16 + fr) * ldc + col0;
#pragma unroll
                for (int bj = 0; bj < 2; ++bj)
#pragma unroll
                    for (int n = 0; n < 2; ++n) { const f32x4 b = *(const f32x4*)(base + off + bj * HALF + n * 16);
                        *(f32x4*)(out + off + bj * HALF + n * 16) = b + gv[bj][n] * acc[ai][bj][m][n]; } }
    }
};
struct EpiHgrn {
    static constexpr bool PERM = true, AFTER_DRAIN = false;
    bf16_t* Qh; bf16_t* LOGF; bf16_t* Vh; bf16_t* Gh; const float* lb; float qscale; const float* bias; const PG8_LAS float* rs; mutable int slot;
    __device__ __forceinline__ void operator()(const f32x4 (&acc)[2][2][4][2], const Unit& u, int wr, int wc, int fr, int fq) const {
        const int type = u.pn >> 3;
        const int row0 = u.pm * BM + wr * 64 + fr, col0 = (u.pn & 7) * BM + wc * 32 + 8 * fq, bcol0 = u.pn * BM + wc * 32 + 8 * fq;
        const PG8_LAS float* rsu = rs + slot * 256 + wr * 64 + fr; ++slot;
        f32x4 bv[2][2];
#pragma unroll
        for (int bj = 0; bj < 2; ++bj) { bv[bj][0] = *(const f32x4*)(bias + bcol0 + bj * HALF); bv[bj][1] = *(const f32x4*)(bias + bcol0 + bj * HALF + 4); }
#pragma unroll
        for (int ai = 0; ai < 2; ++ai)
#pragma unroll
            for (int m = 0; m < 4; ++m) { const size_t roff = (size_t)(row0 + ai * HALF + m * 16) * 2048 + col0; const float rstd = rsu[ai * HALF + m * 16];
#pragma unroll
                for (int bj = 0; bj < 2; ++bj) {
                    f32x4 v0 = acc[ai][bj][m][0] * rstd + bv[bj][0], v1 = acc[ai][bj][m][1] * rstd + bv[bj][1];
                    if (type == 1) {
                        const f32x4 l0 = *(const f32x4*)(lb + col0 + bj * HALF), l1 = *(const f32x4*)(lb + col0 + bj * HALF + 4);
#pragma unroll
                        for (int e = 0; e < 4; ++e) {
                            const float s0 = fast_rcp(1.0f + __expf(-v0[e])), s1 = fast_rcp(1.0f + __expf(-v1[e]));
                            v0[e] = __logf(l0[e] + (1.0f - l0[e]) * s0); v1[e] = __logf(l1[e] + (1.0f - l1[e]) * s1); }
                        u32x4 w; w.x = cvt_pk_bf16(v0[0], v0[1]); w.y = cvt_pk_bf16(v0[2], v0[3]); w.z = cvt_pk_bf16(v1[0], v1[1]); w.w = cvt_pk_bf16(v1[2], v1[3]);
                        *(u32x4*)(LOGF + roff + bj * HALF) = w;
                    } else {
                        if (type == 0) {
#pragma unroll
                            for (int e = 0; e < 4; ++e) { v0[e] = silu_f(v0[e]) * qscale; v1[e] = silu_f(v1[e]) * qscale; }
                        } else if (type == 3) {
#pragma unroll
                            for (int e = 0; e < 4; ++e) { v0[e] = silu_f(v0[e]); v1[e] = silu_f(v1[e]); }
                        }
                        u32x4 w; w.x = cvt_pk_bf16(v0[0], v0[1]); w.y = cvt_pk_bf16(v0[2], v0[3]); w.z = cvt_pk_bf16(v1[0], v1[1]); w.w = cvt_pk_bf16(v1[2], v1[3]);
                        if (type == 0) *(u32x4*)(Qh + roff + bj * HALF) = w;
                        else if (type == 2) *(u32x4*)(Vh + roff + bj * HALF) = w;
                        else *(u32x4*)(Gh + roff + bj * HALF) = w;
                    } } }
    }
};

template <bool BASE_BF16> struct EpiResidN {
    static constexpr bool PERM = true, AFTER_DRAIN = false;
    const void* base; bf16_t* out; const float* gate; int ldc; const float* ngain; const float* nscale; bf16_t* An; float* part;
    __device__ __forceinline__ void operator()(const f32x4 (&acc)[2][2][4][2], const Unit& u, int wr, int wc, int fr, int fq) const {
        const int col0 = u.pn * BM + wc * 32 + 8 * fq;
        f32x4 gv[2][2], wv[2][2];
#pragma unroll
        for (int bj = 0; bj < 2; ++bj)
#pragma unroll
            for (int n = 0; n < 2; ++n) { gv[bj][n] = *(const f32x4*)(gate + col0 + bj * HALF + n * 4);
                const f32x4 g = *(const f32x4*)(ngain + col0 + bj * HALF + n * 4), s = *(const f32x4*)(nscale + col0 + bj * HALF + n * 4); wv[bj][n] = g * (s + 1.0f); }
#pragma unroll
        for (int ai = 0; ai < 2; ++ai)
#pragma unroll
            for (int m = 0; m < 4; ++m) { const int row = u.pm * BM + ai * HALF + wr * 64 + m * 16 + fr; const size_t off = (size_t)row * ldc + col0; float ss = 0.f;
#pragma unroll
                for (int bj = 0; bj < 2; ++bj) { f32x4 b0, b1;
                    if (BASE_BF16) { const u32x4 bb = *(const u32x4*)((const bf16_t*)base + off + bj * HALF);
                        b0 = (f32x4){__uint_as_float(bb.x << 16), __uint_as_float(bb.x & 0xffff0000u), __uint_as_float(bb.y << 16), __uint_as_float(bb.y & 0xffff0000u)};
                        b1 = (f32x4){__uint_as_float(bb.z << 16), __uint_as_float(bb.z & 0xffff0000u), __uint_as_float(bb.w << 16), __uint_as_float(bb.w & 0xffff0000u)}; }
                    else { b0 = *(const f32x4*)((const float*)base + off + bj * HALF); b1 = *(const f32x4*)((const float*)base + off + bj * HALF + 4); }
                    const f32x4 o0 = b0 + gv[bj][0] * acc[ai][bj][m][0], o1 = b1 + gv[bj][1] * acc[ai][bj][m][1];
                    u32x4 ob; ob.x = cvt_pk_bf16(o0[0], o0[1]); ob.y = cvt_pk_bf16(o0[2], o0[3]); ob.z = cvt_pk_bf16(o1[0], o1[1]); ob.w = cvt_pk_bf16(o1[2], o1[3]);
                    *(u32x4*)(out + off + bj * HALF) = ob;
                    ss += ((o0[0] * o0[0] + o0[1] * o0[1]) + (o0[2] * o0[2] + o0[3] * o0[3])) + ((o1[0] * o1[0] + o1[1] * o1[1]) + (o1[2] * o1[2] + o1[3] * o1[3]));
                    const f32x4 y0 = o0 * wv[bj][0], y1 = o1 * wv[bj][1];
                    u32x4 w; w.x = cvt_pk_bf16(y0[0], y0[1]); w.y = cvt_pk_bf16(y0[2], y0[3]); w.z = cvt_pk_bf16(y1[0], y1[1]); w.w = cvt_pk_bf16(y1[2], y1[3]);
                    *(u32x4*)(An + off + bj * HALF) = w; }
                ss += __shfl_xor(ss, 16); ss += __shfl_xor(ss, 32);
                if (fq == 0) part[(size_t)row * 32 + u.pn * 4 + wc] = ss; }
    }
};
struct EpiResidF {
    static constexpr bool PERM = true, AFTER_DRAIN = false;
    const bf16_t* base; float* out; const float* gate; int ldc;
    __device__ __forceinline__ void operator()(const f32x4 (&acc)[2][2][4][2], const Unit& u, int wr, int wc, int fr, int fq) const {
        const int col0 = u.pn * BM + wc * 32 + 8 * fq;
        f32x4 gv[2][2];
#pragma unroll
        for (int bj = 0; bj < 2; ++bj)
#pragma unroll
            for (int n = 0; n < 2; ++n) gv[bj][n] = *(const f32x4*)(gate + col0 + bj * HALF + n * 4);
#pragma unroll
        for (int ai = 0; ai < 2; ++ai)
#pragma unroll
            for (int m = 0; m < 4; ++m) { const size_t off = (size_t)(u.pm * BM + ai * HALF + wr * 64 + m * 16 + fr) * ldc + col0;
#pragma unroll
                for (int bj = 0; bj < 2; ++bj) { const u32x4 bb = *(const u32x4*)(base + off + bj * HALF);
                    const f32x4 b0 = {__uint_as_float(bb.x << 16), __uint_as_float(bb.x & 0xffff0000u), __uint_as_float(bb.y << 16), __uint_as_float(bb.y & 0xffff0000u)};
                    const f32x4 b1 = {__uint_as_float(bb.z << 16), __uint_as_float(bb.z & 0xffff0000u), __uint_as_float(bb.w << 16), __uint_as_float(bb.w & 0xffff0000u)};
                    *(f32x4*)(out + off + bj * HALF) = b0 + gv[bj][0] * acc[ai][bj][m][0]; *(f32x4*)(out + off + bj * HALF + 4) = b1 + gv[bj][1] * acc[ai][bj][m][1]; } }
    }
};
template <int ACT> struct EpiStoreN {
    static constexpr bool PERM = true, AFTER_DRAIN = false;
    bf16_t* O; int ldc; const float* bias; const PG8_LAS float* rs; mutable int slot;
    __device__ __forceinline__ void operator()(const f32x4 (&acc)[2][2][4][2], const Unit& u, int wr, int wc, int fr, int fq) const {
        const int row0 = u.pm * BM + wr * 64 + fr, col0 = u.pn * BM + wc * 32 + 8 * fq;
        const PG8_LAS float* rsu = rs + slot * 256 + wr * 64 + fr; ++slot;
        f32x4 bv[2][2];
#pragma unroll
        for (int bj = 0; bj < 2; ++bj) { bv[bj][0] = *(const f32x4*)(bias + col0 + bj * HALF); bv[bj][1] = *(const f32x4*)(bias + col0 + bj * HALF + 4); }
#pragma unroll
        for (int ai = 0; ai < 2; ++ai)
#pragma unroll
            for (int m = 0; m < 4; ++m) { bf16_t* rowp = O + (size_t)(row0 + ai * HALF + m * 16) * ldc + col0; const float rstd = rsu[ai * HALF + m * 16];
#pragma unroll
                for (int bj = 0; bj < 2; ++bj) {
                    f32x4 v0 = acc[ai][bj][m][0] * rstd + bv[bj][0], v1 = acc[ai][bj][m][1] * rstd + bv[bj][1];
                    if (ACT == 2) {
#pragma unroll
                        for (int e = 0; e < 4; ++e) { const float a = fmaxf(v0[e], 0.f), b = fmaxf(v1[e], 0.f); v0[e] = a * a; v1[e] = b * b; } }
                    u32x4 w; w.x = cvt_pk_bf16(v0[0], v0[1]); w.y = cvt_pk_bf16(v0[2], v0[3]); w.z = cvt_pk_bf16(v1[0], v1[1]); w.w = cvt_pk_bf16(v1[2], v1[3]);
                    *(u32x4*)(rowp + bj * HALF) = w; } }
    }
};
template <class Epi, class Sched, bool ALIGN_EPI = false, bool SP2 = false>
__device__ __forceinline__ void gemm_phase(PG8_LAS unsigned char* lds, const Gemm g, const Sched& S, const Epi& E) {
    const int tid = opaque_tid(), wid = __builtin_amdgcn_readfirstlane(tid >> 6), lane = tid & 63, wr = wid >> 2, wc = wid & 3, fr = lane & 15, fq = lane >> 4;
    const int K = g.K, nt = K / BK;
    unsigned voffA[2], voffB[2];
#pragma unroll
    for (int i = 0; i < 2; ++i) { int R, C; stage_rc(tid * 16 + i * 8192, R, C); const int Rb = Epi::PERM ? ((R & ~31) + perm32(R & 31)) : R;
        voffA[i] = (unsigned)(R * K + C) * 2u; voffB[i] = (unsigned)(Rb * K + C) * 2u; }
    const size_t kstep = (size_t)(BK * 2);
    const size_t hstep = (size_t)HALF * K * 2;
    const size_t tstep = 2 * hstep;
    const unsigned ldsw = (unsigned)wid * 1024u;
    const int aoff = lds_byte(wr * 64 + fr, fq * 8), boff = lds_byte(wc * 32 + fr, fq * 8);
#define PG8_SA(b, h) (((b) * 2 + (h)) * HTB)
#define PG8_SB(b, h) ((4 + (b) * 2 + (h)) * HTB)
#define PG8_STAGE(bufoff, gbase, voff) do { _Pragma("unroll") for (int _i = 0; _i < 2; ++_i) \
        __builtin_amdgcn_global_load_lds((const unsigned*)((const char*)(gbase) + (voff)[_i]), (PG8_LAS unsigned*)(lds + (bufoff) + ldsw + _i * 8192), 16, 0, 0); } while (0)
#define PG8_LDA(dst, b, h) do { _Pragma("unroll") for (int m = 0; m < 4; ++m) _Pragma("unroll") for (int k = 0; k < 2; ++k) dst[m][k] = *(const PG8_LAS bf16x8*)(lds + PG8_SA(b, h) + aoff + m * 2048 + k * 1024); } while (0)
#define PG8_LDB(dst, b, h) do { _Pragma("unroll") for (int n = 0; n < 2; ++n) _Pragma("unroll") for (int k = 0; k < 2; ++k) dst[n][k] = *(const PG8_LAS bf16x8*)(lds + PG8_SB(b, h) + boff + n * 2048 + k * 1024); } while (0)
#define PG8_MMA(ai, bj, At, Bt) do { __builtin_amdgcn_s_setprio(1); _Pragma("unroll") for (int m = 0; m < 4; ++m) _Pragma("unroll") for (int n = 0; n < 2; ++n) _Pragma("unroll") for (int k = 0; k < 2; ++k) \
        acc[ai][bj][m][n] = __builtin_amdgcn_mfma_f32_16x16x32_bf16(Bt[n][k], At[m][k], acc[ai][bj][m][n], 0, 0, 0); __builtin_amdgcn_s_setprio(0); } while (0)
#define PG8_WAIT_V(n) asm volatile("s_waitcnt vmcnt(" #n ")" ::: "memory")
#define PG8_WAIT_L(n) asm volatile("s_waitcnt lgkmcnt(" #n ")" ::: "memory")
#define PG8_BAR __builtin_amdgcn_s_barrier()
#define PG8_SCHED __builtin_amdgcn_sched_barrier(0)
    Unit cur, nxt; int ui = 0;
    if (!S.next(0, cur)) return;
    f32x4 acc[2][2][4][2];
#pragma unroll
    for (int a = 0; a < 2; ++a)
#pragma unroll
        for (int b = 0; b < 2; ++b)
#pragma unroll
            for (int m = 0; m < 4; ++m)
#pragma unroll
                for (int n = 0; n < 2; ++n) acc[a][b][m][n] = (f32x4){0.f, 0.f, 0.f, 0.f};
    bf16x8 At[4][2], B0[2][2], B1[2][2];
    const char* cA = (const char*)g.A + (size_t)cur.pm * tstep; const char* cB = (const char*)g.Bt + (size_t)cur.pn * tstep;
    S.a_ready(cur);
    if constexpr (SP2) {
        PG8_STAGE(PG8_SB(0, 0), cB, voffB); PG8_STAGE(PG8_SB(0, 1), cB + hstep, voffB); PG8_STAGE(PG8_SA(0, 0), cA, voffA); PG8_STAGE(PG8_SA(0, 1), cA + hstep, voffA);
        if (wr == 1) PG8_BAR;
        PG8_WAIT_V(2); PG8_BAR;
        PG8_STAGE(PG8_SB(1, 0), cB + kstep, voffB); PG8_STAGE(PG8_SA(1, 0), cA + kstep, voffA); PG8_STAGE(PG8_SB(1, 1), cB + hstep + kstep, voffB);
        PG8_WAIT_V(6); PG8_BAR;
    } else {
        PG8_STAGE(PG8_SB(0, 0), cB, voffB); PG8_STAGE(PG8_SA(0, 0), cA, voffA); PG8_STAGE(PG8_SB(0, 1), cB + hstep, voffB); PG8_STAGE(PG8_SA(0, 1), cA + hstep, voffA);
        if (wr == 1) PG8_BAR;
        PG8_WAIT_V(4); PG8_BAR;
        PG8_STAGE(PG8_SB(1, 0), cB + kstep, voffB); PG8_STAGE(PG8_SA(1, 0), cA + kstep, voffA); PG8_STAGE(PG8_SB(1, 1), cB + hstep + kstep, voffB);
        PG8_WAIT_V(6); PG8_BAR;
    }
    for (;;) {
        const bool has_next = S.next(ui + 1, nxt);
        const char* nA = has_next ? (const char*)g.A + (size_t)nxt.pm * tstep : cA; const char* nB = has_next ? (const char*)g.Bt + (size_t)nxt.pn * tstep : cB;
        for (int t = 0; t < nt; t += 2) {
            const bool last = (t == nt - 2);
            const char* a1 = cA + (size_t)(t + 1) * kstep;
            const char* a2 = last ? nA : cA + (size_t)(t + 2) * kstep; const char* b2 = last ? nB : cB + (size_t)(t + 2) * kstep;
            const char* a3 = a2 + kstep; const char* b3 = b2 + kstep;
            if (last && has_next) S.a_ready(nxt);
            if constexpr (SP2) {
            PG8_LDB(B0, 0, 0); PG8_LDB(B1, 0, 1); PG8_SCHED; PG8_LDA(At, 0, 0); PG8_STAGE(PG8_SA(1, 1), a1 + hstep, voffA);
            PG8_WAIT_V(8); PG8_WAIT_L(0); PG8_BAR; PG8_MMA(0, 0, At, B0); PG8_MMA(0, 1, At, B1); PG8_BAR; PG8_SCHED;
            PG8_LDA(At, 0, 1); PG8_STAGE(PG8_SB(0, 0), b2, voffB); PG8_STAGE(PG8_SB(0, 1), b2 + hstep, voffB); PG8_STAGE(PG8_SA(0, 0), a2, voffA);
            PG8_WAIT_V(8); PG8_WAIT_L(0); PG8_BAR; PG8_MMA(1, 0, At, B0); PG8_MMA(1, 1, At, B1); PG8_BAR; PG8_SCHED;
            PG8_LDB(B0, 1, 0); PG8_LDB(B1, 1, 1); PG8_SCHED; PG8_LDA(At, 1, 0); PG8_STAGE(PG8_SA(0, 1), a2 + hstep, voffA);
            PG8_WAIT_V(8); PG8_WAIT_L(0); PG8_BAR; PG8_MMA(0, 0, At, B0); PG8_MMA(0, 1, At, B1); PG8_BAR; PG8_SCHED;
            PG8_LDA(At, 1, 1); PG8_STAGE(PG8_SB(1, 0), b3, voffB); PG8_STAGE(PG8_SB(1, 1), b3 + hstep, voffB); PG8_STAGE(PG8_SA(1, 0), a3, voffA);
            PG8_WAIT_V(8); PG8_WAIT_L(0); PG8_BAR; PG8_MMA(1, 0, At, B0); PG8_MMA(1, 1, At, B1); PG8_BAR; PG8_SCHED;
            } else {
            PG8_LDB(B0, 0, 0); PG8_SCHED; PG8_LDA(At, 0, 0); PG8_STAGE(PG8_SA(1, 1), a1 + hstep, voffA);
            PG8_WAIT_L(8); PG8_BAR; PG8_WAIT_L(0); PG8_MMA(0, 0, At, B0); PG8_BAR; PG8_SCHED;
            PG8_LDB(B1, 0, 1); PG8_STAGE(PG8_SB(0, 0), b2, voffB);
            PG8_BAR; PG8_WAIT_L(0); PG8_MMA(0, 1, At, B1); PG8_BAR;
            PG8_LDA(At, 0, 1); PG8_STAGE(PG8_SA(0, 0), a2, voffA);
            PG8_BAR; PG8_WAIT_L(0); PG8_MMA(1, 0, At, B0); PG8_BAR; PG8_SCHED;
            PG8_STAGE(PG8_SB(0, 1), b2 + hstep, voffB);
            PG8_WAIT_V(6); PG8_BAR; PG8_MMA(1, 1, At, B1); PG8_BAR;
            PG8_LDB(B0, 1, 0); PG8_SCHED; PG8_LDA(At, 1, 0); PG8_STAGE(PG8_SA(0, 1), a2 + hstep, voffA);
            PG8_WAIT_L(8); PG8_BAR; PG8_WAIT_L(0); PG8_MMA(0, 0, At, B0); PG8_BAR; PG8_SCHED;
            PG8_LDB(B1, 1, 1); PG8_STAGE(PG8_SB(1, 0), b3, voffB);
            PG8_BAR; PG8_WAIT_L(0); PG8_MMA(0, 1, At, B1); PG8_BAR;
            PG8_LDA(At, 1, 1); PG8_STAGE(PG8_SA(1, 0), a3, voffA);
            PG8_BAR; PG8_WAIT_L(0); PG8_MMA(1, 0, At, B0); PG8_BAR; PG8_SCHED;
            PG8_STAGE(PG8_SB(1, 1), b3 + hstep, voffB);
            PG8_WAIT_V(6); PG8_BAR; PG8_MMA(1, 1, At, B1); PG8_BAR;
            }
        }
        if constexpr (ALIGN_EPI) { if (wr == 0) PG8_BAR; }
        if constexpr (!Epi::AFTER_DRAIN) { E(acc, cur, wr, wc, fr, fq); S.done(cur); }
        if (!has_next) break;
#pragma unroll
        for (int a = 0; a < 2; ++a)
#pragma unroll
            for (int b = 0; b < 2; ++b)
#pragma unroll
                for (int m = 0; m < 4; ++m)
#pragma unroll
                    for (int n = 0; n < 2; ++n) acc[a][b][m][n] = (f32x4){0.f, 0.f, 0.f, 0.f};
        cur = nxt; cA = nA; cB = nB; ++ui;
        if constexpr (ALIGN_EPI) { if (wr == 1) PG8_BAR; }
    }
    PG8_WAIT_V(0);
    if constexpr (!ALIGN_EPI) { if (wr == 0) PG8_BAR; }
    PG8_BAR;
    if constexpr (Epi::AFTER_DRAIN) { E.fused(acc, cur, wr, wc, fr, fq, lds, wid, lane); S.done(cur); }
#undef PG8_SA
#undef PG8_SB
#undef PG8_STAGE
#undef PG8_LDA
#undef PG8_LDB
#undef PG8_MMA
#undef PG8_WAIT_V
#undef PG8_WAIT_L
#undef PG8_BAR
#undef PG8_SCHED
}
}

namespace cg = cooperative_groups;
#define LAS __attribute__((address_space(3)))
typedef unsigned short bf16_t;
typedef short bf16x8 __attribute__((ext_vector_type(8)));
typedef float f32x4 __attribute__((ext_vector_type(4)));
typedef float f32x2 __attribute__((ext_vector_type(2)));
typedef unsigned u32x4 __attribute__((ext_vector_type(4)));
typedef unsigned u32x2 __attribute__((ext_vector_type(2)));
using pg8::cvt_pk_bf16;

constexpr int T = 8192, D = 2048, DFF = 8192, NQKV = 2560;
constexpr int LDS_BYTES = 147456;
constexpr float EPS = 1e-6f;
constexpr size_t MiB = 1u << 20;
constexpr size_t WS_MOD = 0;
constexpr size_t WS_LB = 128 * 1024;
constexpr size_t WS_BIAS = 512 * 1024;
constexpr size_t WS_PART = 1 * MiB;
constexpr int RS_OFF = 131072;
constexpr size_t WS_BAR = 256 * 1024, BAR_BYTES = 16384;
constexpr int MODCNT_WORD = 3600;
constexpr int MISC_OFF = LDS_BYTES - 64;
constexpr size_t WS_WT_AIN = 2 * MiB, WS_WT_AOUT = 12 * MiB, WS_WT_HIN = 20 * MiB, WS_WT_HOUT = 52 * MiB;
constexpr size_t WS_WT_W1 = 60 * MiB  , WS_WT_W2 = 124 * MiB  ;
constexpr size_t WS_H = 188 * MiB, WS_QKV = 220 * MiB, WS_ATT = 260 * MiB, WS_XA = 292 * MiB, WS_ACT = 356 * MiB;
constexpr size_t WS_QH = 484 * MiB, WS_LOGF = 516 * MiB, WS_VH = 580 * MiB, WS_GH = 220 * MiB, WS_US = 612 * MiB, WS_SS = 676 * MiB, WS_DEC = 740 * MiB, WS_END = 741 * MiB;

__device__ __forceinline__ float bflo(unsigned u) { return __uint_as_float(u << 16); }
__device__ __forceinline__ float bfhi(unsigned u) { return __uint_as_float(u & 0xffff0000u); }
__device__ __forceinline__ float bf2f(bf16_t u) { return __uint_as_float((unsigned)u << 16); }
__device__ __forceinline__ float wave_sum(float v) {
#pragma unroll
    for (int o = 1; o < 64; o <<= 1) v += __shfl_xor(v, o);
    return v;
}
__device__ __forceinline__ f32x4 mfma16(bf16x8 a, bf16x8 b, f32x4 c) { return __builtin_amdgcn_mfma_f32_16x16x32_bf16(a, b, c, 0, 0, 0); }
__device__ __forceinline__ bf16x8 as_bf16x8(u32x4 v) { return __builtin_bit_cast(bf16x8, v); }

struct Params {
    const float* x; const float* c; const float* mod_w; const float* mod_b; const float* norm_mix; const float* norm_mlp;
    const float* attn_w_in; const float* attn_w_out; const float* attn_q_gain; const float* attn_k_gain; const float* attn_sinks;
    const float* hgrn_w_in; const float* hgrn_w_out; const float* hgrn_o_gain; const float* hgrn_lb_logits; const float* mlp_w1; const float* mlp_w2;
    float* out; unsigned char* ws;
};

__device__ __forceinline__ void p0_transpose_item(const float* W, int K, int N, bf16_t* WT, LAS float* scr, int item, int lane) {
    const int nblk = N / 32, kb = item / nblk, nb = item % nblk, k0 = 64 * kb, n0 = 32 * nb;
#pragma unroll 8
    for (int i = 0; i < 32; ++i) { const int kk = 2 * i + (lane >> 5); scr[kk * 33 + (lane & 31)] = W[(size_t)(k0 + kk) * N + n0 + (lane & 31)]; }
    asm volatile("s_waitcnt lgkmcnt(0)" ::: "memory");
    const int c = lane & 7;
#pragma unroll
    for (int j = 0; j < 4; ++j) { const int n = (lane >> 3) + 8 * j; const LAS float* s = scr + (8 * c) * 33 + n;
        u32x4 o; o.x = cvt_pk_bf16(s[0 * 33], s[1 * 33]); o.y = cvt_pk_bf16(s[2 * 33], s[3 * 33]); o.z = cvt_pk_bf16(s[4 * 33], s[5 * 33]); o.w = cvt_pk_bf16(s[6 * 33], s[7 * 33]);
        *(u32x4*)(WT + (size_t)(n0 + n) * K + k0 + 8 * c) = o; }
    asm volatile("s_waitcnt lgkmcnt(0)" ::: "memory");
}

__device__ __forceinline__ void prologue_phase(LAS unsigned char* lds, const Params& p) {
    const int tid = pg8::opaque_tid(), lane = tid & 63, wave = tid >> 6;
    float* MOD = (float*)(p.ws + WS_MOD); float* LB = (float*)(p.ws + WS_LB);
    for (int i = blockIdx.x * 512 + tid; i < 2048; i += gridDim.x * 512) { const float l0 = p.hgrn_lb_logits[i], l1 = p.hgrn_lb_logits[2048 + i]; LB[i] = 1.0f / (1.0f + expf(l0 - l1)); }
    {
        LAS float* cond = (LAS float*)lds; LAS f32x4* red = (LAS f32x4*)(lds + 8192);
        for (int i = tid; i < 2048; i += 512) { const float c = p.c[i]; cond[i] = c / (1.0f + expf(-c)); }
        __syncthreads();
        for (int slice = blockIdx.x; slice < 256; slice += gridDim.x) {
            const int layer = slice >> 7, col0 = (slice & 127) * 96, cgp = tid % 24, kr = tid / 24;
            f32x4 acc = {0.f, 0.f, 0.f, 0.f};
            if (kr < 21) {
                const float* W = p.mod_w + (size_t)layer * 2048 * 12288 + col0 + 4 * cgp;
#pragma unroll 4
                for (int k = kr; k < 2048; k += 21) { const f32x4 w = __builtin_nontemporal_load((const f32x4*)(W + (size_t)k * 12288)); acc += w * cond[k]; }
                red[kr * 24 + cgp] = acc;
            }
            __syncthreads();
            if (tid < 96) { float s = p.mod_b[layer * 12288 + col0 + tid];
                for (int r = 0; r < 21; ++r) s += ((LAS float*)red)[r * 96 + tid];
                MOD[layer * 12288 + col0 + tid] = s; }
            __syncthreads();
        }
    }
    asm volatile("s_waitcnt vmcnt(0)" ::: "memory");
    __syncthreads();
    if (tid == 0) { __builtin_amdgcn_fence(__ATOMIC_RELEASE, "agent"); asm volatile("s_waitcnt vmcnt(0)" ::: "memory");
        (void)__hip_atomic_fetch_add((unsigned*)(p.ws + WS_BAR) + MODCNT_WORD, 1u, __ATOMIC_RELAXED, __HIP_MEMORY_SCOPE_AGENT); }
    {
        LAS float* scr = (LAS float*)(lds + wave * 16384);
        const int gw = blockIdx.x * 8 + wave, NGW = gridDim.x * 8;
        constexpr int I_AIN = (D / 64) * (NQKV / 32), I_SQ = (D / 64) * (D / 32), I_BIG = (D / 64) * (DFF / 32);
        constexpr int NITEMS = I_AIN + 2 * I_SQ + 5 * I_BIG;
        for (int it = gw; it < NITEMS; it += NGW) {
            int r = it;
            if (r < I_AIN) { p0_transpose_item(p.attn_w_in, D, NQKV, (bf16_t*)(p.ws + WS_WT_AIN), scr, r, lane); continue; } r -= I_AIN;
            if (r < I_SQ) { p0_transpose_item(p.attn_w_out, D, D, (bf16_t*)(p.ws + WS_WT_AOUT), scr, r, lane); continue; } r -= I_SQ;
            if (r < I_SQ) { p0_transpose_item(p.hgrn_w_out, D, D, (bf16_t*)(p.ws + WS_WT_HOUT), scr, r, lane); continue; } r -= I_SQ;
            if (r < I_BIG) { p0_transpose_item(p.hgrn_w_in, D, DFF, (bf16_t*)(p.ws + WS_WT_HIN), scr, r, lane); continue; } r -= I_BIG;
            if (r < I_BIG) { p0_transpose_item(p.mlp_w1, D, DFF, (bf16_t*)(p.ws + WS_WT_W1), scr, r, lane); continue; } r -= I_BIG;
            if (r < I_BIG) { p0_transpose_item(p.mlp_w1 + (size_t)D * DFF, D, DFF, (bf16_t*)(p.ws + WS_WT_W1 + 32 * MiB), scr, r, lane); continue; } r -= I_BIG;
            if (r < I_BIG) { p0_transpose_item(p.mlp_w2, DFF, D, (bf16_t*)(p.ws + WS_WT_W2), scr, r, lane); continue; } r -= I_BIG;
            p0_transpose_item(p.mlp_w2 + (size_t)D * DFF, DFF, D, (bf16_t*)(p.ws + WS_WT_W2 + 32 * MiB), scr, r, lane);
        }
    }
}

__device__ __forceinline__ void norm_phase(LAS unsigned char* lds, const float* xin, const float* gain, const float* sh, const float* sc, bf16_t* out) {
    const int tid = pg8::opaque_tid(), lane = tid & 63, wave = tid >> 6;
    LAS float* Av = (LAS float*)lds; LAS float* Bv = (LAS float*)(lds + 8192);
    for (int i = tid; i < 2048; i += 512) { Av[i] = gain[i] * (1.0f + sc[i]); Bv[i] = sh[i]; }
    __syncthreads();
    const int gw = blockIdx.x * 8 + wave, NGW = gridDim.x * 8;
    for (int m = gw; m < T; m += 2 * NGW) {
        const int m2 = m + NGW < T ? m + NGW : m;
        const f32x4* xr = (const f32x4*)(xin + (size_t)m * D) + lane; const f32x4* xr2 = (const f32x4*)(xin + (size_t)m2 * D) + lane;
        f32x4 v[8], v2[8]; float s = 0.f, s2 = 0.f;
#pragma unroll
        for (int j = 0; j < 8; ++j) { v[j] = xr[64 * j]; v2[j] = xr2[64 * j]; }
#pragma unroll
        for (int j = 0; j < 8; ++j) { s += (v[j].x * v[j].x + v[j].y * v[j].y) + (v[j].z * v[j].z + v[j].w * v[j].w); s2 += (v2[j].x * v2[j].x + v2[j].y * v2[j].y) + (v2[j].z * v2[j].z + v2[j].w * v2[j].w); }
        const float rstd = rsqrtf(wave_sum(s) * (1.0f / D) + EPS), rstd2 = rsqrtf(wave_sum(s2) * (1.0f / D) + EPS);
        u32x2* o8 = (u32x2*)(out + (size_t)m * D) + lane; u32x2* o82 = (u32x2*)(out + (size_t)m2 * D) + lane;
#pragma unroll
        for (int j = 0; j < 8; ++j) { const f32x4 a = ((LAS f32x4*)Av)[lane + 64 * j], b = ((LAS f32x4*)Bv)[lane + 64 * j];
            const f32x4 y = v[j] * rstd * a + b, y2 = v2[j] * rstd2 * a + b; u32x2 w, w2; w.x = cvt_pk_bf16(y.x, y.y); w.y = cvt_pk_bf16(y.z, y.w); w2.x = cvt_pk_bf16(y2.x, y2.y); w2.y = cvt_pk_bf16(y2.z, y2.w);
            o8[64 * j] = w; if (m2 != m) o82[64 * j] = w2; }
    }
    __syncthreads();
}


__device__ __forceinline__ void rstd_prepare(LAS float* rs, const float* part, const pg8::StaticOrder& S) {
    const int tid = pg8::opaque_tid(), j = tid >> 7, r0 = (tid & 127) * 2; pg8::Unit u;
    if (S.next(j, u)) {
#pragma unroll
        for (int rr = 0; rr < 2; ++rr) { const f32x4* pp = (const f32x4*)(part + (size_t)(u.pm * 256 + r0 + rr) * 32); float s = 0.f;
#pragma unroll
            for (int i = 0; i < 8; ++i) { const f32x4 v = pp[i]; s += (v.x + v.y) + (v.z + v.w); }
            rs[j * 256 + r0 + rr] = rsqrtf(s * (1.0f / D) + EPS); }
    }
    __syncthreads();
}
__device__ __forceinline__ void bias_gemv(const float* sh, const bf16_t* WT, float* bias, int nrows, int wave_id, int nwaves) {
    const int lane = pg8::opaque_tid() & 63;
    float shv[32];
#pragma unroll
    for (int i = 0; i < 4; ++i)
#pragma unroll
        for (int e = 0; e < 8; ++e) shv[8 * i + e] = sh[(lane + 64 * i) * 8 + e];
    for (int row = wave_id; row < nrows; row += 4 * nwaves) {
        u32x4 v[4][4];
#pragma unroll
        for (int q = 0; q < 4; ++q) { const int rq = row + q * nwaves < nrows ? row + q * nwaves : row; const u32x4* pr = (const u32x4*)(WT + (size_t)rq * D) + lane;
#pragma unroll
            for (int i = 0; i < 4; ++i) v[q][i] = pr[64 * i]; }
#pragma unroll
        for (int q = 0; q < 4; ++q) { float a = 0.f;
#pragma unroll
            for (int i = 0; i < 4; ++i)
#pragma unroll
                for (int e = 0; e < 4; ++e) a += bflo(v[q][i][e]) * shv[8 * i + 2 * e] + bfhi(v[q][i][e]) * shv[8 * i + 2 * e + 1];
            a = wave_sum(a);
            if (lane == 0 && row + q * nwaves < nrows) bias[row + q * nwaves] = a; }
    }
}

__device__ __forceinline__ void attn_phase(LAS unsigned char* lds, const bf16_t* QKV, const float* qg, const float* kg, const float* sinks, bf16_t* ATT) {
    constexpr int LDQ = NQKV, KST = 72, VST = 280;
    LAS bf16_t* Ks = (LAS bf16_t*)lds;
    LAS bf16_t* Vt = (LAS bf16_t*)(lds + 272 * KST * 2);
    const int tid = pg8::opaque_tid(), lane = tid & 63, wid = tid >> 6, fr = lane & 15, fq = lane >> 4;
    for (int unit = blockIdx.x; unit < 256; unit += gridDim.x) {
        const int kvh = unit & 3, nb = unit >> 2;
        u32x4 q0n, q1n;
        { const u32x4* qp = (const u32x4*)(QKV + (size_t)(nb * 128 + fr) * LDQ + (kvh * 8 + wid) * 64 + 8 * fq); q0n = qp[0]; q1n = qp[4]; }
        {
            const int kp = tid >> 1, half = tid & 1, s_abs = (nb - 1) * 128 + kp;
            u32x4 kr[4], vr[4];
#pragma unroll
            for (int i = 0; i < 4; ++i) { kr[i] = (u32x4){0u, 0u, 0u, 0u}; vr[i] = (u32x4){0u, 0u, 0u, 0u}; }
            if (s_abs >= 0) {
                const u32x4* kptr = (const u32x4*)(QKV + (size_t)s_abs * LDQ + 2048 + kvh * 64 + half * 32);
                const u32x4* vptr = (const u32x4*)(QKV + (size_t)s_abs * LDQ + 2304 + kvh * 64 + half * 32);
#pragma unroll
                for (int i = 0; i < 4; ++i) { kr[i] = kptr[i]; vr[i] = vptr[i]; }
            }
            float ss = 0.f;
#pragma unroll
            for (int i = 0; i < 4; ++i)
#pragma unroll
                for (int e = 0; e < 4; ++e) { const float a = bflo(kr[i][e]), b = bfhi(kr[i][e]); ss += a * a + b * b; }
            ss += __shfl_xor(ss, 1);
            const float rstd = rsqrtf(ss * (1.0f / 64.0f) + EPS);
#pragma unroll
            for (int i = 0; i < 4; ++i) { u32x4 w;
#pragma unroll
                for (int e = 0; e < 4; ++e) { const int d = half * 32 + i * 8 + e * 2; w[e] = cvt_pk_bf16(bflo(kr[i][e]) * rstd * kg[d], bfhi(kr[i][e]) * rstd * kg[d + 1]); }
                *(LAS u32x4*)(Ks + kp * KST + half * 32 + i * 8) = w; }
#pragma unroll
            for (int i = 0; i < 4; ++i)
#pragma unroll
                for (int e = 0; e < 4; ++e) { const int d = half * 32 + i * 8 + e * 2;
                    Vt[d * VST + kp] = (bf16_t)(vr[i][e] & 0xffffu); Vt[(d + 1) * VST + kp] = (bf16_t)(vr[i][e] >> 16); }
            for (int e = tid; e < 16 * KST / 2; e += 512) ((LAS unsigned*)(Ks + 256 * KST))[e] = 0u;
            for (int e = tid; e < 64 * 16; e += 512) Vt[(e >> 4) * VST + 256 + (e & 15)] = (bf16_t)0;
        }
        __syncthreads();
        const int h = kvh * 8 + wid;
        const float LOG2E = 1.4426950408889634f;
        const float slope = exp2f(-0.25f * (float)(h + 1)) * LOG2E, sink = sinks[h] * LOG2E;
        float qgv[16];
#pragma unroll
        for (int e = 0; e < 8; ++e) { qgv[e] = qg[8 * fq + e] * (0.125f * LOG2E); qgv[8 + e] = qg[32 + 8 * fq + e] * (0.125f * LOG2E); }
        float ar[4]; bool m0[4];
#pragma unroll
        for (int r = 0; r < 4; ++r) { ar[r] = slope * (float)(128 + fr - 4 * fq - r); m0[r] = fr < 4 * fq + r; }
        const float s16 = slope * 16.0f;
        for (int mt = 0; mt < 8; ++mt) {
            const int qi = 16 * mt + fr, t_abs = nb * 128 + qi;
            const u32x4 q0 = q0n, q1 = q1n;
            if (mt < 7) { const u32x4* qp = (const u32x4*)(QKV + (size_t)(t_abs + 16) * LDQ + h * 64 + 8 * fq); q0n = qp[0]; q1n = qp[4]; }
            float qf[16]; float ss = 0.f;
#pragma unroll
            for (int e = 0; e < 4; ++e) { qf[2 * e] = bflo(q0[e]); qf[2 * e + 1] = bfhi(q0[e]); qf[8 + 2 * e] = bflo(q1[e]); qf[8 + 2 * e + 1] = bfhi(q1[e]); }
#pragma unroll
            for (int e = 0; e < 16; ++e) ss += qf[e] * qf[e];
            ss += __shfl_xor(ss, 16); ss += __shfl_xor(ss, 32);
            const float rstd = rsqrtf(ss * (1.0f / 64.0f) + EPS);
            u32x4 qa, qb;
#pragma unroll
            for (int e = 0; e < 4; ++e) { qa[e] = cvt_pk_bf16(qf[2 * e] * rstd * qgv[2 * e], qf[2 * e + 1] * rstd * qgv[2 * e + 1]);
                                          qb[e] = cvt_pk_bf16(qf[8 + 2 * e] * rstd * qgv[8 + 2 * e], qf[8 + 2 * e + 1] * rstd * qgv[8 + 2 * e + 1]); }
            const bf16x8 Q0 = as_bf16x8(qa), Q1 = as_bf16x8(qb);
            f32x4 S[10];
#pragma unroll
            for (int jj = 0; jj < 9; ++jj) {
                const LAS bf16_t* kp_ = Ks + (16 * (mt + jj) + fr) * KST + 8 * fq;
                const bf16x8 K0 = *(const LAS bf16x8*)kp_, K1 = *(const LAS bf16x8*)(kp_ + 32);
                f32x4 a = {0.f, 0.f, 0.f, 0.f};
                a = mfma16(K0, Q0, a); a = mfma16(K1, Q1, a); S[jj] = a;
            }
            float mx = sink;
#pragma unroll
            for (int jj = 0; jj < 9; ++jj)
#pragma unroll
                for (int r = 0; r < 4; ++r) {
                    float lg = S[jj][r] - (ar[r] - s16 * (float)jj);
                    if (jj == 0) lg = m0[r] ? lg : -INFINITY;
                    if (jj == 8) lg = m0[r] ? -INFINITY : lg;
                    if (nb == 0) lg = (16 * (mt + jj) + 4 * fq + r >= 128) ? lg : -INFINITY;
                    S[jj][r] = lg; mx = fmaxf(mx, lg);
                }
            mx = fmaxf(mx, __shfl_xor(mx, 16)); mx = fmaxf(mx, __shfl_xor(mx, 32));
            float sum = 0.f;
#pragma unroll
            for (int jj = 0; jj < 9; ++jj)
#pragma unroll
                for (int r = 0; r < 4; ++r) { const float pv = __builtin_amdgcn_exp2f(S[jj][r] - mx); S[jj][r] = pv; sum += pv; }
            S[9] = (f32x4){0.f, 0.f, 0.f, 0.f};
            sum += __shfl_xor(sum, 16); sum += __shfl_xor(sum, 32);
            sum += __builtin_amdgcn_exp2f(sink - mx);
            const float inv = 1.0f / sum;
            f32x4 O[4];
#pragma unroll
            for (int dt = 0; dt < 4; ++dt) O[dt] = (f32x4){0.f, 0.f, 0.f, 0.f};
#pragma unroll
            for (int pp = 0; pp < 5; ++pp) {
                u32x4 pw; pw.x = cvt_pk_bf16(S[2 * pp][0], S[2 * pp][1]); pw.y = cvt_pk_bf16(S[2 * pp][2], S[2 * pp][3]);
                pw.z = cvt_pk_bf16(S[2 * pp + 1][0], S[2 * pp + 1][1]); pw.w = cvt_pk_bf16(S[2 * pp + 1][2], S[2 * pp + 1][3]);
                const bf16x8 P = as_bf16x8(pw);
                const int ka = 16 * (mt + 2 * pp) + 4 * fq;
#pragma unroll
                for (int dt = 0; dt < 4; ++dt) {
                    const LAS bf16_t* vrow = Vt + (16 * dt + fr) * VST + ka;
                    const u32x2 va = *(const LAS u32x2*)vrow, vb = *(const LAS u32x2*)(vrow + 16);
                    u32x4 vw; vw.x = va.x; vw.y = va.y; vw.z = vb.x; vw.w = vb.y;
                    O[dt] = mfma16(as_bf16x8(vw), P, O[dt]);
                }
            }
            bf16_t* orow = ATT + (size_t)t_abs * D + h * 64 + 4 * fq;
#pragma unroll
            for (int dt = 0; dt < 4; ++dt) { u32x2 w; w.x = cvt_pk_bf16(O[dt][0] * inv, O[dt][1] * inv); w.y = cvt_pk_bf16(O[dt][2] * inv, O[dt][3] * inv);
                *(u32x2*)(orow + 16 * dt) = w; }
        }
        __syncthreads();
    }
}

__device__ __forceinline__ void hgrn_h1(LAS unsigned char* lds, const bf16_t* LOGF, const bf16_t* Vh, bf16_t* US, float* DEC) {
    LAS float* B = (LAS float*)lds;
    LAS float* TOT = (LAS float*)(lds + 32768);
    LAS bf16_t* KT = (LAS bf16_t*)(lds + 34816);
    LAS bf16_t* VT = (LAS bf16_t*)(lds + 34816 + 18432);
    const int tid = pg8::opaque_tid(), lane = tid & 63, wid = tid >> 6, fr = lane & 15, fq = lane >> 4;
    const int d = tid & 127, seg = tid >> 7;
    u32x4 pl[2]; bf16_t pv[16];
#define H1_LOAD(unit_) do { const int n_ = (unit_) >> 4, h_ = (unit_) & 15, t0_ = n_ * 64; \
        _Pragma("unroll") for (int i = 0; i < 2; ++i) { const int idx = tid + 512 * i, row = idx >> 4, c8 = idx & 15; pl[i] = *(const u32x4*)(LOGF + (size_t)(t0_ + row) * D + h_ * 128 + 8 * c8); } \
        _Pragma("unroll") for (int i = 0; i < 16; ++i) pv[i] = Vh[(size_t)(t0_ + 16 * seg + i) * D + h_ * 128 + d]; } while (0)
    if ((int)blockIdx.x < 2048) H1_LOAD((int)blockIdx.x);
    for (int unit = blockIdx.x; unit < 2048; unit += gridDim.x) {
        const int n = unit >> 4, h = unit & 15;
#pragma unroll
        for (int i = 0; i < 2; ++i) { const int idx = tid + 512 * i;
            ((LAS f32x4*)B)[2 * idx] = (f32x4){bflo(pl[i].x), bfhi(pl[i].x), bflo(pl[i].y), bfhi(pl[i].y)};
            ((LAS f32x4*)B)[2 * idx + 1] = (f32x4){bflo(pl[i].z), bfhi(pl[i].z), bflo(pl[i].w), bfhi(pl[i].w)}; }
        bf16_t vv[16];
#pragma unroll
        for (int i = 0; i < 16; ++i) vv[i] = pv[i];
        __syncthreads();
        if (unit + (int)gridDim.x < 2048) H1_LOAD(unit + (int)gridDim.x);
        float lf[16], b[16]; float run = 0.f;
#pragma unroll
        for (int i = 0; i < 16; ++i) { lf[i] = B[(16 * seg + i) * 128 + d]; run += lf[i]; b[i] = run; }
        TOT[seg * 128 + d] = run;
        __syncthreads();
        float off = 0.f, tot = 0.f;
#pragma unroll
        for (int s2 = 0; s2 < 4; ++s2) { const float tv = TOT[s2 * 128 + d]; off += (s2 < seg) ? tv : 0.f; tot += tv; }
        u32x4 kw[2], vw[2];
#pragma unroll
        for (int i = 0; i < 16; i += 2) {
            const float k0 = (1.0f - __expf(lf[i])) * __expf(tot - (b[i] + off)), k1 = (1.0f - __expf(lf[i + 1])) * __expf(tot - (b[i + 1] + off));
            kw[i >> 3][(i >> 1) & 3] = cvt_pk_bf16(k0, k1);
            vw[i >> 3][(i >> 1) & 3] = (unsigned)vv[i] | ((unsigned)vv[i + 1] << 16);
        }
        *(LAS u32x4*)(KT + d * 72 + 16 * seg) = kw[0]; *(LAS u32x4*)(KT + d * 72 + 16 * seg + 8) = kw[1];
        *(LAS u32x4*)(VT + d * 72 + 16 * seg) = vw[0]; *(LAS u32x4*)(VT + d * 72 + 16 * seg + 8) = vw[1];
        if (seg == 0) DEC[(size_t)(n * 16 + h) * 128 + d] = __expf(tot);
        __syncthreads();
        const bf16x8 V0 = *(const LAS bf16x8*)(VT + (16 * wid + fr) * 72 + 8 * fq), V1 = *(const LAS bf16x8*)(VT + (16 * wid + fr) * 72 + 8 * fq + 32);
        bf16_t* urow = US + ((size_t)(n * 16 + h) * 128 + 16 * wid + fr) * 128 + 4 * fq;
#pragma unroll
        for (int dt = 0; dt < 8; ++dt) {
            const bf16x8 K0 = *(const LAS bf16x8*)(KT + (16 * dt + fr) * 72 + 8 * fq), K1 = *(const LAS bf16x8*)(KT + (16 * dt + fr) * 72 + 8 * fq + 32);
            f32x4 a = {0.f, 0.f, 0.f, 0.f};
            a = mfma16(K0, V0, a); a = mfma16(K1, V1, a);
            u32x2 w; w.x = cvt_pk_bf16(a[0], a[1]); w.y = cvt_pk_bf16(a[2], a[3]);
            *(u32x2*)(urow + 16 * dt) = w;
        }
        __syncthreads();
    }
}
__device__ __forceinline__ void hgrn_h2(const bf16_t* US, bf16_t* SS, const float* DEC) {
    for (int pidx = blockIdx.x * 512 + threadIdx.x; pidx < 131072; pidx += gridDim.x * 512) {
        const int e = 2 * pidx, h = e >> 14, dd = e & 127;
        float s0 = 0.f, s1 = 0.f;
        for (int n0 = 0; n0 < 128; n0 += 16) {
            unsigned u[16]; f32x2 dc[16];
#pragma unroll
            for (int i = 0; i < 16; ++i) { u[i] = __builtin_nontemporal_load((const unsigned*)(US + (size_t)(n0 + i) * 262144 + e)); dc[i] = *(const f32x2*)(DEC + (size_t)((n0 + i) * 16 + h) * 128 + dd); }
#pragma unroll
            for (int i = 0; i < 16; ++i) { *(unsigned*)(SS + (size_t)(n0 + i) * 262144 + e) = cvt_pk_bf16(s0, s1);
                s0 = dc[i].x * s0 + bflo(u[i]); s1 = dc[i].y * s1 + bfhi(u[i]); }
        }
    }
}
__device__ __forceinline__ void hgrn_h3(LAS unsigned char* lds, const bf16_t* LOGF, const bf16_t* Qh, const bf16_t* Vh, const bf16_t* Gh, const bf16_t* US, const float* og, bf16_t* OUT) {
    LAS float* B = (LAS float*)lds;
    LAS float* TOT = (LAS float*)(lds + 33792);
    LAS float* EP = (LAS float*)(lds + 35840);
    LAS bf16_t* QT = (LAS bf16_t*)(lds + 36352);
    LAS bf16_t* KQ = (LAS bf16_t*)(lds + 53760);
    LAS bf16_t* AM = (LAS bf16_t*)(lds + 71168);
    LAS bf16_t* VT = (LAS bf16_t*)(lds + 80384);
    LAS bf16_t* ST = (LAS bf16_t*)(lds + 98816);
    const int tid = pg8::opaque_tid(), lane = tid & 63, wid = tid >> 6, fr = lane & 15, fq = lane >> 4;
    const int d = tid & 127, seg = tid >> 7;
    u32x4 pl[2]; bf16_t pv[16], pq[16];
#define H3_LOAD(unit_) do { const int n_ = (unit_) >> 4, h_ = (unit_) & 15, t0_ = n_ * 64; \
        _Pragma("unroll") for (int i = 0; i < 2; ++i) { const int idx = tid + 512 * i, row = idx >> 4, c8 = idx & 15; pl[i] = *(const u32x4*)(LOGF + (size_t)(t0_ + row) * D + h_ * 128 + 8 * c8); } \
        _Pragma("unroll") for (int i = 0; i < 16; ++i) { pv[i] = Vh[(size_t)(t0_ + 16 * seg + i) * D + h_ * 128 + d]; pq[i] = Qh[(size_t)(t0_ + 16 * seg + i) * D + h_ * 128 + d]; } } while (0)
    if ((int)blockIdx.x < 2048) H3_LOAD((int)blockIdx.x);
    for (int unit = blockIdx.x; unit < 2048; unit += gridDim.x) {
        const int n = unit >> 4, h = unit & 15, t0 = n * 64;
#pragma unroll
        for (int i = 0; i < 2; ++i) { const int idx = tid + 512 * i;
            ((LAS f32x4*)B)[2 * idx] = (f32x4){bflo(pl[i].x), bfhi(pl[i].x), bflo(pl[i].y), bfhi(pl[i].y)};
            ((LAS f32x4*)B)[2 * idx + 1] = (f32x4){bflo(pl[i].z), bfhi(pl[i].z), bflo(pl[i].w), bfhi(pl[i].w)}; }
        bf16_t vv[16], qq[16];
#pragma unroll
        for (int i = 0; i < 16; ++i) { vv[i] = pv[i]; qq[i] = pq[i]; }
        __syncthreads();
        if (unit + (int)gridDim.x < 2048) H3_LOAD(unit + (int)gridDim.x);
        float lf[16], b[16]; float run = 0.f;
#pragma unroll
        for (int i = 0; i < 16; ++i) { lf[i] = B[(16 * seg + i) * 128 + d]; run += lf[i]; b[i] = run; }
        TOT[seg * 128 + d] = run;
        __syncthreads();
        const float t0v = TOT[d], t1v = TOT[128 + d], t2v = TOT[256 + d];
        const float off = (seg > 0 ? t0v : 0.f) + (seg > 1 ? t1v : 0.f) + (seg > 2 ? t2v : 0.f), piv = t0v + t1v;
        u32x4 vw[2];
#pragma unroll
        for (int i = 0; i < 16; ++i) {
            const float bi = b[i] + off; const int c = 16 * seg + i;
            const float qt = bf2f(qq[i]) * __expf(bi - piv), kt = (1.0f - __expf(lf[i])) * __expf(piv - bi);
            QT[c * 136 + d] = (bf16_t)(cvt_pk_bf16(qt, 0.f) & 0xffffu); KQ[c * 136 + d] = (bf16_t)(cvt_pk_bf16(kt, 0.f) & 0xffffu);
        }
#pragma unroll
        for (int i = 0; i < 16; i += 2) vw[i >> 3][(i >> 1) & 3] = (unsigned)vv[i] | ((unsigned)vv[i + 1] << 16);
        *(LAS u32x4*)(VT + d * 72 + 16 * seg) = vw[0]; *(LAS u32x4*)(VT + d * 72 + 16 * seg + 8) = vw[1];
        if (seg == 0) EP[d] = __expf(piv);
        __syncthreads();
        {
            const int v = tid >> 2, dq = (tid & 3) * 32;
            const u32x4* sp = (const u32x4*)(US + ((size_t)(n * 16 + h) * 128 + v) * 128 + dq);
#pragma unroll
            for (int i = 0; i < 4; ++i) { const u32x4 s = sp[i]; u32x4 w;
#pragma unroll
                for (int e = 0; e < 4; ++e) { const int dd = dq + 8 * i + 2 * e; w[e] = cvt_pk_bf16(bflo(s[e]) * EP[dd], bfhi(s[e]) * EP[dd + 1]); }
                *(LAS u32x4*)(ST + v * 136 + dq + 8 * i) = w; }
        }
        {
            const int ct = wid >> 1;
#pragma unroll
            for (int sti = 0; sti < 2; ++sti) {
                const int st = 2 * (wid & 1) + sti;
                f32x4 a = {0.f, 0.f, 0.f, 0.f};
                if (st <= ct) {
#pragma unroll
                    for (int ks = 0; ks < 4; ++ks) {
                        const bf16x8 Kf = *(const LAS bf16x8*)(KQ + (16 * st + fr) * 136 + 8 * fq + 32 * ks), Qf = *(const LAS bf16x8*)(QT + (16 * ct + fr) * 136 + 8 * fq + 32 * ks);
                        a = mfma16(Kf, Qf, a);
                    }
                }
                const int c = 16 * ct + fr, s = 16 * st + 4 * fq;
#pragma unroll
                for (int r = 0; r < 4; ++r) a[r] = (st <= ct && s + r <= c) ? a[r] : 0.f;
                u32x2 w; w.x = cvt_pk_bf16(a[0], a[1]); w.y = cvt_pk_bf16(a[2], a[3]);
                *(LAS u32x2*)(AM + c * 72 + s) = w;
            }
        }
        __syncthreads();
        {
            bf16x8 Sf[4], Vf[2];
#pragma unroll
            for (int ks = 0; ks < 4; ++ks) Sf[ks] = *(const LAS bf16x8*)(ST + (16 * wid + fr) * 136 + 8 * fq + 32 * ks);
#pragma unroll
            for (int ks = 0; ks < 2; ++ks) Vf[ks] = *(const LAS bf16x8*)(VT + (16 * wid + fr) * 72 + 8 * fq + 32 * ks);
#pragma unroll
            for (int ct = 0; ct < 4; ++ct) {
                f32x4 a = {0.f, 0.f, 0.f, 0.f};
#pragma unroll
                for (int ks = 0; ks < 4; ++ks) a = mfma16(Sf[ks], *(const LAS bf16x8*)(QT + (16 * ct + fr) * 136 + 8 * fq + 32 * ks), a);
#pragma unroll
                for (int ks = 0; ks < 2; ++ks) a = mfma16(Vf[ks], *(const LAS bf16x8*)(AM + (16 * ct + fr) * 72 + 8 * fq + 32 * ks), a);
                *(LAS f32x4*)(B + (16 * ct + fr) * 132 + 16 * wid + 4 * fq) = a;
            }
        }
        __syncthreads();
        {
            const int c = tid >> 3, v0 = (tid & 7) * 16;
            f32x4 o[4]; float ss = 0.f;
#pragma unroll
            for (int i = 0; i < 4; ++i) { o[i] = *(const LAS f32x4*)(B + c * 132 + v0 + 4 * i); ss += (o[i].x * o[i].x + o[i].y * o[i].y) + (o[i].z * o[i].z + o[i].w * o[i].w); }
            ss += __shfl_xor(ss, 1); ss += __shfl_xor(ss, 2); ss += __shfl_xor(ss, 4);
            const float rstd = rsqrtf(ss * (1.0f / 128.0f) + EPS);
            const u32x4* gp = (const u32x4*)(Gh + (size_t)(t0 + c) * D + h * 128 + v0);
            const u32x4 g0 = gp[0], g1 = gp[1];
            const f32x4* ogp = (const f32x4*)(og + h * 128 + v0);
            u32x4 w0, w1;
#pragma unroll
            for (int i = 0; i < 2; ++i) { const f32x4 ga = ogp[i];
                w0[2 * i] = cvt_pk_bf16(o[i].x * rstd * ga.x * bflo(g0[2 * i]), o[i].y * rstd * ga.y * bfhi(g0[2 * i]));
                w0[2 * i + 1] = cvt_pk_bf16(o[i].z * rstd * ga.z * bflo(g0[2 * i + 1]), o[i].w * rstd * ga.w * bfhi(g0[2 * i + 1])); }
#pragma unroll
            for (int i = 0; i < 2; ++i) { const f32x4 ga = ogp[2 + i];
                w1[2 * i] = cvt_pk_bf16(o[2 + i].x * rstd * ga.x * bflo(g1[2 * i]), o[2 + i].y * rstd * ga.y * bfhi(g1[2 * i]));
                w1[2 * i + 1] = cvt_pk_bf16(o[2 + i].z * rstd * ga.z * bflo(g1[2 * i + 1]), o[2 + i].w * rstd * ga.w * bfhi(g1[2 * i + 1])); }
            u32x4* op = (u32x4*)(OUT + (size_t)(t0 + c) * D + h * 128 + v0);
            op[0] = w0; op[1] = w1;
        }
        __syncthreads();
    }
}

#define XB_TMO      128
#define XB_XCNT(j)  (256  + 64 * (j))
#define XB_XSUB(j)  (1280 + 64 * (j))
#define XB_XGEN(j)  (2304 + 64 * (j))
#define XB_TOP      3328
#define XB_TOPGEN   3392
#define XCD_BAR_WORDS 3456
#define XB_SPIN_CAP (1u << 18)

__device__ __forceinline__ unsigned xb_ld(unsigned* p)              { return __hip_atomic_load(p, __ATOMIC_RELAXED, __HIP_MEMORY_SCOPE_AGENT); }
__device__ __forceinline__ unsigned xb_add(unsigned* p, unsigned v) { return __hip_atomic_fetch_add(p, v, __ATOMIC_RELAXED, __HIP_MEMORY_SCOPE_AGENT); }
__device__ __forceinline__ unsigned xb_xcc_id() { return (unsigned)__builtin_amdgcn_s_getreg((3 << 11) | 20) & 0xFu; }
#define XB_SPIN(cond, bar) do { unsigned _sp = 0; while (cond) { __builtin_amdgcn_s_sleep(1); \
    if ((++_sp & 255u) == 0u) { if (xb_ld(&(bar)[XB_TMO])) break; if (_sp > XB_SPIN_CAP) { atomicAdd(&(bar)[XB_TMO], 1u); break; } } } } while (0)

struct XcdBarrier {
    unsigned* bar; unsigned x;
    volatile LAS unsigned* st;
};

__device__ __forceinline__ XcdBarrier xcd_barrier_post(unsigned* bar, volatile LAS unsigned* st) {
    XcdBarrier b; b.bar = bar; b.x = xb_xcc_id(); b.st = st;
    if (threadIdx.x == 0) (void)xb_add(&bar[XB_XCNT(b.x)], 1u);
    return b;
}
__device__ __forceinline__ void xcd_barrier_complete(unsigned* bar, unsigned x, unsigned& nloc, unsigned& nx) {
    const unsigned G = gridDim.x * gridDim.y * gridDim.z;
    unsigned sum, cnt, mine, sp = 0u;
    for (;;) {
        sum = 0u; cnt = 0u; mine = 0u;
#pragma unroll
        for (unsigned j = 0; j < 16; ++j) { const unsigned c = xb_ld(&bar[XB_XCNT(j)]); sum += c; cnt += (c > 0u) ? 1u : 0u; mine = (j == x) ? c : mine; }
        if (sum == G) break;
        __builtin_amdgcn_s_sleep(1);
        if ((++sp & 255u) == 0u) { if (xb_ld(&bar[XB_TMO])) break; if (sp > XB_SPIN_CAP) { atomicAdd(&bar[XB_TMO], 1u); break; } }
    }
    nloc = mine > 0u ? mine : 1u; nx = cnt > 0u ? cnt : 1u;
}

__device__ __forceinline__ void xcd_barrier(const XcdBarrier& b) {
    asm volatile("s_waitcnt vmcnt(0)" ::: "memory");
    __syncthreads();
    if (threadIdx.x == 0) {
        unsigned* bar = b.bar;
        __builtin_amdgcn_s_waitcnt(0);
        unsigned nloc = b.st[0], nx = b.st[1];
        if (nloc == 0u) { xcd_barrier_complete(bar, b.x, nloc, nx); b.st[0] = nloc; b.st[1] = nx; }
        const unsigned old = xb_add(&bar[XB_XSUB(b.x)], 1u);
        const unsigned gen = old / nloc;
        if (old + 1u == (gen + 1u) * nloc) {
            __builtin_amdgcn_fence(__ATOMIC_RELEASE, "agent");
            asm volatile("s_waitcnt vmcnt(0)" ::: "memory");
            const unsigned og = xb_add(&bar[XB_TOP], 1u);
            const unsigned tg = og / nx;
            if (og + 1u == (tg + 1u) * nx) xb_add(&bar[XB_TOPGEN], 1u);
            else XB_SPIN(xb_ld(&bar[XB_TOPGEN]) == tg, bar);
            __builtin_amdgcn_fence(__ATOMIC_ACQUIRE, "agent");
            xb_add(&bar[XB_XGEN(b.x)], 1u);
            asm volatile("s_waitcnt vmcnt(0)" ::: "memory");
        } else {
            XB_SPIN(xb_ld(&bar[XB_XGEN(b.x)]) == gen, bar);
            __builtin_amdgcn_fence(__ATOMIC_ACQUIRE, "agent");
            asm volatile("s_waitcnt vmcnt(0)" ::: "memory");
        }
    }
    __syncthreads();
}

__global__ void __launch_bounds__(512, 2) fwd_megakernel(Params p) {
    extern __shared__ __attribute__((aligned(16))) unsigned char lds_raw[];
    LAS unsigned char* lds = (LAS unsigned char*)lds_raw;
    cg::grid_group grid = cg::this_grid();
    unsigned char* ws = p.ws;
    const float* MOD = (const float*)(ws + WS_MOD);
    bf16_t* H = (bf16_t*)(ws + WS_H); bf16_t* QKV = (bf16_t*)(ws + WS_QKV); bf16_t* ATT = (bf16_t*)(ws + WS_ATT); bf16_t* XA = (bf16_t*)(ws + WS_XA);   bf16_t* ACT = (bf16_t*)(ws + WS_ACT);
    bf16_t* QH = (bf16_t*)(ws + WS_QH); bf16_t* LOGF = (bf16_t*)(ws + WS_LOGF); bf16_t* VH = (bf16_t*)(ws + WS_VH); bf16_t* GH = (bf16_t*)(ws + WS_GH); bf16_t* US = (bf16_t*)(ws + WS_US); bf16_t* SS = (bf16_t*)(ws + WS_SS); float* DEC = (float*)(ws + WS_DEC);
    const int G = gridDim.x, bx = blockIdx.x;

    if (threadIdx.x < 16) ((LAS unsigned*)(lds + MISC_OFF))[threadIdx.x] = 0u;
    __syncthreads();
    const XcdBarrier bar = xcd_barrier_post((unsigned*)(ws + WS_BAR), (volatile LAS unsigned*)(lds + MISC_OFF));
#define CG_SYNC() do { asm volatile("s_waitcnt vmcnt(0) lgkmcnt(0)" ::: "memory"); grid.sync(); __builtin_amdgcn_fence(__ATOMIC_ACQUIRE, "agent"); asm volatile("s_waitcnt vmcnt(0)" ::: "memory"); __syncthreads(); } while (0)
#define GRID_SYNC() xcd_barrier(bar)
    prologue_phase(lds, p);
    {
        __syncthreads();
        if (threadIdx.x == 0) { unsigned* cnt = (unsigned*)(ws + WS_BAR) + MODCNT_WORD; unsigned sp = 0;
            while (__hip_atomic_load(cnt, __ATOMIC_RELAXED, __HIP_MEMORY_SCOPE_AGENT) < (unsigned)G) { __builtin_amdgcn_s_sleep(2); if (++sp > (1u << 22)) break; }
            __builtin_amdgcn_fence(__ATOMIC_ACQUIRE, "agent"); asm volatile("s_waitcnt vmcnt(0)" ::: "memory"); }
        __syncthreads();
    }
    norm_phase(lds, p.x, p.norm_mix, MOD, MOD + D, H);
    if (p.ws == nullptr) CG_SYNC();
    GRID_SYNC();
#define GEMM_PHASE(EpiT, Aptr, WToff, Nn, Kk, ...) do { pg8::Gemm g{Aptr, (const bf16_t*)(ws + (WToff)), T, Nn, Kk}; pg8::StaticOrder S; S.init(T, Nn, G, bx); \
        EpiT E{__VA_ARGS__}; pg8::gemm_phase<EpiT, pg8::StaticOrder, true, true>(lds, g, S, E); } while (0)
    float* BIAS = (float*)(ws + WS_BIAS); float* PART = (float*)(ws + WS_PART); LAS float* RS = (LAS float*)(lds + RS_OFF);
    GEMM_PHASE(pg8::EpiStore<0>, H, WS_WT_AIN, NQKV, D, QKV, NQKV);
    {
        const int busy2 = (T / 256) * (NQKV / 256) - G; const bool split = busy2 > 0 && busy2 < G;
        if (!split || bx >= busy2) {
            const int wv = (split ? bx - busy2 : bx) * 8 + (pg8::opaque_tid() >> 6), nw = (split ? G - busy2 : G) * 8;
            bias_gemv(MOD + 3 * D, (const bf16_t*)(ws + WS_WT_W1), BIAS, DFF, wv, nw);
            bias_gemv(MOD + 12288, (const bf16_t*)(ws + WS_WT_HIN), BIAS + DFF, DFF, wv, nw);
            bias_gemv(MOD + 12288 + 3 * D, (const bf16_t*)(ws + WS_WT_W1 + 32 * MiB), BIAS + 2 * DFF, DFF, wv, nw);
        }
    }
    GRID_SYNC();
    attn_phase(lds, QKV, p.attn_q_gain, p.attn_k_gain, p.attn_sinks, ATT);
    GRID_SYNC();
    GEMM_PHASE(pg8::EpiResidN<false>, ATT, WS_WT_AOUT, D, D, p.x, XA, MOD + 2 * D, D, p.norm_mlp, MOD + 4 * D, H, PART);
    GRID_SYNC();
#define GEMM_PHASE_N(EpiT, Aptr, WToff, ...) do { pg8::Gemm g{Aptr, (const bf16_t*)(ws + (WToff)), T, DFF, D}; pg8::StaticOrder S; S.init(T, DFF, G, bx); rstd_prepare(RS, PART, S); \
        EpiT E{__VA_ARGS__}; pg8::gemm_phase<EpiT, pg8::StaticOrder, true, true>(lds, g, S, E); } while (0)
    GEMM_PHASE_N(pg8::EpiStoreN<2>, H, WS_WT_W1, ACT, DFF, BIAS, RS, 0);
    GRID_SYNC();
    GEMM_PHASE(pg8::EpiResidN<true>, ACT, WS_WT_W2, D, DFF, XA, XA, MOD + 5 * D, D, p.norm_mix + D, MOD + 12288 + D, H, PART);
    GRID_SYNC();
    GEMM_PHASE_N(pg8::EpiHgrn, H, WS_WT_HIN, QH, LOGF, VH, GH, (const float*)(ws + WS_LB), 0.08838834764831845f, BIAS + DFF, RS, 0);
    GRID_SYNC();
    hgrn_h1(lds, LOGF, VH, US, DEC);
    GRID_SYNC();
    hgrn_h2(US, SS, DEC);
    GRID_SYNC();
    hgrn_h3(lds, LOGF, QH, VH, GH, SS, p.hgrn_o_gain, ATT);
    GRID_SYNC();
    GEMM_PHASE(pg8::EpiResidN<true>, ATT, WS_WT_HOUT, D, D, XA, XA, MOD + 12288 + 2 * D, D, p.norm_mlp + D, MOD + 12288 + 4 * D, H, PART);
    GRID_SYNC();
    GEMM_PHASE_N(pg8::EpiStoreN<2>, H, WS_WT_W1 + 32 * MiB, ACT, DFF, BIAS + 2 * DFF, RS, 0);
    GRID_SYNC();
    GEMM_PHASE(pg8::EpiResidF, ACT, WS_WT_W2 + 32 * MiB, D, DFF, XA, p.out, MOD + 12288 + 5 * D, D);
}

extern "C" void kernel_launch(void* const* d_in, const int* in_sizes, int n_in, void* d_out, int out_size, void* d_ws, size_t ws_size, hipStream_t stream) {
    static int grid = 0;
    if (grid == 0) {
        if (n_in != 17 || out_size != T * D || ws_size < WS_END) { fprintf(stderr, "kernel_launch: unexpected shapes (n_in %d out %d ws %zu, need %zu)\n", n_in, out_size, ws_size, (size_t)WS_END); grid = -1; return; }
        int dev = 0, cus = 0, per_cu = 0;
        (void)hipGetDevice(&dev);
        (void)hipDeviceGetAttribute(&cus, hipDeviceAttributeMultiprocessorCount, dev);
        (void)hipFuncSetAttribute((const void*)fwd_megakernel, hipFuncAttributeMaxDynamicSharedMemorySize, LDS_BYTES);
        (void)hipOccupancyMaxActiveBlocksPerMultiprocessor(&per_cu, (const void*)fwd_megakernel, 512, LDS_BYTES);
        if (per_cu < 1) { fprintf(stderr, "kernel_launch: occupancy query says %d blocks per CU\n", per_cu); per_cu = 1; }
        grid = cus * per_cu;
        if (grid != 256) { fprintf(stderr, "kernel_launch: built for a 256-workgroup grid (got %d)\n", grid); grid = -1; return; }
    }
    if (grid < 0) return;
    Params p{};
    p.x = (const float*)d_in[0]; p.c = (const float*)d_in[1]; p.mod_w = (const float*)d_in[2]; p.mod_b = (const float*)d_in[3];
    p.norm_mix = (const float*)d_in[4]; p.norm_mlp = (const float*)d_in[5]; p.attn_w_in = (const float*)d_in[6]; p.attn_w_out = (const float*)d_in[7];
    p.attn_q_gain = (const float*)d_in[8]; p.attn_k_gain = (const float*)d_in[9]; p.attn_sinks = (const float*)d_in[10];
    p.hgrn_w_in = (const float*)d_in[11]; p.hgrn_w_out = (const float*)d_in[12]; p.hgrn_o_gain = (const float*)d_in[13]; p.hgrn_lb_logits = (const float*)d_in[14];
    p.mlp_w1 = (const float*)d_in[15]; p.mlp_w2 = (const float*)d_in[16];
    p.out = (float*)d_out; p.ws = (unsigned char*)d_ws;
    (void)hipMemsetAsync((char*)d_ws + WS_BAR, 0, BAR_BYTES, stream);
    void* args[] = {&p};
    hipError_t e = hipLaunchCooperativeKernel((const void*)fwd_megakernel, dim3(grid), dim3(512), args, LDS_BYTES, stream);
    if (e != hipSuccess) fprintf(stderr, "kernel_launch: cooperative launch failed: %s (grid %d)\n", hipGetErrorString(e), grid);
}
```

```cpp
#include <hip/hip_runtime.h>
#include <hip/hip_cooperative_groups.h>
#include <cstdio>
#include <cstdint>
#include <cmath>
namespace pg8 {
#define PG8_LAS __attribute__((address_space(3)))
typedef unsigned short bf16_t;
typedef short bf16x8 __attribute__((ext_vector_type(8)));
typedef float f32x4 __attribute__((ext_vector_type(4)));
typedef unsigned u32x4 __attribute__((ext_vector_type(4)));
constexpr int BM = 256, BK = 64, HALF = 128, HTB = HALF * BK * 2  , STAGE_BYTES = 8 * HTB, NXCD = 8, WGM = 8;

__host__ __device__ __forceinline__ int lds_byte(int r, int c) { const int st = (r >> 4) * 2 + (c >> 5), rr = r & 15, cc = c & 31, ob = rr * 64 + cc * 2; return st * 1024 + (ob ^ (((ob >> 9) & 1) << 5)); }
__host__ __device__ __forceinline__ void stage_rc(int b, int& R, int& C) { const int st = b / 1024, sb = b % 1024, swz = sb ^ (((sb >> 9) & 1) << 5); R = (st >> 1) * 16 + swz / 64; C = (st & 1) * 32 + (swz % 64) / 2; }
__host__ __device__ __forceinline__ int perm32(int rho) { const int n = rho >> 4, i = rho & 15; return 8 * (i >> 2) + 4 * n + (i & 3); }

struct Unit { int pm, pn; };
struct Gemm { const bf16_t* A; const bf16_t* Bt; int M, N, K; };

struct StaticOrder {
    int nM, nN, nwg, G, c;
    __host__ __device__ void init(int M, int N, int G_, int c_) { nM = M / BM; nN = N / BM; nwg = nM * nN; G = G_; c = c_; }
    __host__ __device__ bool next(int i, Unit& u) const {
        const long L = (long)i * G + c; if (L >= nwg) return false;
        int wgid = (int)L; { const int q = nwg / NXCD, r = nwg % NXCD, xcd = wgid % NXCD, off = wgid / NXCD; wgid = (xcd < r ? xcd * (q + 1) : r * (q + 1) + (xcd - r) * q) + off; }
        const int nig = WGM * nN, gid = wgid / nig, fm = gid * WGM, gsz = (nM - fm) < WGM ? (nM - fm) : WGM;
        u.pm = fm + ((wgid % nig) % gsz); u.pn = (wgid % nig) / gsz; return true;
    }
    __device__ __forceinline__ void a_ready(const Unit&) const {}
    __device__ __forceinline__ void done(const Unit&) const {}
};

typedef __bf16 bf16x2_t __attribute__((ext_vector_type(2)));
typedef float f32x2 __attribute__((ext_vector_type(2)));
__device__ __forceinline__ unsigned cvt_pk_bf16(float lo, float hi) { const f32x2 v = {lo, hi}; const bf16x2_t b = __builtin_convertvector(v, bf16x2_t); return __builtin_bit_cast(unsigned, b); }
__device__ __forceinline__ int opaque_tid() { int t = threadIdx.x; asm volatile("" : "+v"(t)); return t; }
typedef unsigned u32x2 __attribute__((ext_vector_type(2)));
__device__ __forceinline__ float fast_rcp(float x) { return __builtin_amdgcn_rcpf(x); }
__device__ __forceinline__ float silu_f(float x) { return x * fast_rcp(1.0f + __expf(-x)); }
template <int ACT> struct EpiStore {
    static constexpr bool PERM = true, AFTER_DRAIN = false;
    bf16_t* O; int ldc;
    __device__ __forceinline__ void operator()(const f32x4 (&acc)[2][2][4][2], const Unit& u, int wr, int wc, int fr, int fq) const {
        const int row0 = u.pm * BM + wr * 64 + fr, col0 = u.pn * BM + wc * 32 + 8 * fq;
#pragma unroll
        for (int ai = 0; ai < 2; ++ai)
#pragma unroll
            for (int m = 0; m < 4; ++m) { bf16_t* rowp = O + (size_t)(row0 + ai * HALF + m * 16) * ldc + col0;
#pragma unroll
                for (int bj = 0; bj < 2; ++bj) { f32x4 v0 = acc[ai][bj][m][0], v1 = acc[ai][bj][m][1];
                    if (ACT == 2) {
#pragma unroll
                        for (int e = 0; e < 4; ++e) { const float a = fmaxf(v0[e], 0.f), b = fmaxf(v1[e], 0.f); v0[e] = a * a; v1[e] = b * b; } }
                    u32x4 w; w.x = cvt_pk_bf16(v0[0], v0[1]); w.y = cvt_pk_bf16(v0[2], v0[3]); w.z = cvt_pk_bf16(v1[0], v1[1]); w.w = cvt_pk_bf16(v1[2], v1[3]);
                    *(u32x4*)(rowp + bj * HALF) = w; } }
    }
};
struct EpiResid {
    static constexpr bool PERM = false, AFTER_DRAIN = false;
    const float* base; float* out; const float* gate; int ldc;
    __device__ __forceinline__ void operator()(const f32x4 (&acc)[2][2][4][2], const Unit& u, int wr, int wc, int fr, int fq) const {
        const int col0 = u.pn * BM + wc * 32 + 4 * fq;
        f32x4 gv[2][2];
#pragma unroll
        for (int bj = 0; bj < 2; ++bj)
#pragma unroll
            for (int n = 0; n < 2; ++n) gv[bj][n] = *(const f32x4*)(gate + col0 + bj * HALF + n * 16);
#pragma unroll
        for (int ai = 0; ai < 2; ++ai)
#pragma unroll
            for (int m = 0; m < 4; ++m) { const size_t off = (size_t)(u.pm * BM + ai * HALF + wr * 64 + m * 16 + fr) * ldc + col0;
#pragma unroll
                for (int bj = 0; bj < 2; ++bj)
#pragma unroll
                    for (int n = 0; n < 2; ++n) { const f32x4 b = *(const f32x4*)(base + off + bj * HALF + n * 16);
                        *(f32x4*)(out + off + bj * HALF + n * 16) = b + gv[bj][n] * acc[ai][bj][m][n]; } }
    }
};
struct EpiHgrn {
    static constexpr bool PERM = true, AFTER_DRAIN = false;
    bf16_t* Qh; bf16_t* LOGF; bf16_t* Vh; bf16_t* Gh; const float* lb; float qscale; const float* bias; const PG8_LAS float* rs; mutable int slot;
    __device__ __forceinline__ void operator()(const f32x4 (&acc)[2][2][4][2], const Unit& u, int wr, int wc, int fr, int fq) const {
        const int type = u.pn >> 3;
        const int row0 = u.pm * BM + wr * 64 + fr, col0 = (u.pn & 7) * BM + wc * 32 + 8 * fq, bcol0 = u.pn * BM + wc * 32 + 8 * fq;
        const PG8_LAS float* rsu = rs + slot * 256 + wr * 64 + fr; ++slot;
        f32x4 bv[2][2];
#pragma unroll
        for (int bj = 0; bj < 2; ++bj) { bv[bj][0] = *(const f32x4*)(bias + bcol0 + bj * HALF); bv[bj][1] = *(const f32x4*)(bias + bcol0 + bj * HALF + 4); }
#pragma unroll
        for (int ai = 0; ai < 2; ++ai)
#pragma unroll
            for (int m = 0; m < 4; ++m) { const size_t roff = (size_t)(row0 + ai * HALF + m * 16) * 2048 + col0; const float rstd = rsu[ai * HALF + m * 16];
#pragma unroll
                for (int bj = 0; bj < 2; ++bj) {
                    f32x4 v0 = acc[ai][bj][m][0] * rstd + bv[bj][0], v1 = acc[ai][bj][m][1] * rstd + bv[bj][1];
                    if (type == 1) {
                        const f32x4 l0 = *(const f32x4*)(lb + col0 + bj * HALF), l1 = *(const f32x4*)(lb + col0 + bj * HALF + 4);
#pragma unroll
                        for (int e = 0; e < 4; ++e) {
                            const float s0 = fast_rcp(1.0f + __expf(-v0[e])), s1 = fast_rcp(1.0f + __expf(-v1[e]));
                            v0[e] = __logf(l0[e] + (1.0f - l0[e]) * s0); v1[e] = __logf(l1[e] + (1.0f - l1[e]) * s1); }
                        u32x4 w; w.x = cvt_pk_bf16(v0[0], v0[1]); w.y = cvt_pk_bf16(v0[2], v0[3]); w.z = cvt_pk_bf16(v1[0], v1[1]); w.w = cvt_pk_bf16(v1[2], v1[3]);
                        *(u32x4*)(LOGF + roff + bj * HALF) = w;
                    } else {
                        if (type == 0) {
#pragma unroll
                            for (int e = 0; e < 4; ++e) { v0[e] = silu_f(v0[e]) * qscale; v1[e] = silu_f(v1[e]) * qscale; }
                        } else if (type == 3) {
#pragma unroll
                            for (int e = 0; e < 4; ++e) { v0[e] = silu_f(v0[e]); v1[e] = silu_f(v1[e]); }
                        }
                        u32x4 w; w.x = cvt_pk_bf16(v0[0], v0[1]); w.y = cvt_pk_bf16(v0[2], v0[3]); w.z = cvt_pk_bf16(v1[0], v1[1]); w.w = cvt_pk_bf16(v1[2], v1[3]);
                        if (type == 0) *(u32x4*)(Qh + roff + bj * HALF) = w;
                        else if (type == 2) *(u32x4*)(Vh + roff + bj * HALF) = w;
                        else *(u32x4*)(Gh + roff + bj * HALF) = w;
                    } } }
    }
};

template <bool BASE_BF16> struct EpiResidN {
    static constexpr bool PERM = true, AFTER_DRAIN = false;
    const void* base; bf16_t* out; const float* gate; int ldc; const float* ngain; const float* nscale; bf16_t* An; float* part;
    __device__ __forceinline__ void operator()(const f32x4 (&acc)[2][2][4][2], const Unit& u, int wr, int wc, int fr, int fq) const {
        const int col0 = u.pn * BM + wc * 32 + 8 * fq;
        f32x4 gv[2][2], wv[2][2];
#pragma unroll
        for (int bj = 0; bj < 2; ++bj)
#pragma unroll
            for (int n = 0; n < 2; ++n) { gv[bj][n] = *(const f32x4*)(gate + col0 + bj * HALF + n * 4);
                const f32x4 g = *(const f32x4*)(ngain + col0 + bj * HALF + n * 4), s = *(const f32x4*)(nscale + col0 + bj * HALF + n * 4); wv[bj][n] = g * (s + 1.0f); }
#pragma unroll
        for (int ai = 0; ai < 2; ++ai)
#pragma unroll
            for (int m = 0; m < 4; ++m) { const int row = u.pm * BM + ai * HALF + wr * 64 + m * 16 + fr; const size_t off = (size_t)row * ldc + col0; float ss = 0.f;
#pragma unroll
                for (int bj = 0; bj < 2; ++bj) { f32x4 b0, b1;
                    if (BASE_BF16) { const u32x4 bb = *(const u32x4*)((const bf16_t*)base + off + bj * HALF);
                        b0 = (f32x4){__uint_as_float(bb.x << 16), __uint_as_float(bb.x & 0xffff0000u), __uint_as_float(bb.y << 16), __uint_as_float(bb.y & 0xffff0000u)};
                        b1 = (f32x4){__uint_as_float(bb.z << 16), __uint_as_float(bb.z & 0xffff0000u), __uint_as_float(bb.w << 16), __uint_as_float(bb.w & 0xffff0000u)}; }
                    else { b0 = *(const f32x4*)((const float*)base + off + bj * HALF); b1 = *(const f32x4*)((const float*)base + off + bj * HALF + 4); }
                    const f32x4 o0 = b0 + gv[bj][0] * acc[ai][bj][m][0], o1 = b1 + gv[bj][1] * acc[ai][bj][m][1];
                    u32x4 ob; ob.x = cvt_pk_bf16(o0[0], o0[1]); ob.y = cvt_pk_bf16(o0[2], o0[3]); ob.z = cvt_pk_bf16(o1[0], o1[1]); ob.w = cvt_pk_bf16(o1[2], o1[3]);
                    *(u32x4*)(out + off + bj * HALF) = ob;
                    ss += ((o0[0] * o0[0] + o0[1] * o0[1]) + (o0[2] * o0[2] + o0[3] * o0[3])) + ((o1[0] * o1[0] + o1[1] * o1[1]) + (o1[2] * o1[2] + o1[3] * o1[3]));
                    const f32x4 y0 = o0 * wv[bj][0], y1 = o1 * wv[bj][1];
                    u32x4 w; w.x = cvt_pk_bf16(y0[0], y0[1]); w.y = cvt_pk_bf16(y0[2], y0[3]); w.z = cvt_pk_bf16(y1[0], y1[1]); w.w = cvt_pk_bf16(y1[2], y1[3]);
                    *(u32x4*)(An + off + bj * HALF) = w; }
                ss += __shfl_xor(ss, 16); ss += __shfl_xor(ss, 32);
                if (fq == 0) part[(size_t)row * 32 + u.pn * 4 + wc] = ss; }
    }
};
struct EpiResidF {
    static constexpr bool PERM = true, AFTER_DRAIN = false;
    const bf16_t* base; float* out; const float* gate; int ldc;
    __device__ __forceinline__ void operator()(const f32x4 (&acc)[2][2][4][2], const Unit& u, int wr, int wc, int fr, int fq) const {
        const int col0 = u.pn * BM + wc * 32 + 8 * fq;
        f32x4 gv[2][2];
#pragma unroll
        for (int bj = 0; bj < 2; ++bj)
#pragma unroll
            for (int n = 0; n < 2; ++n) gv[bj][n] = *(const f32x4*)(gate + col0 + bj * HALF + n * 4);
#pragma unroll
        for (int ai = 0; ai < 2; ++ai)
#pragma unroll
            for (int m = 0; m < 4; ++m) { const size_t off = (size_t)(u.pm * BM + ai * HALF + wr * 64 + m * 16 + fr) * ldc + col0;
#pragma unroll
                for (int bj = 0; bj < 2; ++bj) { const u32x4 bb = *(const u32x4*)(base + off + bj * HALF);
                    const f32x4 b0 = {__uint_as_float(bb.x << 16), __uint_as_float(bb.x & 0xffff0000u), __uint_as_float(bb.y << 16), __uint_as_float(bb.y & 0xffff0000u)};
                    const f32x4 b1 = {__uint_as_float(bb.z << 16), __uint_as_float(bb.z & 0xffff0000u), __uint_as_float(bb.w << 16), __uint_as_float(bb.w & 0xffff0000u)};
                    *(f32x4*)(out + off + bj * HALF) = b0 + gv[bj][0] * acc[ai][bj][m][0]; *(f32x4*)(out + off + bj * HALF + 4) = b1 + gv[bj][1] * acc[ai][bj][m][1]; } }
    }
};
template <int ACT> struct EpiStoreN {
    static constexpr bool PERM = true, AFTER_DRAIN = false;
    bf16_t* O; int ldc; const float* bias; const PG8_LAS float* rs; mutable int slot;
    __device__ __forceinline__ void operator()(const f32x4 (&acc)[2][2][4][2], const Unit& u, int wr, int wc, int fr, int fq) const {
        const int row0 = u.pm * BM + wr * 64 + fr, col0 = u.pn * BM + wc * 32 + 8 * fq;
        const PG8_LAS float* rsu = rs + slot * 256 + wr * 64 + fr; ++slot;
        f32x4 bv[2][2];
#pragma unroll
        for (int bj = 0; bj < 2; ++bj) { bv[bj][0] = *(const f32x4*)(bias + col0 + bj * HALF); bv[bj][1] = *(const f32x4*)(bias + col0 + bj * HALF + 4); }
#pragma unroll
        for (int ai = 0; ai < 2; ++ai)
#pragma unroll
            for (int m = 0; m < 4; ++m) { bf16_t* rowp = O + (size_t)(row0 + ai * HALF + m * 16) * ldc + col0; const float rstd = rsu[ai * HALF + m * 16];
#pragma unroll
                for (int bj = 0; bj < 2; ++bj) {
                    f32x4 v0 = acc[ai][bj][m][0] * rstd + bv[bj][0], v1 = acc[ai][bj][m][1] * rstd + bv[bj][1];
                    if (ACT == 2) {
#pragma unroll
                        for (int e = 0; e < 4; ++e) { const float a = fmaxf(v0[e], 0.f), b = fmaxf(v1[e], 0.f); v0[e] = a * a; v1[e] = b * b; } }
                    u32x4 w; w.x = cvt_pk_bf16(v0[0], v0[1]); w.y = cvt_pk_bf16(v0[2], v0[3]); w.z = cvt_pk_bf16(v1[0], v1[1]); w.w = cvt_pk_bf16(v1[2], v1[3]);
                    *(u32x4*)(rowp + bj * HALF) = w; } }
    }
};
template <class Epi, class Sched, bool ALIGN_EPI = false, bool SP2 = false>
__device__ __forceinline__ void gemm_phase(PG8_LAS unsigned char* lds, const Gemm g, const Sched& S, const Epi& E) {
    const int tid = opaque_tid(), wid = __builtin_amdgcn_readfirstlane(tid >> 6), lane = tid & 63, wr = wid >> 2, wc = wid & 3, fr = lane & 15, fq = lane >> 4;
    const int K = g.K, nt = K / BK;
    unsigned voffA[2], voffB[2];
#pragma unroll
    for (int i = 0; i < 2; ++i) { int R, C; stage_rc(tid * 16 + i * 8192, R, C); const int Rb = Epi::PERM ? ((R & ~31) + perm32(R & 31)) : R;
        voffA[i] = (unsigned)(R * K + C) * 2u; voffB[i] = (unsigned)(Rb * K + C) * 2u; }
    const size_t kstep = (size_t)(BK * 2);
    const size_t hstep = (size_t)HALF * K * 2;
    const size_t tstep = 2 * hstep;
    const unsigned ldsw = (unsigned)wid * 1024u;
    const int aoff = lds_byte(wr * 64 + fr, fq * 8), boff = lds_byte(wc * 32 + fr, fq * 8);
#define PG8_SA(b, h) (((b) * 2 + (h)) * HTB)
#define PG8_SB(b, h) ((4 + (b) * 2 + (h)) * HTB)
#define PG8_STAGE(bufoff, gbase, voff) do { _Pragma("unroll") for (int _i = 0; _i < 2; ++_i) \
        __builtin_amdgcn_global_load_lds((const unsigned*)((const char*)(gbase) + (voff)[_i]), (PG8_LAS unsigned*)(lds + (bufoff) + ldsw + _i * 8192), 16, 0, 0); } while (0)
#define PG8_LDA(dst, b, h) do { _Pragma("unroll") for (int m = 0; m < 4; ++m) _Pragma("unroll") for (int k = 0; k < 2; ++k) dst[m][k] = *(const PG8_LAS bf16x8*)(lds + PG8_SA(b, h) + aoff + m * 2048 + k * 1024); } while (0)
#define PG8_LDB(dst, b, h) do { _Pragma("unroll") for (int n = 0; n < 2; ++n) _Pragma("unroll") for (int k = 0; k < 2; ++k) dst[n][k] = *(const PG8_LAS bf16x8*)(lds + PG8_SB(b, h) + boff + n * 2048 + k * 1024); } while (0)
#define PG8_MMA(ai, bj, At, Bt) do { __builtin_amdgcn_s_setprio(1); _Pragma("unroll") for (int m = 0; m < 4; ++m) _Pragma("unroll") for (int n = 0; n < 2; ++n) _Pragma("unroll") for (int k = 0; k < 2; ++k) \
        acc[ai][bj][m][n] = __builtin_amdgcn_mfma_f32_16x16x32_bf16(Bt[n][k], At[m][k], acc[ai][bj][m][n], 0, 0, 0); __builtin_amdgcn_s_setprio(0); } while (0)
#define PG8_WAIT_V(n) asm volatile("s_waitcnt vmcnt(" #n ")" ::: "memory")
#define PG8_WAIT_L(n) asm volatile("s_waitcnt lgkmcnt(" #n ")" ::: "memory")
#define PG8_BAR __builtin_amdgcn_s_barrier()
#define PG8_SCHED __builtin_amdgcn_sched_barrier(0)
    Unit cur, nxt; int ui = 0;
    if (!S.next(0, cur)) return;
    f32x4 acc[2][2][4][2];
#pragma unroll
    for (int a = 0; a < 2; ++a)
#pragma unroll
        for (int b = 0; b < 2; ++b)
#pragma unroll
            for (int m = 0; m < 4; ++m)
#pragma unroll
                for (int n = 0; n < 2; ++n) acc[a][b][m][n] = (f32x4){0.f, 0.f, 0.f, 0.f};
    bf16x8 At[4][2], B0[2][2], B1[2][2];
    const char* cA = (const char*)g.A + (size_t)cur.pm * tstep; const char* cB = (const char*)g.Bt + (size_t)cur.pn * tstep;
    S.a_ready(cur);
    if constexpr (SP2) {
        PG8_STAGE(PG8_SB(0, 0), cB, voffB); PG8_STAGE(PG8_SB(0, 1), cB + hstep, voffB); PG8_STAGE(PG8_SA(0, 0), cA, voffA); PG8_STAGE(PG8_SA(0, 1), cA + hstep, voffA);
        if (wr == 1) PG8_BAR;
        PG8_WAIT_V(2); PG8_BAR;
        PG8_STAGE(PG8_SB(1, 0), cB + kstep, voffB); PG8_STAGE(PG8_SA(1, 0), cA + kstep, voffA); PG8_STAGE(PG8_SB(1, 1), cB + hstep + kstep, voffB);
        PG8_WAIT_V(6); PG8_BAR;
    } else {
        PG8_STAGE(PG8_SB(0, 0), cB, voffB); PG8_STAGE(PG8_SA(0, 0), cA, voffA); PG8_STAGE(PG8_SB(0, 1), cB + hstep, voffB); PG8_STAGE(PG8_SA(0, 1), cA + hstep, voffA);
        if (wr == 1) PG8_BAR;
        PG8_WAIT_V(4); PG8_BAR;
        PG8_STAGE(PG8_SB(1, 0), cB + kstep, voffB); PG8_STAGE(PG8_SA(1, 0), cA + kstep, voffA); PG8_STAGE(PG8_SB(1, 1), cB + hstep + kstep, voffB);
        PG8_WAIT_V(6); PG8_BAR;
    }
    for (;;) {
        const bool has_next = S.next(ui + 1, nxt);
        const char* nA = has_next ? (const char*)g.A + (size_t)nxt.pm * tstep : cA; const char* nB = has_next ? (const char*)g.Bt + (size_t)nxt.pn * tstep : cB;
        for (int t = 0; t < nt; t += 2) {
            const bool last = (t == nt - 2);
            const char* a1 = cA + (size_t)(t + 1) * kstep;
            const char* a2 = last ? nA : cA + (size_t)(t + 2) * kstep; const char* b2 = last ? nB : cB + (size_t)(t + 2) * kstep;
            const char* a3 = a2 + kstep; const char* b3 = b2 + kstep;
            if (last && has_next) S.a_ready(nxt);
            if constexpr (SP2) {
            PG8_LDB(B0, 0, 0); PG8_LDB(B1, 0, 1); PG8_SCHED; PG8_LDA(At, 0, 0); PG8_STAGE(PG8_SA(1, 1), a1 + hstep, voffA);
            PG8_WAIT_V(8); PG8_WAIT_L(0); PG8_BAR; PG8_MMA(0, 0, At, B0); PG8_MMA(0, 1, At, B1); PG8_BAR; PG8_SCHED;
            PG8_LDA(At, 0, 1); PG8_STAGE(PG8_SB(0, 0), b2, voffB); PG8_STAGE(PG8_SB(0, 1), b2 + hstep, voffB); PG8_STAGE(PG8_SA(0, 0), a2, voffA);
            PG8_WAIT_V(8); PG8_WAIT_L(0); PG8_BAR; PG8_MMA(1, 0, At, B0); PG8_MMA(1, 1, At, B1); PG8_BAR; PG8_SCHED;
            PG8_LDB(B0, 1, 0); PG8_LDB(B1, 1, 1); PG8_SCHED; PG8_LDA(At, 1, 0); PG8_STAGE(PG8_SA(0, 1), a2 + hstep, voffA);
            PG8_WAIT_V(8); PG8_WAIT_L(0); PG8_BAR; PG8_MMA(0, 0, At, B0); PG8_MMA(0, 1, At, B1); PG8_BAR; PG8_SCHED;
            PG8_LDA(At, 1, 1); PG8_STAGE(PG8_SB(1, 0), b3, voffB); PG8_STAGE(PG8_SB(1, 1), b3 + hstep, voffB); PG8_STAGE(PG8_SA(1, 0), a3, voffA);
            PG8_WAIT_V(8); PG8_WAIT_L(0); PG8_BAR; PG8_MMA(1, 0, At, B0); PG8_MMA(1, 1, At, B1); PG8_BAR; PG8_SCHED;
            } else {
            PG8_LDB(B0, 0, 0); PG8_SCHED; PG8_LDA(At, 0, 0); PG8_STAGE(PG8_SA(1, 1), a1 + hstep, voffA);
            PG8_WAIT_L(8); PG8_BAR; PG8_WAIT_L(0); PG8_MMA(0, 0, At, B0); PG8_BAR; PG8_SCHED;
            PG8_LDB(B1, 0, 1); PG8_STAGE(PG8_SB(0, 0), b2, voffB);
            PG8_BAR; PG8_WAIT_L(0); PG8_MMA(0, 1, At, B1); PG8_BAR;
            PG8_LDA(At, 0, 1); PG8_STAGE(PG8_SA(0, 0), a2, voffA);
            PG8_BAR; PG8_WAIT_L(0); PG8_MMA(1, 0, At, B0); PG8_BAR; PG8_SCHED;
            PG8_STAGE(PG8_SB(0, 1), b2 + hstep, voffB);
            PG8_WAIT_V(6); PG8_BAR; PG8_MMA(1, 1, At, B1); PG8_BAR;
            PG8_LDB(B0, 1, 0); PG8_SCHED; PG8_LDA(At, 1, 0); PG8_STAGE(PG8_SA(0, 1), a2 + hstep, voffA);
            PG8_WAIT_L(8); PG8_BAR; PG8_WAIT_L(0); PG8_MMA(0, 0, At, B0); PG8_BAR; PG8_SCHED;
            PG8_LDB(B1, 1, 1); PG8_STAGE(PG8_SB(1, 0), b3, voffB);
            PG8_BAR; PG8_WAIT_L(0); PG8_MMA(0, 1, At, B1); PG8_BAR;
            PG8_LDA(At, 1, 1); PG8_STAGE(PG8_SA(1, 0), a3, voffA);
            PG8_BAR; PG8_WAIT_L(0); PG8_MMA(1, 0, At, B0); PG8_BAR; PG8_SCHED;
            PG8_STAGE(PG8_SB(1, 1), b3 + hstep, voffB);
            PG8_WAIT_V(6); PG8_BAR; PG8_MMA(1, 1, At, B1); PG8_BAR;
            }
        }
        if constexpr (ALIGN_EPI) { if (wr == 0) PG8_BAR; }
        if constexpr (!Epi::AFTER_DRAIN) { E(acc, cur, wr, wc, fr, fq); S.done(cur); }
        if (!has_next) break;
#pragma unroll
        for (int a = 0; a < 2; ++a)
#pragma unroll
            for (int b = 0; b < 2; ++b)
#pragma unroll
                for (int m = 0; m < 4; ++m)
#pragma unroll
                    for (int n = 0; n < 2; ++n) acc[a][b][m][n] = (f32x4){0.f, 0.f, 0.f, 0.f};
        cur = nxt; cA = nA; cB = nB; ++ui;
        if constexpr (ALIGN_EPI) { if (wr == 1) PG8_BAR; }
    }
    PG8_WAIT_V(0);
    if constexpr (!ALIGN_EPI) { if (wr == 0) PG8_BAR; }
    PG8_BAR;
    if constexpr (Epi::AFTER_DRAIN) { E.fused(acc, cur, wr, wc, fr, fq, lds, wid, lane); S.done(cur); }
#undef PG8_SA
#undef PG8_SB
#undef PG8_STAGE
#undef PG8_LDA
#undef PG8_LDB
#undef PG8_MMA
#undef PG8_WAIT_V
#undef PG8_WAIT_L
#undef PG8_BAR
#undef PG8_SCHED
}
}

namespace cg = cooperative_groups;
#define LAS __attribute__((address_space(3)))
typedef unsigned short bf16_t;
typedef short bf16x8 __attribute__((ext_vector_type(8)));
typedef float f32x4 __attribute__((ext_vector_type(4)));
typedef float f32x2 __attribute__((ext_vector_type(2)));
typedef unsigned u32x4 __attribute__((ext_vector_type(4)));
typedef unsigned u32x2 __attribute__((ext_vector_type(2)));
using pg8::cvt_pk_bf16;

constexpr int T = 8192, D = 2048, DFF = 8192, NQKV = 2560;
constexpr int LDS_BYTES = 147456;
constexpr float EPS = 1e-6f;
constexpr size_t MiB = 1u << 20;
constexpr size_t WS_MOD = 0;
constexpr size_t WS_LB = 128 * 1024;
constexpr size_t WS_BIAS = 512 * 1024;
constexpr size_t WS_PART = 1 * MiB;
constexpr int RS_OFF = 131072;
constexpr size_t WS_BAR = 256 * 1024, BAR_BYTES = 16384;
constexpr int MODCNT_WORD = 3600;
constexpr int MISC_OFF = LDS_BYTES - 64;
constexpr size_t WS_WT_AIN = 2 * MiB, WS_WT_AOUT = 12 * MiB, WS_WT_HIN = 20 * MiB, WS_WT_HOUT = 52 * MiB;
constexpr size_t WS_WT_W1 = 60 * MiB  , WS_WT_W2 = 124 * MiB  ;
constexpr size_t WS_H = 188 * MiB, WS_QKV = 220 * MiB, WS_ATT = 260 * MiB, WS_XA = 292 * MiB, WS_ACT = 356 * MiB;
constexpr size_t WS_QH = 484 * MiB, WS_LOGF = 516 * MiB, WS_VH = 580 * MiB, WS_GH = 220 * MiB, WS_US = 612 * MiB, WS_SS = 676 * MiB, WS_DEC = 740 * MiB, WS_END = 741 * MiB;

__device__ __forceinline__ float bflo(unsigned u) { return __uint_as_float(u << 16); }
__device__ __forceinline__ float bfhi(unsigned u) { return __uint_as_float(u & 0xffff0000u); }
__device__ __forceinline__ float bf2f(bf16_t u) { return __uint_as_float((unsigned)u << 16); }
__device__ __forceinline__ float wave_sum(float v) {
#pragma unroll
    for (int o = 1; o < 64; o <<= 1) v += __shfl_xor(v, o);
    return v;
}
__device__ __forceinline__ f32x4 mfma16(bf16x8 a, bf16x8 b, f32x4 c) { return __builtin_amdgcn_mfma_f32_16x16x32_bf16(a, b, c, 0, 0, 0); }
__device__ __forceinline__ bf16x8 as_bf16x8(u32x4 v) { return __builtin_bit_cast(bf16x8, v); }

struct Params {
    const float* x; const float* c; const float* mod_w; const float* mod_b; const float* norm_mix; const float* norm_mlp;
    const float* attn_w_in; const float* attn_w_out; const float* attn_q_gain; const float* attn_k_gain; const float* attn_sinks;
    const float* hgrn_w_in; const float* hgrn_w_out; const float* hgrn_o_gain; const float* hgrn_lb_logits; const float* mlp_w1; const float* mlp_w2;
    float* out; unsigned char* ws;
};

__device__ __forceinline__ void p0_transpose_item(const float* W, int K, int N, bf16_t* WT, LAS float* scr, int item, int lane) {
    const int nblk = N / 32, kb = item / nblk, nb = item % nblk, k0 = 64 * kb, n0 = 32 * nb;
#pragma unroll 8
    for (int i = 0; i < 32; ++i) { const int kk = 2 * i + (lane >> 5); scr[kk * 33 + (lane & 31)] = W[(size_t)(k0 + kk) * N + n0 + (lane & 31)]; }
    asm volatile("s_waitcnt lgkmcnt(0)" ::: "memory");
    const int c = lane & 7;
#pragma unroll
    for (int j = 0; j < 4; ++j) { const int n = (lane >> 3) + 8 * j; const LAS float* s = scr + (8 * c) * 33 + n;
        u32x4 o; o.x = cvt_pk_bf16(s[0 * 33], s[1 * 33]); o.y = cvt_pk_bf16(s[2 * 33], s[3 * 33]); o.z = cvt_pk_bf16(s[4 * 33], s[5 * 33]); o.w = cvt_pk_bf16(s[6 * 33], s[7 * 33]);
        *(u32x4*)(WT + (size_t)(n0 + n) * K + k0 + 8 * c) = o; }
    asm volatile("s_waitcnt lgkmcnt(0)" ::: "memory");
}

__device__ __forceinline__ void prologue_phase(LAS unsigned char* lds, const Params& p) {
    const int tid = pg8::opaque_tid(), lane = tid & 63, wave = tid >> 6;
    float* MOD = (float*)(p.ws + WS_MOD); float* LB = (float*)(p.ws + WS_LB);
    for (int i = blockIdx.x * 512 + tid; i < 2048; i += gridDim.x * 512) { const float l0 = p.hgrn_lb_logits[i], l1 = p.hgrn_lb_logits[2048 + i]; LB[i] = 1.0f / (1.0f + expf(l0 - l1)); }
    {
        LAS float* cond = (LAS float*)lds; LAS f32x4* red = (LAS f32x4*)(lds + 8192);
        for (int i = tid; i < 2048; i += 512) { const float c = p.c[i]; cond[i] = c / (1.0f + expf(-c)); }
        __syncthreads();
        for (int slice = blockIdx.x; slice < 256; slice += gridDim.x) {
            const int layer = slice >> 7, col0 = (slice & 127) * 96, cgp = tid % 24, kr = tid / 24;
            f32x4 acc = {0.f, 0.f, 0.f, 0.f};
            if (kr < 21) {
                const float* W = p.mod_w + (size_t)layer * 2048 * 12288 + col0 + 4 * cgp;
#pragma unroll 4
                for (int k = kr; k < 2048; k += 21) { const f32x4 w = __builtin_nontemporal_load((const f32x4*)(W + (size_t)k * 12288)); acc += w * cond[k]; }
                red[kr * 24 + cgp] = acc;
            }
            __syncthreads();
            if (tid < 96) { float s = p.mod_b[layer * 12288 + col0 + tid];
                for (int r = 0; r < 21; ++r) s += ((LAS float*)red)[r * 96 + tid];
                MOD[layer * 12288 + col0 + tid] = s; }
            __syncthreads();
        }
    }
    asm volatile("s_waitcnt vmcnt(0)" ::: "memory");
    __syncthreads();
    if (tid == 0) { __builtin_amdgcn_fence(__ATOMIC_RELEASE, "agent"); asm volatile("s_waitcnt vmcnt(0)" ::: "memory");
        (void)__hip_atomic_fetch_add((unsigned*)(p.ws + WS_BAR) + MODCNT_WORD, 1u, __ATOMIC_RELAXED, __HIP_MEMORY_SCOPE_AGENT); }
    {
        LAS float* scr = (LAS float*)(lds + wave * 16384);
        const int gw = blockIdx.x * 8 + wave, NGW = gridDim.x * 8;
        constexpr int I_AIN = (D / 64) * (NQKV / 32), I_SQ = (D / 64) * (D / 32), I_BIG = (D / 64) * (DFF / 32);
        constexpr int NITEMS = I_AIN + 2 * I_SQ + 5 * I_BIG;
        for (int it = gw; it < NITEMS; it += NGW) {
            int r = it;
            if (r < I_AIN) { p0_transpose_item(p.attn_w_in, D, NQKV, (bf16_t*)(p.ws + WS_WT_AIN), scr, r, lane); continue; } r -= I_AIN;
            if (r < I_SQ) { p0_transpose_item(p.attn_w_out, D, D, (bf16_t*)(p.ws + WS_WT_AOUT), scr, r, lane); continue; } r -= I_SQ;
            if (r < I_SQ) { p0_transpose_item(p.hgrn_w_out, D, D, (bf16_t*)(p.ws + WS_WT_HOUT), scr, r, lane); continue; } r -= I_SQ;
            if (r < I_BIG) { p0_transpose_item(p.hgrn_w_in, D, DFF, (bf16_t*)(p.ws + WS_WT_HIN), scr, r, lane); continue; } r -= I_BIG;
            if (r < I_BIG) { p0_transpose_item(p.mlp_w1, D, DFF, (bf16_t*)(p.ws + WS_WT_W1), scr, r, lane); continue; } r -= I_BIG;
            if (r < I_BIG) { p0_transpose_item(p.mlp_w1 + (size_t)D * DFF, D, DFF, (bf16_t*)(p.ws + WS_WT_W1 + 32 * MiB), scr, r, lane); continue; } r -= I_BIG;
            if (r < I_BIG) { p0_transpose_item(p.mlp_w2, DFF, D, (bf16_t*)(p.ws + WS_WT_W2), scr, r, lane); continue; } r -= I_BIG;
            p0_transpose_item(p.mlp_w2 + (size_t)D * DFF, DFF, D, (bf16_t*)(p.ws + WS_WT_W2 + 32 * MiB), scr, r, lane);
        }
    }
}

__device__ __forceinline__ void norm_phase(LAS unsigned char* lds, const float* xin, const float* gain, const float* sh, const float* sc, bf16_t* out) {
    const int tid = pg8::opaque_tid(), lane = tid & 63, wave = tid >> 6;
    LAS float* Av = (LAS float*)lds; LAS float* Bv = (LAS float*)(lds + 8192);
    for (int i = tid; i < 2048; i += 512) { Av[i] = gain[i] * (1.0f + sc[i]); Bv[i] = sh[i]; }
    __syncthreads();
    const int gw = blockIdx.x * 8 + wave, NGW = gridDim.x * 8;
    for (int m = gw; m < T; m += 2 * NGW) {
        const int m2 = m + NGW < T ? m + NGW : m;
        const f32x4* xr = (const f32x4*)(xin + (size_t)m * D) + lane; const f32x4* xr2 = (const f32x4*)(xin + (size_t)m2 * D) + lane;
        f32x4 v[8], v2[8]; float s = 0.f, s2 = 0.f;
#pragma unroll
        for (int j = 0; j < 8; ++j) { v[j] = xr[64 * j]; v2[j] = xr2[64 * j]; }
#pragma unroll
        for (int j = 0; j < 8; ++j) { s += (v[j].x * v[j].x + v[j].y * v[j].y) + (v[j].z * v[j].z + v[j].w * v[j].w); s2 += (v2[j].x * v2[j].x + v2[j].y * v2[j].y) + (v2[j].z * v2[j].z + v2[j].w * v2[j].w); }
        const float rstd = rsqrtf(wave_sum(s) * (1.0f / D) + EPS), rstd2 = rsqrtf(wave_sum(s2) * (1.0f / D) + EPS);
        u32x2* o8 = (u32x2*)(out + (size_t)m * D) + lane; u32x2* o82 = (u32x2*)(out + (size_t)m2 * D) + lane;
#pragma unroll
        for (int j = 0; j < 8; ++j) { const f32x4 a = ((LAS f32x4*)Av)[lane + 64 * j], b = ((LAS f32x4*)Bv)[lane + 64 * j];
            const f32x4 y = v[j] * rstd * a + b, y2 = v2[j] * rstd2 * a + b; u32x2 w, w2; w.x = cvt_pk_bf16(y.x, y.y); w.y = cvt_pk_bf16(y.z, y.w); w2.x = cvt_pk_bf16(y2.x, y2.y); w2.y = cvt_pk_bf16(y2.z, y2.w);
            o8[64 * j] = w; if (m2 != m) o82[64 * j] = w2; }
    }
    __syncthreads();
}


__device__ __forceinline__ void rstd_prepare(LAS float* rs, const float* part, const pg8::StaticOrder& S) {
    const int tid = pg8::opaque_tid(), j = tid >> 7, r0 = (tid & 127) * 2; pg8::Unit u;
    if (S.next(j, u)) {
#pragma unroll
        for (int rr = 0; rr < 2; ++rr) { const f32x4* pp = (const f32x4*)(part + (size_t)(u.pm * 256 + r0 + rr) * 32); float s = 0.f;
#pragma unroll
            for (int i = 0; i < 8; ++i) { const f32x4 v = pp[i]; s += (v.x + v.y) + (v.z + v.w); }
            rs[j * 256 + r0 + rr] = rsqrtf(s * (1.0f / D) + EPS); }
    }
    __syncthreads();
}
__device__ __forceinline__ void bias_gemv(const float* sh, const bf16_t* WT, float* bias, int nrows, int wave_id, int nwaves) {
    const int lane = pg8::opaque_tid() & 63;
    float shv[32];
#pragma unroll
    for (int i = 0; i < 4; ++i)
#pragma unroll
        for (int e = 0; e < 8; ++e) shv[8 * i + e] = sh[(lane + 64 * i) * 8 + e];
    for (int row = wave_id; row < nrows; row += 4 * nwaves) {
        u32x4 v[4][4];
#pragma unroll
        for (int q = 0; q < 4; ++q) { const int rq = row + q * nwaves < nrows ? row + q * nwaves : row; const u32x4* pr = (const u32x4*)(WT + (size_t)rq * D) + lane;
#pragma unroll
            for (int i = 0; i < 4; ++i) v[q][i] = pr[64 * i]; }
#pragma unroll
        for (int q = 0; q < 4; ++q) { float a = 0.f;
#pragma unroll
            for (int i = 0; i < 4; ++i)
#pragma unroll
                for (int e = 0; e < 4; ++e) a += bflo(v[q][i][e]) * shv[8 * i + 2 * e] + bfhi(v[q][i][e]) * shv[8 * i + 2 * e + 1];
            a = wave_sum(a);
            if (lane == 0 && row + q * nwaves < nrows) bias[row + q * nwaves] = a; }
    }
}

__device__ __forceinline__ void attn_phase(LAS unsigned char* lds, const bf16_t* QKV, const float* qg, const float* kg, const float* sinks, bf16_t* ATT) {
    constexpr int LDQ = NQKV, KST = 72, VST = 280;
    LAS bf16_t* Ks = (LAS bf16_t*)lds;
    LAS bf16_t* Vt = (LAS bf16_t*)(lds + 272 * KST * 2);
    const int tid = pg8::opaque_tid(), lane = tid & 63, wid = tid >> 6, fr = lane & 15, fq = lane >> 4;
    for (int unit = blockIdx.x; unit < 256; unit += gridDim.x) {
        const int kvh = unit & 3, nb = unit >> 2;
        u32x4 q0n, q1n;
        { const u32x4* qp = (const u32x4*)(QKV + (size_t)(nb * 128 + fr) * LDQ + (kvh * 8 + wid) * 64 + 8 * fq); q0n = qp[0]; q1n = qp[4]; }
        {
            const int kp = tid >> 1, half = tid & 1, s_abs = (nb - 1) * 128 + kp;
            u32x4 kr[4], vr[4];
#pragma unroll
            for (int i = 0; i < 4; ++i) { kr[i] = (u32x4){0u, 0u, 0u, 0u}; vr[i] = (u32x4){0u, 0u, 0u, 0u}; }
            if (s_abs >= 0) {
                const u32x4* kptr = (const u32x4*)(QKV + (size_t)s_abs * LDQ + 2048 + kvh * 64 + half * 32);
                const u32x4* vptr = (const u32x4*)(QKV + (size_t)s_abs * LDQ + 2304 + kvh * 64 + half * 32);
#pragma unroll
                for (int i = 0; i < 4; ++i) { kr[i] = kptr[i]; vr[i] = vptr[i]; }
            }
            float ss = 0.f;
#pragma unroll
            for (int i = 0; i < 4; ++i)
#pragma unroll
                for (int e = 0; e < 4; ++e) { const float a = bflo(kr[i][e]), b = bfhi(kr[i][e]); ss += a * a + b * b; }
            ss += __shfl_xor(ss, 1);
            const float rstd = rsqrtf(ss * (1.0f / 64.0f) + EPS);
#pragma unroll
            for (int i = 0; i < 4; ++i) { u32x4 w;
#pragma unroll
                for (int e = 0; e < 4; ++e) { const int d = half * 32 + i * 8 + e * 2; w[e] = cvt_pk_bf16(bflo(kr[i][e]) * rstd * kg[d], bfhi(kr[i][e]) * rstd * kg[d + 1]); }
                *(LAS u32x4*)(Ks + kp * KST + half * 32 + i * 8) = w; }
#pragma unroll
            for (int i = 0; i < 4; ++i)
#pragma unroll
                for (int e = 0; e < 4; ++e) { const int d = half * 32 + i * 8 + e * 2;
                    Vt[d * VST + kp] = (bf16_t)(vr[i][e] & 0xffffu); Vt[(d + 1) * VST + kp] = (bf16_t)(vr[i][e] >> 16); }
            for (int e = tid; e < 16 * KST / 2; e += 512) ((LAS unsigned*)(Ks + 256 * KST))[e] = 0u;
            for (int e = tid; e < 64 * 16; e += 512) Vt[(e >> 4) * VST + 256 + (e & 15)] = (bf16_t)0;
        }
        __syncthreads();
        const int h = kvh * 8 + wid;
        const float LOG2E = 1.4426950408889634f;
        const float slope = exp2f(-0.25f * (float)(h + 1)) * LOG2E, sink = sinks[h] * LOG2E;
        float qgv[16];
#pragma unroll
        for (int e = 0; e < 8; ++e) { qgv[e] = qg[8 * fq + e] * (0.125f * LOG2E); qgv[8 + e] = qg[32 + 8 * fq + e] * (0.125f * LOG2E); }
        float ar[4]; bool m0[4];
#pragma unroll
        for (int r = 0; r < 4; ++r) { ar[r] = slope * (float)(128 + fr - 4 * fq - r); m0[r] = fr < 4 * fq + r; }
        const float s16 = slope * 16.0f;
        for (int mt = 0; mt < 8; ++mt) {
            const int qi = 16 * mt + fr, t_abs = nb * 128 + qi;
            const u32x4 q0 = q0n, q1 = q1n;
            if (mt < 7) { const u32x4* qp = (const u32x4*)(QKV + (size_t)(t_abs + 16) * LDQ + h * 64 + 8 * fq); q0n = qp[0]; q1n = qp[4]; }
            float qf[16]; float ss = 0.f;
#pragma unroll
            for (int e = 0; e < 4; ++e) { qf[2 * e] = bflo(q0[e]); qf[2 * e + 1] = bfhi(q0[e]); qf[8 + 2 * e] = bflo(q1[e]); qf[8 + 2 * e + 1] = bfhi(q1[e]); }
#pragma unroll
            for (int e = 0; e < 16; ++e) ss += qf[e] * qf[e];
            ss += __shfl_xor(ss, 16); ss += __shfl_xor(ss, 32);
            const float rstd = rsqrtf(ss * (1.0f / 64.0f) + EPS);
            u32x4 qa, qb;
#pragma unroll
            for (int e = 0; e < 4; ++e) { qa[e] = cvt_pk_bf16(qf[2 * e] * rstd * qgv[2 * e], qf[2 * e + 1] * rstd * qgv[2 * e + 1]);
                                          qb[e] = cvt_pk_bf16(qf[8 + 2 * e] * rstd * qgv[8 + 2 * e], qf[8 + 2 * e + 1] * rstd * qgv[8 + 2 * e + 1]); }
            const bf16x8 Q0 = as_bf16x8(qa), Q1 = as_bf16x8(qb);
            f32x4 S[10];
#pragma unroll
            for (int jj = 0; jj < 9; ++jj) {
                const LAS bf16_t* kp_ = Ks + (16 * (mt + jj) + fr) * KST + 8 * fq;
                const bf16x8 K0 = *(const LAS bf16x8*)kp_, K1 = *(const LAS bf16x8*)(kp_ + 32);
                f32x4 a = {0.f, 0.f, 0.f, 0.f};
                a = mfma16(K0, Q0, a); a = mfma16(K1, Q1, a); S[jj] = a;
            }
            float mx = sink;
#pragma unroll
            for (int jj = 0; jj < 9; ++jj)
#pragma unroll
                for (int r = 0; r < 4; ++r) {
                    float lg = S[jj][r] - (ar[r] - s16 * (float)jj);
                    if (jj == 0) lg = m0[r] ? lg : -INFINITY;
                    if (jj == 8) lg = m0[r] ? -INFINITY : lg;
                    if (nb == 0) lg = (16 * (mt + jj) + 4 * fq + r >= 128) ? lg : -INFINITY;
                    S[jj][r] = lg; mx = fmaxf(mx, lg);
                }
            mx = fmaxf(mx, __shfl_xor(mx, 16)); mx = fmaxf(mx, __shfl_xor(mx, 32));
            float sum = 0.f;
#pragma unroll
            for (int jj = 0; jj < 9; ++jj)
#pragma unroll
                for (int r = 0; r < 4; ++r) { const float pv = __builtin_amdgcn_exp2f(S[jj][r] - mx); S[jj][r] = pv; sum += pv; }
            S[9] = (f32x4){0.f, 0.f, 0.f, 0.f};
            sum += __shfl_xor(sum, 16); sum += __shfl_xor(sum, 32);
            sum += __builtin_amdgcn_exp2f(sink - mx);
            const float inv = 1.0f / sum;
            f32x4 O[4];
#pragma unroll
            for (int dt = 0; dt < 4; ++dt) O[dt] = (f32x4){0.f, 0.f, 0.f, 0.f};
#pragma unroll
            for (int pp = 0; pp < 5; ++pp) {
                u32x4 pw; pw.x = cvt_pk_bf16(S[2 * pp][0], S[2 * pp][1]); pw.y = cvt_pk_bf16(S[2 * pp][2], S[2 * pp][3]);
                pw.z = cvt_pk_bf16(S[2 * pp + 1][0], S[2 * pp + 1][1]); pw.w = cvt_pk_bf16(S[2 * pp + 1][2], S[2 * pp + 1][3]);
                const bf16x8 P = as_bf16x8(pw);
                const int ka = 16 * (mt + 2 * pp) + 4 * fq;
#pragma unroll
                for (int dt = 0; dt < 4; ++dt) {
                    const LAS bf16_t* vrow = Vt + (16 * dt + fr) * VST + ka;
                    const u32x2 va = *(const LAS u32x2*)vrow, vb = *(const LAS u32x2*)(vrow + 16);
                    u32x4 vw; vw.x = va.x; vw.y = va.y; vw.z = vb.x; vw.w = vb.y;
                    O[dt] = mfma16(as_bf16x8(vw), P, O[dt]);
                }
            }
            bf16_t* orow = ATT + (size_t)t_abs * D + h * 64 + 4 * fq;
#pragma unroll
            for (int dt = 0; dt < 4; ++dt) { u32x2 w; w.x = cvt_pk_bf16(O[dt][0] * inv, O[dt][1] * inv); w.y = cvt_pk_bf16(O[dt][2] * inv, O[dt][3] * inv);
                *(u32x2*)(orow + 16 * dt) = w; }
        }
        __syncthreads();
    }
}

__device__ __forceinline__ void hgrn_h1(LAS unsigned char* lds, const bf16_t* LOGF, const bf16_t* Vh, bf16_t* US, float* DEC) {
    LAS float* B = (LAS float*)lds;
    LAS float* TOT = (LAS float*)(lds + 32768);
    LAS bf16_t* KT = (LAS bf16_t*)(lds + 34816);
    LAS bf16_t* VT = (LAS bf16_t*)(lds + 34816 + 18432);
    LAS float* EB = (LAS float*)(lds + 71680);
    const int tid = pg8::opaque_tid(), lane = tid & 63, wid = tid >> 6, fr = lane & 15, fq = lane >> 4;
    const int d = tid & 127, seg = tid >> 7;
    u32x4 pl[2]; bf16_t pv[16];
#define H1_LOAD(su_) do { const int u_ = (su_) >> 1, t0_ = (u_ >> 4) * 128 + 64 * ((su_) & 1), h_ = u_ & 15; \
        _Pragma("unroll") for (int i = 0; i < 2; ++i) { const int idx = tid + 512 * i, row = idx >> 4, c8 = idx & 15; pl[i] = *(const u32x4*)(LOGF + (size_t)(t0_ + row) * D + h_ * 128 + 8 * c8); } \
        _Pragma("unroll") for (int i = 0; i < 16; ++i) pv[i] = Vh[(size_t)(t0_ + 16 * seg + i) * D + h_ * 128 + d]; } while (0)
    if ((int)blockIdx.x < 1024) H1_LOAD(2 * (int)blockIdx.x);
    for (int unit = blockIdx.x; unit < 1024; unit += gridDim.x) {
        const int N = unit >> 4, h = unit & 15;
        f32x4 accA[8]; float totA = 0.f;
#pragma unroll
        for (int sub = 0; sub < 2; ++sub) {
#pragma unroll
            for (int i = 0; i < 2; ++i) { const int idx = tid + 512 * i;
                ((LAS f32x4*)B)[2 * idx] = (f32x4){bflo(pl[i].x), bfhi(pl[i].x), bflo(pl[i].y), bfhi(pl[i].y)};
                ((LAS f32x4*)B)[2 * idx + 1] = (f32x4){bflo(pl[i].z), bfhi(pl[i].z), bflo(pl[i].w), bfhi(pl[i].w)}; }
            bf16_t vv[16];
#pragma unroll
            for (int i = 0; i < 16; ++i) vv[i] = pv[i];
            __syncthreads();
            if (sub == 0) H1_LOAD(2 * unit + 1); else if (unit + (int)gridDim.x < 1024) H1_LOAD(2 * (unit + (int)gridDim.x));
            float lf[16], b[16]; float run = 0.f;
#pragma unroll
            for (int i = 0; i < 16; ++i) { lf[i] = B[(16 * seg + i) * 128 + d]; run += lf[i]; b[i] = run; }
            TOT[seg * 128 + d] = run;
            __syncthreads();
            float off = 0.f, tot = 0.f;
#pragma unroll
            for (int s2 = 0; s2 < 4; ++s2) { const float tv = TOT[s2 * 128 + d]; off += (s2 < seg) ? tv : 0.f; tot += tv; }
            u32x4 kw[2], vw[2];
#pragma unroll
            for (int i = 0; i < 16; i += 2) {
                const float k0 = (1.0f - __expf(lf[i])) * __expf(tot - (b[i] + off)), k1 = (1.0f - __expf(lf[i + 1])) * __expf(tot - (b[i + 1] + off));
                kw[i >> 3][(i >> 1) & 3] = cvt_pk_bf16(k0, k1);
                vw[i >> 3][(i >> 1) & 3] = (unsigned)vv[i] | ((unsigned)vv[i + 1] << 16);
            }
            *(LAS u32x4*)(KT + d * 72 + 16 * seg) = kw[0]; *(LAS u32x4*)(KT + d * 72 + 16 * seg + 8) = kw[1];
            *(LAS u32x4*)(VT + d * 72 + 16 * seg) = vw[0]; *(LAS u32x4*)(VT + d * 72 + 16 * seg + 8) = vw[1];
            if (seg == 0) { if (sub == 0) totA = tot; else { EB[d] = __expf(tot); DEC[(size_t)(N * 16 + h) * 128 + d] = __expf(totA + tot); } }
            __syncthreads();
            const bf16x8 V0 = *(const LAS bf16x8*)(VT + (16 * wid + fr) * 72 + 8 * fq), V1 = *(const LAS bf16x8*)(VT + (16 * wid + fr) * 72 + 8 * fq + 32);
            bf16_t* urow = US + ((size_t)(N * 16 + h) * 128 + 16 * wid + fr) * 128 + 4 * fq;
#pragma unroll
            for (int dt = 0; dt < 8; ++dt) {
                const bf16x8 K0 = *(const LAS bf16x8*)(KT + (16 * dt + fr) * 72 + 8 * fq), K1 = *(const LAS bf16x8*)(KT + (16 * dt + fr) * 72 + 8 * fq + 32);
                f32x4 a = {0.f, 0.f, 0.f, 0.f};
                a = mfma16(K0, V0, a); a = mfma16(K1, V1, a);
                if (sub == 0) accA[dt] = a;
                else { const f32x4 e4 = *(const LAS f32x4*)(EB + 16 * dt + 4 * fq); const f32x4 u = accA[dt] * e4 + a;
                    u32x2 w; w.x = cvt_pk_bf16(u[0], u[1]); w.y = cvt_pk_bf16(u[2], u[3]);
                    *(u32x2*)(urow + 16 * dt) = w; }
            }
            __syncthreads();
        }
    }
}
__device__ __forceinline__ void hgrn_h2(const bf16_t* US, bf16_t* SS, const float* DEC) {
    for (int pidx = blockIdx.x * 512 + threadIdx.x; pidx < 131072; pidx += gridDim.x * 512) {
        const int e = 2 * pidx, h = e >> 14, dd = e & 127;
        float s0 = 0.f, s1 = 0.f;
        for (int n0 = 0; n0 < 64; n0 += 16) {
            unsigned u[16]; f32x2 dc[16];
#pragma unroll
            for (int i = 0; i < 16; ++i) { u[i] = __builtin_nontemporal_load((const unsigned*)(US + (size_t)(n0 + i) * 262144 + e)); dc[i] = *(const f32x2*)(DEC + (size_t)((n0 + i) * 16 + h) * 128 + dd); }
#pragma unroll
            for (int i = 0; i < 16; ++i) { *(unsigned*)(SS + (size_t)(n0 + i) * 262144 + e) = cvt_pk_bf16(s0, s1);
                s0 = dc[i].x * s0 + bflo(u[i]); s1 = dc[i].y * s1 + bfhi(u[i]); }
        }
    }
}
__device__ __forceinline__ void hgrn_h3(LAS unsigned char* lds, const bf16_t* LOGF, const bf16_t* Qh, const bf16_t* Vh, const bf16_t* Gh, const bf16_t* US, const float* og, bf16_t* OUT) {
    LAS float* B = (LAS float*)lds;
    LAS bf16_t* KTA = (LAS bf16_t*)lds;
    LAS float* TOT = (LAS float*)(lds + 33792);
    LAS float* EP = (LAS float*)(lds + 35840);
    LAS bf16_t* QT = (LAS bf16_t*)(lds + 36352);
    LAS bf16_t* KQ = (LAS bf16_t*)(lds + 53760);
    LAS bf16_t* AM = (LAS bf16_t*)(lds + 71168);
    LAS bf16_t* VT = (LAS bf16_t*)(lds + 80384);
    LAS bf16_t* ST = (LAS bf16_t*)(lds + 98816);
    LAS float* EA = (LAS float*)(lds + 133632);
    const int tid = pg8::opaque_tid(), lane = tid & 63, wid = tid >> 6, fr = lane & 15, fq = lane >> 4;
    const int d = tid & 127, seg = tid >> 7;
    u32x4 pl[2]; bf16_t pv[16], pq[16];
#define H3_LOAD(su_) do { const int u_ = (su_) >> 1, t0_ = (u_ >> 4) * 128 + 64 * ((su_) & 1), h_ = u_ & 15; \
        _Pragma("unroll") for (int i = 0; i < 2; ++i) { const int idx = tid + 512 * i, row = idx >> 4, c8 = idx & 15; pl[i] = *(const u32x4*)(LOGF + (size_t)(t0_ + row) * D + h_ * 128 + 8 * c8); } \
        _Pragma("unroll") for (int i = 0; i < 16; ++i) { pv[i] = Vh[(size_t)(t0_ + 16 * seg + i) * D + h_ * 128 + d]; pq[i] = Qh[(size_t)(t0_ + 16 * seg + i) * D + h_ * 128 + d]; } } while (0)
    if ((int)blockIdx.x < 1024) H3_LOAD(2 * (int)blockIdx.x);
    for (int unit = blockIdx.x; unit < 1024; unit += gridDim.x) {
        const int N = unit >> 4, h = unit & 15;
        f32x4 accU[8];
#pragma unroll
        for (int sub = 0; sub < 2; ++sub) {
            const int t0 = N * 128 + 64 * sub;
#pragma unroll
            for (int i = 0; i < 2; ++i) { const int idx = tid + 512 * i;
                ((LAS f32x4*)B)[2 * idx] = (f32x4){bflo(pl[i].x), bfhi(pl[i].x), bflo(pl[i].y), bfhi(pl[i].y)};
                ((LAS f32x4*)B)[2 * idx + 1] = (f32x4){bflo(pl[i].z), bfhi(pl[i].z), bflo(pl[i].w), bfhi(pl[i].w)}; }
            bf16_t vv[16], qq[16];
#pragma unroll
            for (int i = 0; i < 16; ++i) { vv[i] = pv[i]; qq[i] = pq[i]; }
            u32x2 sraw[8];
            if (sub == 1) { const bf16_t* sp2 = US + ((size_t)(N * 16 + h) * 128 + 16 * wid + fr) * 128 + 4 * fq;
#pragma unroll
                for (int dt = 0; dt < 8; ++dt) sraw[dt] = *(const u32x2*)(sp2 + 16 * dt); }
            __syncthreads();
            if (sub == 0) H3_LOAD(2 * unit + 1); else if (unit + (int)gridDim.x < 1024) H3_LOAD(2 * (unit + (int)gridDim.x));
            float lf[16], b[16]; float run = 0.f;
#pragma unroll
            for (int i = 0; i < 16; ++i) { lf[i] = B[(16 * seg + i) * 128 + d]; run += lf[i]; b[i] = run; }
            TOT[seg * 128 + d] = run;
            __syncthreads();
            const float t0v = TOT[d], t1v = TOT[128 + d], t2v = TOT[256 + d], t3v = TOT[384 + d];
            const float off = (seg > 0 ? t0v : 0.f) + (seg > 1 ? t1v : 0.f) + (seg > 2 ? t2v : 0.f), piv = t0v + t1v, tot = (t0v + t1v) + (t2v + t3v);
            u32x4 vw[2], kw[2];
#pragma unroll
            for (int i = 0; i < 16; ++i) {
                const float bi = b[i] + off; const int c = 16 * seg + i;
                const float kk = 1.0f - __expf(lf[i]);
                const float qt = bf2f(qq[i]) * __expf(bi - piv), kt = kk * __expf(piv - bi);
                QT[c * 136 + d] = (bf16_t)(cvt_pk_bf16(qt, 0.f) & 0xffffu); KQ[c * 136 + d] = (bf16_t)(cvt_pk_bf16(kt, 0.f) & 0xffffu);
                if (sub == 0) { const float kh = kk * __expf(tot - bi); lf[i] = kh; }
            }
#pragma unroll
            for (int i = 0; i < 16; i += 2) { vw[i >> 3][(i >> 1) & 3] = (unsigned)vv[i] | ((unsigned)vv[i + 1] << 16); if (sub == 0) kw[i >> 3][(i >> 1) & 3] = cvt_pk_bf16(lf[i], lf[i + 1]); }
            *(LAS u32x4*)(VT + d * 72 + 16 * seg) = vw[0]; *(LAS u32x4*)(VT + d * 72 + 16 * seg + 8) = vw[1];
            if (sub == 0) { *(LAS u32x4*)(KTA + d * 72 + 16 * seg) = kw[0]; *(LAS u32x4*)(KTA + d * 72 + 16 * seg + 8) = kw[1]; }
            if (seg == 0) { EP[d] = __expf(piv); if (sub == 0) EA[d] = __expf(tot); }
            __syncthreads();
            if (sub == 0) {
                const int v = tid >> 2, dq = (tid & 3) * 32;
                const u32x4* sp = (const u32x4*)(US + ((size_t)(N * 16 + h) * 128 + v) * 128 + dq);
#pragma unroll
                for (int i = 0; i < 4; ++i) { const u32x4 s = sp[i]; u32x4 w;
#pragma unroll
                    for (int e = 0; e < 4; ++e) { const int dd = dq + 8 * i + 2 * e; w[e] = cvt_pk_bf16(bflo(s[e]) * EP[dd], bfhi(s[e]) * EP[dd + 1]); }
                    *(LAS u32x4*)(ST + v * 136 + dq + 8 * i) = w; }
            } else {
#pragma unroll
                for (int dt = 0; dt < 8; ++dt) { const f32x4 ea = *(const LAS f32x4*)(EA + 16 * dt + 4 * fq), ep = *(const LAS f32x4*)(EP + 16 * dt + 4 * fq);
                    const f32x4 sv = {bflo(sraw[dt].x), bfhi(sraw[dt].x), bflo(sraw[dt].y), bfhi(sraw[dt].y)};
                    const f32x4 r = (sv * ea + accU[dt]) * ep;
                    u32x2 w; w.x = cvt_pk_bf16(r[0], r[1]); w.y = cvt_pk_bf16(r[2], r[3]);
                    *(LAS u32x2*)(ST + (16 * wid + fr) * 136 + 16 * dt + 4 * fq) = w; }
            }
            {
                const int ct = wid >> 1;
#pragma unroll
                for (int sti = 0; sti < 2; ++sti) {
                    const int st = 2 * (wid & 1) + sti;
                    f32x4 a = {0.f, 0.f, 0.f, 0.f};
                    if (st <= ct) {
#pragma unroll
                        for (int ks = 0; ks < 4; ++ks) {
                            const bf16x8 Kf = *(const LAS bf16x8*)(KQ + (16 * st + fr) * 136 + 8 * fq + 32 * ks), Qf = *(const LAS bf16x8*)(QT + (16 * ct + fr) * 136 + 8 * fq + 32 * ks);
                            a = mfma16(Kf, Qf, a);
                        }
                    }
                    const int c = 16 * ct + fr, s = 16 * st + 4 * fq;
#pragma unroll
                    for (int r = 0; r < 4; ++r) a[r] = (st <= ct && s + r <= c) ? a[r] : 0.f;
                    u32x2 w; w.x = cvt_pk_bf16(a[0], a[1]); w.y = cvt_pk_bf16(a[2], a[3]);
                    *(LAS u32x2*)(AM + c * 72 + s) = w;
                }
            }
            if (sub == 0) {
                const bf16x8 V0 = *(const LAS bf16x8*)(VT + (16 * wid + fr) * 72 + 8 * fq), V1 = *(const LAS bf16x8*)(VT + (16 * wid + fr) * 72 + 8 * fq + 32);
#pragma unroll
                for (int dt = 0; dt < 8; ++dt) {
                    const bf16x8 K0 = *(const LAS bf16x8*)(KTA + (16 * dt + fr) * 72 + 8 * fq), K1 = *(const LAS bf16x8*)(KTA + (16 * dt + fr) * 72 + 8 * fq + 32);
                    f32x4 a = {0.f, 0.f, 0.f, 0.f};
                    a = mfma16(K0, V0, a); a = mfma16(K1, V1, a); accU[dt] = a;
                }
            }
            __syncthreads();
            {
                bf16x8 Sf[4], Vf[2];
#pragma unroll
                for (int ks = 0; ks < 4; ++ks) Sf[ks] = *(const LAS bf16x8*)(ST + (16 * wid + fr) * 136 + 8 * fq + 32 * ks);
#pragma unroll
                for (int ks = 0; ks < 2; ++ks) Vf[ks] = *(const LAS bf16x8*)(VT + (16 * wid + fr) * 72 + 8 * fq + 32 * ks);
#pragma unroll
                for (int ct = 0; ct < 4; ++ct) {
                    f32x4 a = {0.f, 0.f, 0.f, 0.f};
#pragma unroll
                    for (int ks = 0; ks < 4; ++ks) a = mfma16(Sf[ks], *(const LAS bf16x8*)(QT + (16 * ct + fr) * 136 + 8 * fq + 32 * ks), a);
#pragma unroll
                    for (int ks = 0; ks < 2; ++ks) a = mfma16(Vf[ks], *(const LAS bf16x8*)(AM + (16 * ct + fr) * 72 + 8 * fq + 32 * ks), a);
                    *(LAS f32x4*)(B + (16 * ct + fr) * 132 + 16 * wid + 4 * fq) = a;
                }
            }
            __syncthreads();
            {
                const int c = tid >> 3, v0 = (tid & 7) * 16;
                f32x4 o[4]; float ss = 0.f;
#pragma unroll
                for (int i = 0; i < 4; ++i) { o[i] = *(const LAS f32x4*)(B + c * 132 + v0 + 4 * i); ss += (o[i].x * o[i].x + o[i].y * o[i].y) + (o[i].z * o[i].z + o[i].w * o[i].w); }
                ss += __shfl_xor(ss, 1); ss += __shfl_xor(ss, 2); ss += __shfl_xor(ss, 4);
                const float rstd = rsqrtf(ss * (1.0f / 128.0f) + EPS);
                const u32x4* gp = (const u32x4*)(Gh + (size_t)(t0 + c) * D + h * 128 + v0);
                const u32x4 g0 = gp[0], g1 = gp[1];
                const f32x4* ogp = (const f32x4*)(og + h * 128 + v0);
                u32x4 w0, w1;
#pragma unroll
                for (int i = 0; i < 2; ++i) { const f32x4 ga = ogp[i];
                    w0[2 * i] = cvt_pk_bf16(o[i].x * rstd * ga.x * bflo(g0[2 * i]), o[i].y * rstd * ga.y * bfhi(g0[2 * i]));
                    w0[2 * i + 1] = cvt_pk_bf16(o[i].z * rstd * ga.z * bflo(g0[2 * i + 1]), o[i].w * rstd * ga.w * bfhi(g0[2 * i + 1])); }
#pragma unroll
                for (int i = 0; i < 2; ++i) { const f32x4 ga = ogp[2 + i];
                    w1[2 * i] = cvt_pk_bf16(o[2 + i].x * rstd * ga.x * bflo(g1[2 * i]), o[2 + i].y * rstd * ga.y * bfhi(g1[2 * i]));
                    w1[2 * i + 1] = cvt_pk_bf16(o[2 + i].z * rstd * ga.z * bflo(g1[2 * i + 1]), o[2 + i].w * rstd * ga.w * bfhi(g1[2 * i + 1])); }
                u32x4* op = (u32x4*)(OUT + (size_t)(t0 + c) * D + h * 128 + v0);
                op[0] = w0; op[1] = w1;
            }
            __syncthreads();
        }
    }
}

#define XB_TMO      128
#define XB_XCNT(j)  (256  + 64 * (j))
#define XB_XSUB(j)  (1280 + 64 * (j))
#define XB_XGEN(j)  (2304 + 64 * (j))
#define XB_TOP      3328
#define XB_TOPGEN   3392
#define XCD_BAR_WORDS 3456
#define XB_SPIN_CAP (1u << 18)

__device__ __forceinline__ unsigned xb_ld(unsigned* p)              { return __hip_atomic_load(p, __ATOMIC_RELAXED, __HIP_MEMORY_SCOPE_AGENT); }
__device__ __forceinline__ unsigned xb_add(unsigned* p, unsigned v) { return __hip_atomic_fetch_add(p, v, __ATOMIC_RELAXED, __HIP_MEMORY_SCOPE_AGENT); }
__device__ __forceinline__ unsigned xb_xcc_id() { return (unsigned)__builtin_amdgcn_s_getreg((3 << 11) | 20) & 0xFu; }
#define XB_SPIN(cond, bar) do { unsigned _sp = 0; while (cond) { __builtin_amdgcn_s_sleep(1); \
    if ((++_sp & 255u) == 0u) { if (xb_ld(&(bar)[XB_TMO])) break; if (_sp > XB_SPIN_CAP) { atomicAdd(&(bar)[XB_TMO], 1u); break; } } } } while (0)

struct XcdBarrier {
    unsigned* bar; unsigned x;
    volatile LAS unsigned* st;
};

__device__ __forceinline__ XcdBarrier xcd_barrier_post(unsigned* bar, volatile LAS unsigned* st) {
    XcdBarrier b; b.bar = bar; b.x = xb_xcc_id(); b.st = st;
    if (threadIdx.x == 0) (void)xb_add(&bar[XB_XCNT(b.x)], 1u);
    return b;
}
__device__ __forceinline__ void xcd_barrier_complete(unsigned* bar, unsigned x, unsigned& nloc, unsigned& nx) {
    const unsigned G = gridDim.x * gridDim.y * gridDim.z;
    unsigned sum, cnt, mine, sp = 0u;
    for (;;) {
        sum = 0u; cnt = 0u; mine = 0u;
#pragma unroll
        for (unsigned j = 0; j < 16; ++j) { const unsigned c = xb_ld(&bar[XB_XCNT(j)]); sum += c; cnt += (c > 0u) ? 1u : 0u; mine = (j == x) ? c : mine; }
        if (sum == G) break;
        __builtin_amdgcn_s_sleep(1);
        if ((++sp & 255u) == 0u) { if (xb_ld(&bar[XB_TMO])) break; if (sp > XB_SPIN_CAP) { atomicAdd(&bar[XB_TMO], 1u); break; } }
    }
    nloc = mine > 0u ? mine : 1u; nx = cnt > 0u ? cnt : 1u;
}

__device__ __forceinline__ void xcd_barrier(const XcdBarrier& b) {
    asm volatile("s_waitcnt vmcnt(0)" ::: "memory");
    __syncthreads();
    if (threadIdx.x == 0) {
        unsigned* bar = b.bar;
        __builtin_amdgcn_s_waitcnt(0);
        unsigned nloc = b.st[0], nx = b.st[1];
        if (nloc == 0u) { xcd_barrier_complete(bar, b.x, nloc, nx); b.st[0] = nloc; b.st[1] = nx; }
        const unsigned old = xb_add(&bar[XB_XSUB(b.x)], 1u);
        const unsigned gen = old / nloc;
        if (old + 1u == (gen + 1u) * nloc) {
            __builtin_amdgcn_fence(__ATOMIC_RELEASE, "agent");
            asm volatile("s_waitcnt vmcnt(0)" ::: "memory");
            const unsigned og = xb_add(&bar[XB_TOP], 1u);
            const unsigned tg = og / nx;
            if (og + 1u == (tg + 1u) * nx) xb_add(&bar[XB_TOPGEN], 1u);
            else XB_SPIN(xb_ld(&bar[XB_TOPGEN]) == tg, bar);
            __builtin_amdgcn_fence(__ATOMIC_ACQUIRE, "agent");
            xb_add(&bar[XB_XGEN(b.x)], 1u);
            asm volatile("s_waitcnt vmcnt(0)" ::: "memory");
        } else {
            XB_SPIN(xb_ld(&bar[XB_XGEN(b.x)]) == gen, bar);
            __builtin_amdgcn_fence(__ATOMIC_ACQUIRE, "agent");
            asm volatile("s_waitcnt vmcnt(0)" ::: "memory");
        }
    }
    __syncthreads();
}

__global__ void __launch_bounds__(512, 2) fwd_megakernel(Params p) {
    extern __shared__ __attribute__((aligned(16))) unsigned char lds_raw[];
    LAS unsigned char* lds = (LAS unsigned char*)lds_raw;
    cg::grid_group grid = cg::this_grid();
    unsigned char* ws = p.ws;
    const float* MOD = (const float*)(ws + WS_MOD);
    bf16_t* H = (bf16_t*)(ws + WS_H); bf16_t* QKV = (bf16_t*)(ws + WS_QKV); bf16_t* ATT = (bf16_t*)(ws + WS_ATT); bf16_t* XA = (bf16_t*)(ws + WS_XA);   bf16_t* ACT = (bf16_t*)(ws + WS_ACT);
    bf16_t* QH = (bf16_t*)(ws + WS_QH); bf16_t* LOGF = (bf16_t*)(ws + WS_LOGF); bf16_t* VH = (bf16_t*)(ws + WS_VH); bf16_t* GH = (bf16_t*)(ws + WS_GH); bf16_t* US = (bf16_t*)(ws + WS_US); bf16_t* SS = (bf16_t*)(ws + WS_SS); float* DEC = (float*)(ws + WS_DEC);
    const int G = gridDim.x, bx = blockIdx.x;

    if (threadIdx.x < 16) ((LAS unsigned*)(lds + MISC_OFF))[threadIdx.x] = 0u;
    __syncthreads();
    const XcdBarrier bar = xcd_barrier_post((unsigned*)(ws + WS_BAR), (volatile LAS unsigned*)(lds + MISC_OFF));
#define CG_SYNC() do { asm volatile("s_waitcnt vmcnt(0) lgkmcnt(0)" ::: "memory"); grid.sync(); __builtin_amdgcn_fence(__ATOMIC_ACQUIRE, "agent"); asm volatile("s_waitcnt vmcnt(0)" ::: "memory"); __syncthreads(); } while (0)
#define GRID_SYNC() xcd_barrier(bar)
    prologue_phase(lds, p);
    {
        __syncthreads();
        if (threadIdx.x == 0) { unsigned* cnt = (unsigned*)(ws + WS_BAR) + MODCNT_WORD; unsigned sp = 0;
            while (__hip_atomic_load(cnt, __ATOMIC_RELAXED, __HIP_MEMORY_SCOPE_AGENT) < (unsigned)G) { __builtin_amdgcn_s_sleep(2); if (++sp > (1u << 22)) break; }
            __builtin_amdgcn_fence(__ATOMIC_ACQUIRE, "agent"); asm volatile("s_waitcnt vmcnt(0)" ::: "memory"); }
        __syncthreads();
    }
    norm_phase(lds, p.x, p.norm_mix, MOD, MOD + D, H);
    if (p.ws == nullptr) CG_SYNC();
    GRID_SYNC();
#define GEMM_PHASE(EpiT, Aptr, WToff, Nn, Kk, ...) do { pg8::Gemm g{Aptr, (const bf16_t*)(ws + (WToff)), T, Nn, Kk}; pg8::StaticOrder S; S.init(T, Nn, G, bx); \
        EpiT E{__VA_ARGS__}; pg8::gemm_phase<EpiT, pg8::StaticOrder, true, true>(lds, g, S, E); } while (0)
    float* BIAS = (float*)(ws + WS_BIAS); float* PART = (float*)(ws + WS_PART); LAS float* RS = (LAS float*)(lds + RS_OFF);
    GEMM_PHASE(pg8::EpiStore<0>, H, WS_WT_AIN, NQKV, D, QKV, NQKV);
    {
        const int busy2 = (T / 256) * (NQKV / 256) - G; const bool split = busy2 > 0 && busy2 < G;
        if (!split || bx >= busy2) {
            const int wv = (split ? bx - busy2 : bx) * 8 + (pg8::opaque_tid() >> 6), nw = (split ? G - busy2 : G) * 8;
            bias_gemv(MOD + 3 * D, (const bf16_t*)(ws + WS_WT_W1), BIAS, DFF, wv, nw);
            bias_gemv(MOD + 12288, (const bf16_t*)(ws + WS_WT_HIN), BIAS + DFF, DFF, wv, nw);
            bias_gemv(MOD + 12288 + 3 * D, (const bf16_t*)(ws + WS_WT_W1 + 32 * MiB), BIAS + 2 * DFF, DFF, wv, nw);
        }
    }
    GRID_SYNC();
    attn_phase(lds, QKV, p.attn_q_gain, p.attn_k_gain, p.attn_sinks, ATT);
    GRID_SYNC();
    GEMM_PHASE(pg8::EpiResidN<false>, ATT, WS_WT_AOUT, D, D, p.x, XA, MOD + 2 * D, D, p.norm_mlp, MOD + 4 * D, H, PART);
    GRID_SYNC();
#define GEMM_PHASE_N(EpiT, Aptr, WToff, ...) do { pg8::Gemm g{Aptr, (const bf16_t*)(ws + (WToff)), T, DFF, D}; pg8::StaticOrder S; S.init(T, DFF, G, bx); rstd_prepare(RS, PART, S); \
        EpiT E{__VA_ARGS__}; pg8::gemm_phase<EpiT, pg8::StaticOrder, true, true>(lds, g, S, E); } while (0)
    GEMM_PHASE_N(pg8::EpiStoreN<2>, H, WS_WT_W1, ACT, DFF, BIAS, RS, 0);
    GRID_SYNC();
    GEMM_PHASE(pg8::EpiResidN<true>, ACT, WS_WT_W2, D, DFF, XA, XA, MOD + 5 * D, D, p.norm_mix + D, MOD + 12288 + D, H, PART);
    GRID_SYNC();
    GEMM_PHASE_N(pg8::EpiHgrn, H, WS_WT_HIN, QH, LOGF, VH, GH, (const float*)(ws + WS_LB), 0.08838834764831845f, BIAS + DFF, RS, 0);
    GRID_SYNC();
    hgrn_h1(lds, LOGF, VH, US, DEC);
    GRID_SYNC();
    hgrn_h2(US, SS, DEC);
    GRID_SYNC();
    hgrn_h3(lds, LOGF, QH, VH, GH, SS, p.hgrn_o_gain, ATT);
    GRID_SYNC();
    GEMM_PHASE(pg8::EpiResidN<true>, ATT, WS_WT_HOUT, D, D, XA, XA, MOD + 12288 + 2 * D, D, p.norm_mlp + D, MOD + 12288 + 4 * D, H, PART);
    GRID_SYNC();
    GEMM_PHASE_N(pg8::EpiStoreN<2>, H, WS_WT_W1 + 32 * MiB, ACT, DFF, BIAS + 2 * DFF, RS, 0);
    GRID_SYNC();
    GEMM_PHASE(pg8::EpiResidF, ACT, WS_WT_W2 + 32 * MiB, D, DFF, XA, p.out, MOD + 12288 + 5 * D, D);
}

extern "C" void kernel_launch(void* const* d_in, const int* in_sizes, int n_in, void* d_out, int out_size, void* d_ws, size_t ws_size, hipStream_t stream) {
    static int grid = 0;
    if (grid == 0) {
        if (n_in != 17 || out_size != T * D || ws_size < WS_END) { fprintf(stderr, "kernel_launch: unexpected shapes (n_in %d out %d ws %zu, need %zu)\n", n_in, out_size, ws_size, (size_t)WS_END); grid = -1; return; }
        int dev = 0, cus = 0, per_cu = 0;
        (void)hipGetDevice(&dev);
        (void)hipDeviceGetAttribute(&cus, hipDeviceAttributeMultiprocessorCount, dev);
        (void)hipFuncSetAttribute((const void*)fwd_megakernel, hipFuncAttributeMaxDynamicSharedMemorySize, LDS_BYTES);
        (void)hipOccupancyMaxActiveBlocksPerMultiprocessor(&per_cu, (const void*)fwd_megakernel, 512, LDS_BYTES);
        if (per_cu < 1) { fprintf(stderr, "kernel_launch: occupancy query says %d blocks per CU\n", per_cu); per_cu = 1; }
        grid = cus * per_cu;
        if (grid != 256) { fprintf(stderr, "kernel_launch: built for a 256-workgroup grid (got %d)\n", grid); grid = -1; return; }
    }
    if (grid < 0) return;
    Params p{};
    p.x = (const float*)d_in[0]; p.c = (const float*)d_in[1]; p.mod_w = (const float*)d_in[2]; p.mod_b = (const float*)d_in[3];
    p.norm_mix = (const float*)d_in[4]; p.norm_mlp = (const float*)d_in[5]; p.attn_w_in = (const float*)d_in[6]; p.attn_w_out = (const float*)d_in[7];
    p.attn_q_gain = (const float*)d_in[8]; p.attn_k_gain = (const float*)d_in[9]; p.attn_sinks = (const float*)d_in[10];
    p.hgrn_w_in = (const float*)d_in[11]; p.hgrn_w_out = (const float*)d_in[12]; p.hgrn_o_gain = (const float*)d_in[13]; p.hgrn_lb_logits = (const float*)d_in[14];
    p.mlp_w1 = (const float*)d_in[15]; p.mlp_w2 = (const float*)d_in[16];
    p.out = (float*)d_out; p.ws = (unsigned char*)d_ws;
    (void)hipMemsetAsync((char*)d_ws + WS_BAR, 0, BAR_BYTES, stream);
    void* args[] = {&p};
    hipError_t e = hipLaunchCooperativeKernel((const void*)fwd_megakernel, dim3(grid), dim3(512), args, LDS_BYTES, stream);
    if (e != hipSuccess) fprintf(stderr, "kernel_launch: cooperative launch failed: %s (grid %d)\n", hipGetErrorString(e), grid);
}
```

```cpp
#include <hip/hip_runtime.h>
#include <hip/hip_cooperative_groups.h>
#include <cstdio>
#include <cstdint>
#include <cmath>
namespace pg8 {
#define PG8_LAS __attribute__((address_space(3)))
typedef unsigned short bf16_t;
typedef short bf16x8 __attribute__((ext_vector_type(8)));
typedef float f32x4 __attribute__((ext_vector_type(4)));
typedef unsigned u32x4 __attribute__((ext_vector_type(4)));
constexpr int BM = 256, BK = 64, HALF = 128, HTB = HALF * BK * 2  , STAGE_BYTES = 8 * HTB, NXCD = 8, WGM = 8;

__host__ __device__ __forceinline__ int lds_byte(int r, int c) { const int st = (r >> 4) * 2 + (c >> 5), rr = r & 15, cc = c & 31, ob = rr * 64 + cc * 2; return st * 1024 + (ob ^ (((ob >> 9) & 1) << 5)); }
__host__ __device__ __forceinline__ void stage_rc(int b, int& R, int& C) { const int st = b / 1024, sb = b % 1024, swz = sb ^ (((sb >> 9) & 1) << 5); R = (st >> 1) * 16 + swz / 64; C = (st & 1) * 32 + (swz % 64) / 2; }
__host__ __device__ __forceinline__ int perm32(int rho) { const int n = rho >> 4, i = rho & 15; return 8 * (i >> 2) + 4 * n + (i & 3); }

struct Unit { int pm, pn; };
struct Gemm { const bf16_t* A; const bf16_t* Bt; int M, N, K; };

struct StaticOrder {
    int nM, nN, nwg, G, c;
    __host__ __device__ void init(int M, int N, int G_, int c_) { nM = M / BM; nN = N / BM; nwg = nM * nN; G = G_; c = c_; }
    __host__ __device__ bool next(int i, Unit& u) const {
        const long L = (long)i * G + c; if (L >= nwg) return false;
        int wgid = (int)L; { const int q = nwg / NXCD, r = nwg % NXCD, xcd = wgid % NXCD, off = wgid / NXCD; wgid = (xcd < r ? xcd * (q + 1) : r * (q + 1) + (xcd - r) * q) + off; }
        const int nig = WGM * nN, gid = wgid / nig, fm = gid * WGM, gsz = (nM - fm) < WGM ? (nM - fm) : WGM;
        u.pm = fm + ((wgid % nig) % gsz); u.pn = (wgid % nig) / gsz; return true;
    }
    __device__ __forceinline__ void a_ready(const Unit&) const {}
    __device__ __forceinline__ void done(const Unit&) const {}
};

typedef __bf16 bf16x2_t __attribute__((ext_vector_type(2)));
typedef float f32x2 __attribute__((ext_vector_type(2)));
__device__ __forceinline__ unsigned cvt_pk_bf16(float lo, float hi) { const f32x2 v = {lo, hi}; const bf16x2_t b = __builtin_convertvector(v, bf16x2_t); return __builtin_bit_cast(unsigned, b); }
__device__ __forceinline__ int opaque_tid() { int t = threadIdx.x; asm volatile("" : "+v"(t)); return t; }
typedef unsigned u32x2 __attribute__((ext_vector_type(2)));
__device__ __forceinline__ float fast_rcp(float x) { return __builtin_amdgcn_rcpf(x); }
__device__ __forceinline__ float silu_f(float x) { return x * fast_rcp(1.0f + __expf(-x)); }
template <int ACT> struct EpiStore {
    static constexpr bool PERM = true, AFTER_DRAIN = false;
    bf16_t* O; int ldc;
    __device__ __forceinline__ void operator()(const f32x4 (&acc)[2][2][4][2], const Unit& u, int wr, int wc, int fr, int fq) const {
        const int row0 = u.pm * BM + wr * 64 + fr, col0 = u.pn * BM + wc * 32 + 8 * fq;
#pragma unroll
        for (int ai = 0; ai < 2; ++ai)
#pragma unroll
            for (int m = 0; m < 4; ++m) { bf16_t* rowp = O + (size_t)(row0 + ai * HALF + m * 16) * ldc + col0;
#pragma unroll
                for (int bj = 0; bj < 2; ++bj) { f32x4 v0 = acc[ai][bj][m][0], v1 = acc[ai][bj][m][1];
                    if (ACT == 2) {
#pragma unroll
                        for (int e = 0; e < 4; ++e) { const float a = fmaxf(v0[e], 0.f), b = fmaxf(v1[e], 0.f); v0[e] = a * a; v1[e] = b * b; } }
                    u32x4 w; w.x = cvt_pk_bf16(v0[0], v0[1]); w.y = cvt_pk_bf16(v0[2], v0[3]); w.z = cvt_pk_bf16(v1[0], v1[1]); w.w = cvt_pk_bf16(v1[2], v1[3]);
                    *(u32x4*)(rowp + bj * HALF) = w; } }
    }
};
struct EpiResid {
    static constexpr bool PERM = false, AFTER_DRAIN = false;
    const float* base; float* out; const float* gate; int ldc;
    __device__ __forceinline__ void operator()(const f32x4 (&acc)[2][2][4][2], const Unit& u, int wr, int wc, int fr, int fq) const {
        const int col0 = u.pn * BM + wc * 32 + 4 * fq;
        f32x4 gv[2][2];
#pragma unroll
        for (int bj = 0; bj < 2; ++bj)
#pragma unroll
            for (int n = 0; n < 2; ++n) gv[bj][n] = *(const f32x4*)(gate + col0 + bj * HALF + n * 16);
#pragma unroll
        for (int ai = 0; ai < 2; ++ai)
#pragma unroll
            for (int m = 0; m < 4; ++m) { const size_t off = (size_t)(u.pm * BM + ai * HALF + wr * 64 + m * 16 + fr) * ldc + col0;
#pragma unroll
                for (int bj = 0; bj < 2; ++bj)
#pragma unroll
                    for (int n = 0; n < 2; ++n) { const f32x4 b = *(const f32x4*)(base + off + bj * HALF + n * 16);
                        *(f32x4*)(out + off + bj * HALF + n * 16) = b + gv[bj][n] * acc[ai][bj][m][n]; } }
    }
};
struct EpiHgrn {
    static constexpr bool PERM = true, AFTER_DRAIN = false;
    bf16_t* Qh; bf16_t* LOGF; bf16_t* Vh; bf16_t* Gh; const float* lb; float qscale; const float* bias; const PG8_LAS float* rs; mutable int slot;
    __device__ __forceinline__ void operator()(const f32x4 (&acc)[2][2][4][2], const Unit& u, int wr, int wc, int fr, int fq) const {
        const int type = u.pn >> 3;
        const int row0 = u.pm * BM + wr * 64 + fr, col0 = (u.pn & 7) * BM + wc * 32 + 8 * fq, bcol0 = u.pn * BM + wc * 32 + 8 * fq;
        const PG8_LAS float* rsu = rs + slot * 256 + wr * 64 + fr; ++slot;
        f32x4 bv[2][2];
#pragma unroll
        for (int bj = 0; bj < 2; ++bj) { bv[bj][0] = *(const f32x4*)(bias + bcol0 + bj * HALF); bv[bj][1] = *(const f32x4*)(bias + bcol0 + bj * HALF + 4); }
#pragma unroll
        for (int ai = 0; ai < 2; ++ai)
#pragma unroll
            for (int m = 0; m < 4; ++m) { const size_t roff = (size_t)(row0 + ai * HALF + m * 16) * 2048 + col0; const float rstd = rsu[ai * HALF + m * 16];
#pragma unroll
                for (int bj = 0; bj < 2; ++bj) {
                    f32x4 v0 = acc[ai][bj][m][0] * rstd + bv[bj][0], v1 = acc[ai][bj][m][1] * rstd + bv[bj][1];
                    if (type == 1) {
                        const f32x4 l0 = *(const f32x4*)(lb + col0 + bj * HALF), l1 = *(const f32x4*)(lb + col0 + bj * HALF + 4);
#pragma unroll
                        for (int e = 0; e < 4; ++e) {
                            const float s0 = fast_rcp(1.0f + __expf(-v0[e])), s1 = fast_rcp(1.0f + __expf(-v1[e]));
                            v0[e] = __logf(l0[e] + (1.0f - l0[e]) * s0); v1[e] = __logf(l1[e] + (1.0f - l1[e]) * s1); }
                        u32x4 w; w.x = cvt_pk_bf16(v0[0], v0[1]); w.y = cvt_pk_bf16(v0[2], v0[3]); w.z = cvt_pk_bf16(v1[0], v1[1]); w.w = cvt_pk_bf16(v1[2], v1[3]);
                        *(u32x4*)(LOGF + roff + bj * HALF) = w;
                    } else {
                        if (type == 0) {
#pragma unroll
                            for (int e = 0; e < 4; ++e) { v0[e] = silu_f(v0[e]) * qscale; v1[e] = silu_f(v1[e]) * qscale; }
                        } else if (type == 3) {
#pragma unroll
                            for (int e = 0; e < 4; ++e) { v0[e] = silu_f(v0[e]); v1[e] = silu_f(v1[e]); }
                        }
                        u32x4 w; w.x = cvt_pk_bf16(v0[0], v0[1]); w.y = cvt_pk_bf16(v0[2], v0[3]); w.z = cvt_pk_bf16(v1[0], v1[1]); w.w = cvt_pk_bf16(v1[2], v1[3]);
                        if (type == 0) *(u32x4*)(Qh + roff + bj * HALF) = w;
                        else if (type == 2) *(u32x4*)(Vh + roff + bj * HALF) = w;
                        else *(u32x4*)(Gh + roff + bj * HALF) = w;
                    } } }
    }
};

template <bool BASE_BF16> struct EpiResidN {
    static constexpr bool PERM = true, AFTER_DRAIN = false;
    const void* base; bf16_t* out; const float* gate; int ldc; float* part;
    __device__ __forceinline__ void operator()(const f32x4 (&acc)[2][2][4][2], const Unit& u, int wr, int wc, int fr, int fq) const {
        const int col0 = u.pn * BM + wc * 32 + 8 * fq;
        f32x4 gv[2][2];
#pragma unroll
        for (int bj = 0; bj < 2; ++bj)
#pragma unroll
            for (int n = 0; n < 2; ++n) gv[bj][n] = *(const f32x4*)(gate + col0 + bj * HALF + n * 4);
#pragma unroll
        for (int ai = 0; ai < 2; ++ai)
#pragma unroll
            for (int m = 0; m < 4; ++m) { const int row = u.pm * BM + ai * HALF + wr * 64 + m * 16 + fr; const size_t off = (size_t)row * ldc + col0; float ss = 0.f;
#pragma unroll
                for (int bj = 0; bj < 2; ++bj) { f32x4 b0, b1;
                    if (BASE_BF16) { const u32x4 bb = *(const u32x4*)((const bf16_t*)base + off + bj * HALF);
                        b0 = (f32x4){__uint_as_float(bb.x << 16), __uint_as_float(bb.x & 0xffff0000u), __uint_as_float(bb.y << 16), __uint_as_float(bb.y & 0xffff0000u)};
                        b1 = (f32x4){__uint_as_float(bb.z << 16), __uint_as_float(bb.z & 0xffff0000u), __uint_as_float(bb.w << 16), __uint_as_float(bb.w & 0xffff0000u)}; }
                    else { b0 = *(const f32x4*)((const float*)base + off + bj * HALF); b1 = *(const f32x4*)((const float*)base + off + bj * HALF + 4); }
                    const f32x4 o0 = b0 + gv[bj][0] * acc[ai][bj][m][0], o1 = b1 + gv[bj][1] * acc[ai][bj][m][1];
                    u32x4 ob; ob.x = cvt_pk_bf16(o0[0], o0[1]); ob.y = cvt_pk_bf16(o0[2], o0[3]); ob.z = cvt_pk_bf16(o1[0], o1[1]); ob.w = cvt_pk_bf16(o1[2], o1[3]);
                    *(u32x4*)(out + off + bj * HALF) = ob;
                    ss += ((o0[0] * o0[0] + o0[1] * o0[1]) + (o0[2] * o0[2] + o0[3] * o0[3])) + ((o1[0] * o1[0] + o1[1] * o1[1]) + (o1[2] * o1[2] + o1[3] * o1[3]));
                    }
                ss += __shfl_xor(ss, 16); ss += __shfl_xor(ss, 32);
                if (fq == 0) part[(size_t)row * 32 + u.pn * 4 + wc] = ss; }
    }
};
struct EpiResidF {
    static constexpr bool PERM = true, AFTER_DRAIN = false;
    const bf16_t* base; float* out; const float* gate; int ldc;
    __device__ __forceinline__ void operator()(const f32x4 (&acc)[2][2][4][2], const Unit& u, int wr, int wc, int fr, int fq) const {
        const int col0 = u.pn * BM + wc * 32 + 8 * fq;
        f32x4 gv[2][2];
#pragma unroll
        for (int bj = 0; bj < 2; ++bj)
#pragma unroll
            for (int n = 0; n < 2; ++n) gv[bj][n] = *(const f32x4*)(gate + col0 + bj * HALF + n * 4);
#pragma unroll
        for (int ai = 0; ai < 2; ++ai)
#pragma unroll
            for (int m = 0; m < 4; ++m) { const size_t off = (size_t)(u.pm * BM + ai * HALF + wr * 64 + m * 16 + fr) * ldc + col0;
#pragma unroll
                for (int bj = 0; bj < 2; ++bj) { const u32x4 bb = *(const u32x4*)(base + off + bj * HALF);
                    const f32x4 b0 = {__uint_as_float(bb.x << 16), __uint_as_float(bb.x & 0xffff0000u), __uint_as_float(bb.y << 16), __uint_as_float(bb.y & 0xffff0000u)};
                    const f32x4 b1 = {__uint_as_float(bb.z << 16), __uint_as_float(bb.z & 0xffff0000u), __uint_as_float(bb.w << 16), __uint_as_float(bb.w & 0xffff0000u)};
                    *(f32x4*)(out + off + bj * HALF) = b0 + gv[bj][0] * acc[ai][bj][m][0]; *(f32x4*)(out + off + bj * HALF + 4) = b1 + gv[bj][1] * acc[ai][bj][m][1]; } }
    }
};
template <int ACT> struct EpiStoreN {
    static constexpr bool PERM = true, AFTER_DRAIN = false;
    bf16_t* O; int ldc; const float* bias; const PG8_LAS float* rs; mutable int slot;
    __device__ __forceinline__ void operator()(const f32x4 (&acc)[2][2][4][2], const Unit& u, int wr, int wc, int fr, int fq) const {
        const int row0 = u.pm * BM + wr * 64 + fr, col0 = u.pn * BM + wc * 32 + 8 * fq;
        const PG8_LAS float* rsu = rs + slot * 256 + wr * 64 + fr; ++slot;
        f32x4 bv[2][2];
#pragma unroll
        for (int bj = 0; bj < 2; ++bj) { bv[bj][0] = *(const f32x4*)(bias + col0 + bj * HALF); bv[bj][1] = *(const f32x4*)(bias + col0 + bj * HALF + 4); }
#pragma unroll
        for (int ai = 0; ai < 2; ++ai)
#pragma unroll
            for (int m = 0; m < 4; ++m) { bf16_t* rowp = O + (size_t)(row0 + ai * HALF + m * 16) * ldc + col0; const float rstd = rsu[ai * HALF + m * 16];
#pragma unroll
                for (int bj = 0; bj < 2; ++bj) {
                    f32x4 v0 = acc[ai][bj][m][0] * rstd + bv[bj][0], v1 = acc[ai][bj][m][1] * rstd + bv[bj][1];
                    if (ACT == 2) {
#pragma unroll
                        for (int e = 0; e < 4; ++e) { const float a = fmaxf(v0[e], 0.f), b = fmaxf(v1[e], 0.f); v0[e] = a * a; v1[e] = b * b; } }
                    u32x4 w; w.x = cvt_pk_bf16(v0[0], v0[1]); w.y = cvt_pk_bf16(v0[2], v0[3]); w.z = cvt_pk_bf16(v1[0], v1[1]); w.w = cvt_pk_bf16(v1[2], v1[3]);
                    *(u32x4*)(rowp + bj * HALF) = w; } }
    }
};
template <class Epi, class Sched, bool ALIGN_EPI = false, bool SP2 = false>
__device__ __forceinline__ void gemm_phase(PG8_LAS unsigned char* lds, const Gemm g, const Sched& S, const Epi& E) {
    const int tid = opaque_tid(), wid = __builtin_amdgcn_readfirstlane(tid >> 6), lane = tid & 63, wr = wid >> 2, wc = wid & 3, fr = lane & 15, fq = lane >> 4;
    const int K = g.K, nt = K / BK;
    unsigned voffA[2], voffB[2];
#pragma unroll
    for (int i = 0; i < 2; ++i) { int R, C; stage_rc(tid * 16 + i * 8192, R, C); const int Rb = Epi::PERM ? ((R & ~31) + perm32(R & 31)) : R;
        voffA[i] = (unsigned)(R * K + C) * 2u; voffB[i] = (unsigned)(Rb * K + C) * 2u; }
    const size_t kstep = (size_t)(BK * 2);
    const size_t hstep = (size_t)HALF * K * 2;
    const size_t tstep = 2 * hstep;
    const unsigned ldsw = (unsigned)wid * 1024u;
    const int aoff = lds_byte(wr * 64 + fr, fq * 8), boff = lds_byte(wc * 32 + fr, fq * 8);
#define PG8_SA(b, h) (((b) * 2 + (h)) * HTB)
#define PG8_SB(b, h) ((4 + (b) * 2 + (h)) * HTB)
#define PG8_STAGE(bufoff, gbase, voff) do { _Pragma("unroll") for (int _i = 0; _i < 2; ++_i) \
        __builtin_amdgcn_global_load_lds((const unsigned*)((const char*)(gbase) + (voff)[_i]), (PG8_LAS unsigned*)(lds + (bufoff) + ldsw + _i * 8192), 16, 0, 0); } while (0)
#define PG8_LDA(dst, b, h) do { _Pragma("unroll") for (int m = 0; m < 4; ++m) _Pragma("unroll") for (int k = 0; k < 2; ++k) dst[m][k] = *(const PG8_LAS bf16x8*)(lds + PG8_SA(b, h) + aoff + m * 2048 + k * 1024); } while (0)
#define PG8_LDB(dst, b, h) do { _Pragma("unroll") for (int n = 0; n < 2; ++n) _Pragma("unroll") for (int k = 0; k < 2; ++k) dst[n][k] = *(const PG8_LAS bf16x8*)(lds + PG8_SB(b, h) + boff + n * 2048 + k * 1024); } while (0)
#define PG8_MMA(ai, bj, At, Bt) do { __builtin_amdgcn_s_setprio(1); _Pragma("unroll") for (int m = 0; m < 4; ++m) _Pragma("unroll") for (int n = 0; n < 2; ++n) _Pragma("unroll") for (int k = 0; k < 2; ++k) \
        acc[ai][bj][m][n] = __builtin_amdgcn_mfma_f32_16x16x32_bf16(Bt[n][k], At[m][k], acc[ai][bj][m][n], 0, 0, 0); __builtin_amdgcn_s_setprio(0); } while (0)
#define PG8_WAIT_V(n) asm volatile("s_waitcnt vmcnt(" #n ")" ::: "memory")
#define PG8_WAIT_L(n) asm volatile("s_waitcnt lgkmcnt(" #n ")" ::: "memory")
#define PG8_BAR __builtin_amdgcn_s_barrier()
#define PG8_SCHED __builtin_amdgcn_sched_barrier(0)
    Unit cur, nxt; int ui = 0;
    if (!S.next(0, cur)) return;
    f32x4 acc[2][2][4][2];
#pragma unroll
    for (int a = 0; a < 2; ++a)
#pragma unroll
        for (int b = 0; b < 2; ++b)
#pragma unroll
            for (int m = 0; m < 4; ++m)
#pragma unroll
                for (int n = 0; n < 2; ++n) acc[a][b][m][n] = (f32x4){0.f, 0.f, 0.f, 0.f};
    bf16x8 At[4][2], B0[2][2], B1[2][2];
    const char* cA = (const char*)g.A + (size_t)cur.pm * tstep; const char* cB = (const char*)g.Bt + (size_t)cur.pn * tstep;
    S.a_ready(cur);
    if constexpr (SP2) {
        PG8_STAGE(PG8_SB(0, 0), cB, voffB); PG8_STAGE(PG8_SB(0, 1), cB + hstep, voffB); PG8_STAGE(PG8_SA(0, 0), cA, voffA); PG8_STAGE(PG8_SA(0, 1), cA + hstep, voffA);
        if (wr == 1) PG8_BAR;
        PG8_WAIT_V(2); PG8_BAR;
        PG8_STAGE(PG8_SB(1, 0), cB + kstep, voffB); PG8_STAGE(PG8_SA(1, 0), cA + kstep, voffA); PG8_STAGE(PG8_SB(1, 1), cB + hstep + kstep, voffB);
        PG8_WAIT_V(6); PG8_BAR;
    } else {
        PG8_STAGE(PG8_SB(0, 0), cB, voffB); PG8_STAGE(PG8_SA(0, 0), cA, voffA); PG8_STAGE(PG8_SB(0, 1), cB + hstep, voffB); PG8_STAGE(PG8_SA(0, 1), cA + hstep, voffA);
        if (wr == 1) PG8_BAR;
        PG8_WAIT_V(4); PG8_BAR;
        PG8_STAGE(PG8_SB(1, 0), cB + kstep, voffB); PG8_STAGE(PG8_SA(1, 0), cA + kstep, voffA); PG8_STAGE(PG8_SB(1, 1), cB + hstep + kstep, voffB);
        PG8_WAIT_V(6); PG8_BAR;
    }
    for (;;) {
        const bool has_next = S.next(ui + 1, nxt);
        const char* nA = has_next ? (const char*)g.A + (size_t)nxt.pm * tstep : cA; const char* nB = has_next ? (const char*)g.Bt + (size_t)nxt.pn * tstep : cB;
        for (int t = 0; t < nt; t += 2) {
            const bool last = (t == nt - 2);
            const char* a1 = cA + (size_t)(t + 1) * kstep;
            const char* a2 = last ? nA : cA + (size_t)(t + 2) * kstep; const char* b2 = last ? nB : cB + (size_t)(t + 2) * kstep;
            const char* a3 = a2 + kstep; const char* b3 = b2 + kstep;
            if (last && has_next) S.a_ready(nxt);
            if constexpr (SP2) {
            PG8_LDB(B0, 0, 0); PG8_LDB(B1, 0, 1); PG8_SCHED; PG8_LDA(At, 0, 0); PG8_STAGE(PG8_SA(1, 1), a1 + hstep, voffA);
            PG8_WAIT_V(8); PG8_WAIT_L(0); PG8_BAR; PG8_MMA(0, 0, At, B0); PG8_MMA(0, 1, At, B1); PG8_BAR; PG8_SCHED;
            PG8_LDA(At, 0, 1); PG8_STAGE(PG8_SB(0, 0), b2, voffB); PG8_STAGE(PG8_SB(0, 1), b2 + hstep, voffB); PG8_STAGE(PG8_SA(0, 0), a2, voffA);
            PG8_WAIT_V(8); PG8_WAIT_L(0); PG8_BAR; PG8_MMA(1, 0, At, B0); PG8_MMA(1, 1, At, B1); PG8_BAR; PG8_SCHED;
            PG8_LDB(B0, 1, 0); PG8_LDB(B1, 1, 1); PG8_SCHED; PG8_LDA(At, 1, 0); PG8_STAGE(PG8_SA(0, 1), a2 + hstep, voffA);
            PG8_WAIT_V(8); PG8_WAIT_L(0); PG8_BAR; PG8_MMA(0, 0, At, B0); PG8_MMA(0, 1, At, B1); PG8_BAR; PG8_SCHED;
            PG8_LDA(At, 1, 1); PG8_STAGE(PG8_SB(1, 0), b3, voffB); PG8_STAGE(PG8_SB(1, 1), b3 + hstep, voffB); PG8_STAGE(PG8_SA(1, 0), a3, voffA);
            PG8_WAIT_V(8); PG8_WAIT_L(0); PG8_BAR; PG8_MMA(1, 0, At, B0); PG8_MMA(1, 1, At, B1); PG8_BAR; PG8_SCHED;
            } else {
            PG8_LDB(B0, 0, 0); PG8_SCHED; PG8_LDA(At, 0, 0); PG8_STAGE(PG8_SA(1, 1), a1 + hstep, voffA);
            PG8_WAIT_L(8); PG8_BAR; PG8_WAIT_L(0); PG8_MMA(0, 0, At, B0); PG8_BAR; PG8_SCHED;
            PG8_LDB(B1, 0, 1); PG8_STAGE(PG8_SB(0, 0), b2, voffB);
            PG8_BAR; PG8_WAIT_L(0); PG8_MMA(0, 1, At, B1); PG8_BAR;
            PG8_LDA(At, 0, 1); PG8_STAGE(PG8_SA(0, 0), a2, voffA);
            PG8_BAR; PG8_WAIT_L(0); PG8_MMA(1, 0, At, B0); PG8_BAR; PG8_SCHED;
            PG8_STAGE(PG8_SB(0, 1), b2 + hstep, voffB);
            PG8_WAIT_V(6); PG8_BAR; PG8_MMA(1, 1, At, B1); PG8_BAR;
            PG8_LDB(B0, 1, 0); PG8_SCHED; PG8_LDA(At, 1, 0); PG8_STAGE(PG8_SA(0, 1), a2 + hstep, voffA);
            PG8_WAIT_L(8); PG8_BAR; PG8_WAIT_L(0); PG8_MMA(0, 0, At, B0); PG8_BAR; PG8_SCHED;
            PG8_LDB(B1, 1, 1); PG8_STAGE(PG8_SB(1, 0), b3, voffB);
            PG8_BAR; PG8_WAIT_L(0); PG8_MMA(0, 1, At, B1); PG8_BAR;
            PG8_LDA(At, 1, 1); PG8_STAGE(PG8_SA(1, 0), a3, voffA);
            PG8_BAR; PG8_WAIT_L(0); PG8_MMA(1, 0, At, B0); PG8_BAR; PG8_SCHED;
            PG8_STAGE(PG8_SB(1, 1), b3 + hstep, voffB);
            PG8_WAIT_V(6); PG8_BAR; PG8_MMA(1, 1, At, B1); PG8_BAR;
            }
        }
        if constexpr (ALIGN_EPI) { if (wr == 0) PG8_BAR; }
        if constexpr (!Epi::AFTER_DRAIN) { E(acc, cur, wr, wc, fr, fq); S.done(cur); }
        if (!has_next) break;
#pragma unroll
        for (int a = 0; a < 2; ++a)
#pragma unroll
            for (int b = 0; b < 2; ++b)
#pragma unroll
                for (int m = 0; m < 4; ++m)
#pragma unroll
                    for (int n = 0; n < 2; ++n) acc[a][b][m][n] = (f32x4){0.f, 0.f, 0.f, 0.f};
        cur = nxt; cA = nA; cB = nB; ++ui;
        if constexpr (ALIGN_EPI) { if (wr == 1) PG8_BAR; }
    }
    PG8_WAIT_V(0);
    if constexpr (!ALIGN_EPI) { if (wr == 0) PG8_BAR; }
    PG8_BAR;
    if constexpr (Epi::AFTER_DRAIN) { E.fused(acc, cur, wr, wc, fr, fq, lds, wid, lane); S.done(cur); }
#undef PG8_SA
#undef PG8_SB
#undef PG8_STAGE
#undef PG8_LDA
#undef PG8_LDB
#undef PG8_MMA
#undef PG8_WAIT_V
#undef PG8_WAIT_L
#undef PG8_BAR
#undef PG8_SCHED
}
}

namespace cg = cooperative_groups;
#define LAS __attribute__((address_space(3)))
typedef unsigned short bf16_t;
typedef short bf16x8 __attribute__((ext_vector_type(8)));
typedef float f32x4 __attribute__((ext_vector_type(4)));
typedef float f32x2 __attribute__((ext_vector_type(2)));
typedef unsigned u32x4 __attribute__((ext_vector_type(4)));
typedef unsigned u32x2 __attribute__((ext_vector_type(2)));
using pg8::cvt_pk_bf16;

constexpr int T = 8192, D = 2048, DFF = 8192, NQKV = 2560;
constexpr int LDS_BYTES = 147456;
constexpr float EPS = 1e-6f;
constexpr size_t MiB = 1u << 20;
constexpr size_t WS_MOD = 0;
constexpr size_t WS_LB = 128 * 1024;
constexpr size_t WS_BIAS = 512 * 1024;
constexpr size_t WS_PART = 1 * MiB;
constexpr int RS_OFF = 131072;
constexpr size_t WS_BAR = 256 * 1024, BAR_BYTES = 16384;
constexpr int MODCNT_WORD = 3600;
constexpr int MISC_OFF = LDS_BYTES - 64;
constexpr size_t WS_WT_AIN = 2 * MiB, WS_WT_AOUT = 12 * MiB, WS_WT_HIN = 20 * MiB, WS_WT_HOUT = 52 * MiB;
constexpr size_t WS_WT_W1 = 60 * MiB  , WS_WT_W2 = 124 * MiB  ;
constexpr size_t WS_H = 188 * MiB, WS_QKV = 220 * MiB, WS_ATT = 260 * MiB, WS_XA = 292 * MiB, WS_ACT = 356 * MiB;
constexpr size_t WS_QH = 484 * MiB, WS_LOGF = 516 * MiB, WS_VH = 580 * MiB, WS_GH = 220 * MiB, WS_US = 612 * MiB, WS_SS = 676 * MiB, WS_DEC = 740 * MiB, WS_END = 741 * MiB;

__device__ __forceinline__ float bflo(unsigned u) { return __uint_as_float(u << 16); }
__device__ __forceinline__ float bfhi(unsigned u) { return __uint_as_float(u & 0xffff0000u); }
__device__ __forceinline__ float bf2f(bf16_t u) { return __uint_as_float((unsigned)u << 16); }
__device__ __forceinline__ float wave_sum(float v) {
#pragma unroll
    for (int o = 1; o < 64; o <<= 1) v += __shfl_xor(v, o);
    return v;
}
__device__ __forceinline__ f32x4 mfma16(bf16x8 a, bf16x8 b, f32x4 c) { return __builtin_amdgcn_mfma_f32_16x16x32_bf16(a, b, c, 0, 0, 0); }
__device__ __forceinline__ bf16x8 as_bf16x8(u32x4 v) { return __builtin_bit_cast(bf16x8, v); }

struct Params {
    const float* x; const float* c; const float* mod_w; const float* mod_b; const float* norm_mix; const float* norm_mlp;
    const float* attn_w_in; const float* attn_w_out; const float* attn_q_gain; const float* attn_k_gain; const float* attn_sinks;
    const float* hgrn_w_in; const float* hgrn_w_out; const float* hgrn_o_gain; const float* hgrn_lb_logits; const float* mlp_w1; const float* mlp_w2;
    float* out; unsigned char* ws;
};

__device__ __forceinline__ void p0_transpose_item(const float* W, int K, int N, bf16_t* WT, LAS float* scr, int item, int lane) {
    const int nblk = N / 32, kb = item / nblk, nb = item % nblk, k0 = 64 * kb, n0 = 32 * nb;
#pragma unroll 8
    for (int i = 0; i < 32; ++i) { const int kk = 2 * i + (lane >> 5); scr[kk * 33 + (lane & 31)] = W[(size_t)(k0 + kk) * N + n0 + (lane & 31)]; }
    asm volatile("s_waitcnt lgkmcnt(0)" ::: "memory");
    const int c = lane & 7;
#pragma unroll
    for (int j = 0; j < 4; ++j) { const int n = (lane >> 3) + 8 * j; const LAS float* s = scr + (8 * c) * 33 + n;
        u32x4 o; o.x = cvt_pk_bf16(s[0 * 33], s[1 * 33]); o.y = cvt_pk_bf16(s[2 * 33], s[3 * 33]); o.z = cvt_pk_bf16(s[4 * 33], s[5 * 33]); o.w = cvt_pk_bf16(s[6 * 33], s[7 * 33]);
        *(u32x4*)(WT + (size_t)(n0 + n) * K + k0 + 8 * c) = o; }
    asm volatile("s_waitcnt lgkmcnt(0)" ::: "memory");
}

__device__ __forceinline__ void p0_transpose_item_scaled(const float* W, int K, int N, bf16_t* WT, LAS float* scr, int item, int lane, const float* gain, const float* sc) {
    const int nblk = N / 32, kb = item / nblk, nb = item % nblk, k0 = 64 * kb, n0 = 32 * nb;
#pragma unroll 8
    for (int i = 0; i < 32; ++i) { const int kk = 2 * i + (lane >> 5); scr[kk * 33 + (lane & 31)] = W[(size_t)(k0 + kk) * N + n0 + (lane & 31)] * (gain[k0 + kk] * (1.0f + sc[k0 + kk])); }
    asm volatile("s_waitcnt lgkmcnt(0)" ::: "memory");
    const int c = lane & 7;
#pragma unroll
    for (int j = 0; j < 4; ++j) { const int n = (lane >> 3) + 8 * j; const LAS float* s = scr + (8 * c) * 33 + n;
        u32x4 o; o.x = cvt_pk_bf16(s[0 * 33], s[1 * 33]); o.y = cvt_pk_bf16(s[2 * 33], s[3 * 33]); o.z = cvt_pk_bf16(s[4 * 33], s[5 * 33]); o.w = cvt_pk_bf16(s[6 * 33], s[7 * 33]);
        *(u32x4*)(WT + (size_t)(n0 + n) * K + k0 + 8 * c) = o; }
    asm volatile("s_waitcnt lgkmcnt(0)" ::: "memory");
}

__device__ __forceinline__ void prologue_phase(LAS unsigned char* lds, const Params& p) {
    const int tid = pg8::opaque_tid(), lane = tid & 63, wave = tid >> 6;
    float* MOD = (float*)(p.ws + WS_MOD); float* LB = (float*)(p.ws + WS_LB);
    for (int i = blockIdx.x * 512 + tid; i < 2048; i += gridDim.x * 512) { const float l0 = p.hgrn_lb_logits[i], l1 = p.hgrn_lb_logits[2048 + i]; LB[i] = 1.0f / (1.0f + expf(l0 - l1)); }
    {
        LAS float* cond = (LAS float*)lds; LAS f32x4* red = (LAS f32x4*)(lds + 8192);
        for (int i = tid; i < 2048; i += 512) { const float c = p.c[i]; cond[i] = c / (1.0f + expf(-c)); }
        __syncthreads();
        for (int slice = blockIdx.x; slice < 256; slice += gridDim.x) {
            const int layer = slice >> 7, col0 = (slice & 127) * 96, cgp = tid % 24, kr = tid / 24;
            f32x4 acc = {0.f, 0.f, 0.f, 0.f};
            if (kr < 21) {
                const float* W = p.mod_w + (size_t)layer * 2048 * 12288 + col0 + 4 * cgp;
#pragma unroll 4
                for (int k = kr; k < 2048; k += 21) { const f32x4 w = __builtin_nontemporal_load((const f32x4*)(W + (size_t)k * 12288)); acc += w * cond[k]; }
                red[kr * 24 + cgp] = acc;
            }
            __syncthreads();
            if (tid < 96) { float s = p.mod_b[layer * 12288 + col0 + tid];
                for (int r = 0; r < 21; ++r) s += ((LAS float*)red)[r * 96 + tid];
                MOD[layer * 12288 + col0 + tid] = s; }
            __syncthreads();
        }
    }
    asm volatile("s_waitcnt vmcnt(0)" ::: "memory");
    __syncthreads();
    if (tid == 0) { __builtin_amdgcn_fence(__ATOMIC_RELEASE, "agent"); asm volatile("s_waitcnt vmcnt(0)" ::: "memory");
        (void)__hip_atomic_fetch_add((unsigned*)(p.ws + WS_BAR) + MODCNT_WORD, 1u, __ATOMIC_RELAXED, __HIP_MEMORY_SCOPE_AGENT); }
    LAS float* scr = (LAS float*)(lds + wave * 16384);
    const int gw = blockIdx.x * 8 + wave, NGW = gridDim.x * 8;
    constexpr int I_AIN = (D / 64) * (NQKV / 32), I_SQ = (D / 64) * (D / 32), I_BIG = (D / 64) * (DFF / 32);
    {
        constexpr int NITEMS = I_AIN + 2 * I_SQ + 2 * I_BIG;
        for (int it = gw; it < NITEMS; it += NGW) {
            int r = it;
            if (r < I_AIN) { p0_transpose_item(p.attn_w_in, D, NQKV, (bf16_t*)(p.ws + WS_WT_AIN), scr, r, lane); continue; } r -= I_AIN;
            if (r < I_SQ) { p0_transpose_item(p.attn_w_out, D, D, (bf16_t*)(p.ws + WS_WT_AOUT), scr, r, lane); continue; } r -= I_SQ;
            if (r < I_SQ) { p0_transpose_item(p.hgrn_w_out, D, D, (bf16_t*)(p.ws + WS_WT_HOUT), scr, r, lane); continue; } r -= I_SQ;
            if (r < I_BIG) { p0_transpose_item(p.mlp_w2, DFF, D, (bf16_t*)(p.ws + WS_WT_W2), scr, r, lane); continue; } r -= I_BIG;
            p0_transpose_item(p.mlp_w2 + (size_t)D * DFF, DFF, D, (bf16_t*)(p.ws + WS_WT_W2 + 32 * MiB), scr, r, lane);
        }
    }
    {
        __syncthreads();
        if (tid == 0) { unsigned* cnt = (unsigned*)(p.ws + WS_BAR) + MODCNT_WORD; unsigned sp = 0;
            while (__hip_atomic_load(cnt, __ATOMIC_RELAXED, __HIP_MEMORY_SCOPE_AGENT) < gridDim.x) { __builtin_amdgcn_s_sleep(2); if (++sp > (1u << 22)) break; }
            __builtin_amdgcn_fence(__ATOMIC_ACQUIRE, "agent"); asm volatile("s_waitcnt vmcnt(0)" ::: "memory"); }
        __syncthreads();
    }
    {
        const float* MODc = (const float*)(p.ws + WS_MOD);
        for (int it = gw; it < 3 * I_BIG; it += NGW) {
            int r = it;
            if (r < I_BIG) { p0_transpose_item_scaled(p.mlp_w1, D, DFF, (bf16_t*)(p.ws + WS_WT_W1), scr, r, lane, p.norm_mlp, MODc + 4 * D); continue; } r -= I_BIG;
            if (r < I_BIG) { p0_transpose_item_scaled(p.hgrn_w_in, D, DFF, (bf16_t*)(p.ws + WS_WT_HIN), scr, r, lane, p.norm_mix + D, MODc + 12288 + D); continue; } r -= I_BIG;
            p0_transpose_item_scaled(p.mlp_w1 + (size_t)D * DFF, D, DFF, (bf16_t*)(p.ws + WS_WT_W1 + 32 * MiB), scr, r, lane, p.norm_mlp + D, MODc + 12288 + 4 * D);
        }
    }
    __syncthreads();
}

__device__ __forceinline__ void norm_phase(LAS unsigned char* lds, const float* xin, const float* gain, const float* sh, const float* sc, bf16_t* out) {
    const int tid = pg8::opaque_tid(), lane = tid & 63, wave = tid >> 6;
    LAS float* Av = (LAS float*)lds; LAS float* Bv = (LAS float*)(lds + 8192);
    for (int i = tid; i < 2048; i += 512) { Av[i] = gain[i] * (1.0f + sc[i]); Bv[i] = sh[i]; }
    __syncthreads();
    const int gw = blockIdx.x * 8 + wave, NGW = gridDim.x * 8;
    for (int m = gw; m < T; m += 2 * NGW) {
        const int m2 = m + NGW < T ? m + NGW : m;
        const f32x4* xr = (const f32x4*)(xin + (size_t)m * D) + lane; const f32x4* xr2 = (const f32x4*)(xin + (size_t)m2 * D) + lane;
        f32x4 v[8], v2[8]; float s = 0.f, s2 = 0.f;
#pragma unroll
        for (int j = 0; j < 8; ++j) { v[j] = xr[64 * j]; v2[j] = xr2[64 * j]; }
#pragma unroll
        for (int j = 0; j < 8; ++j) { s += (v[j].x * v[j].x + v[j].y * v[j].y) + (v[j].z * v[j].z + v[j].w * v[j].w); s2 += (v2[j].x * v2[j].x + v2[j].y * v2[j].y) + (v2[j].z * v2[j].z + v2[j].w * v2[j].w); }
        const float rstd = rsqrtf(wave_sum(s) * (1.0f / D) + EPS), rstd2 = rsqrtf(wave_sum(s2) * (1.0f / D) + EPS);
        u32x2* o8 = (u32x2*)(out + (size_t)m * D) + lane; u32x2* o82 = (u32x2*)(out + (size_t)m2 * D) + lane;
#pragma unroll
        for (int j = 0; j < 8; ++j) { const f32x4 a = ((LAS f32x4*)Av)[lane + 64 * j], b = ((LAS f32x4*)Bv)[lane + 64 * j];
            const f32x4 y = v[j] * rstd * a + b, y2 = v2[j] * rstd2 * a + b; u32x2 w, w2; w.x = cvt_pk_bf16(y.x, y.y); w.y = cvt_pk_bf16(y.z, y.w); w2.x = cvt_pk_bf16(y2.x, y2.y); w2.y = cvt_pk_bf16(y2.z, y2.w);
            o8[64 * j] = w; if (m2 != m) o82[64 * j] = w2; }
    }
    __syncthreads();
}


__device__ __forceinline__ void rstd_prepare(LAS float* rs, const float* part, const pg8::StaticOrder& S) {
    const int tid = pg8::opaque_tid(), j = tid >> 7, r0 = (tid & 127) * 2; pg8::Unit u;
    if (S.next(j, u)) {
#pragma unroll
        for (int rr = 0; rr < 2; ++rr) { const f32x4* pp = (const f32x4*)(part + (size_t)(u.pm * 256 + r0 + rr) * 32); float s = 0.f;
#pragma unroll
            for (int i = 0; i < 8; ++i) { const f32x4 v = pp[i]; s += (v.x + v.y) + (v.z + v.w); }
            rs[j * 256 + r0 + rr] = rsqrtf(s * (1.0f / D) + EPS); }
    }
    __syncthreads();
}
__device__ __forceinline__ void bias_gemv(const float* sh, const float* gain, const float* sc, const bf16_t* WT, float* bias, int nrows, int wave_id, int nwaves) {
    const int lane = pg8::opaque_tid() & 63;
    float shv[32];
#pragma unroll
    for (int i = 0; i < 4; ++i)
#pragma unroll
        for (int e = 0; e < 8; ++e) { const int k = (lane + 64 * i) * 8 + e; shv[8 * i + e] = sh[k] / (gain[k] * (1.0f + sc[k])); }
    for (int row = wave_id; row < nrows; row += 4 * nwaves) {
        u32x4 v[4][4];
#pragma unroll
        for (int q = 0; q < 4; ++q) { const int rq = row + q * nwaves < nrows ? row + q * nwaves : row; const u32x4* pr = (const u32x4*)(WT + (size_t)rq * D) + lane;
#pragma unroll
            for (int i = 0; i < 4; ++i) v[q][i] = pr[64 * i]; }
#pragma unroll
        for (int q = 0; q < 4; ++q) { float a = 0.f;
#pragma unroll
            for (int i = 0; i < 4; ++i)
#pragma unroll
                for (int e = 0; e < 4; ++e) a += bflo(v[q][i][e]) * shv[8 * i + 2 * e] + bfhi(v[q][i][e]) * shv[8 * i + 2 * e + 1];
            a = wave_sum(a);
            if (lane == 0 && row + q * nwaves < nrows) bias[row + q * nwaves] = a; }
    }
}

__device__ __forceinline__ void attn_phase(LAS unsigned char* lds, const bf16_t* QKV, const float* qg, const float* kg, const float* sinks, bf16_t* ATT) {
    constexpr int LDQ = NQKV, KST = 72, VST = 280;
    LAS bf16_t* Ks = (LAS bf16_t*)lds;
    LAS bf16_t* Vt = (LAS bf16_t*)(lds + 272 * KST * 2);
    const int tid = pg8::opaque_tid(), lane = tid & 63, wid = tid >> 6, fr = lane & 15, fq = lane >> 4;
    for (int unit = blockIdx.x; unit < 256; unit += gridDim.x) {
        const int kvh = unit & 3, nb = unit >> 2;
        u32x4 q0n, q1n;
        { const u32x4* qp = (const u32x4*)(QKV + (size_t)(nb * 128 + fr) * LDQ + (kvh * 8 + wid) * 64 + 8 * fq); q0n = qp[0]; q1n = qp[4]; }
        {
            const int kp = tid >> 1, half = tid & 1, s_abs = (nb - 1) * 128 + kp;
            u32x4 kr[4], vr[4];
#pragma unroll
            for (int i = 0; i < 4; ++i) { kr[i] = (u32x4){0u, 0u, 0u, 0u}; vr[i] = (u32x4){0u, 0u, 0u, 0u}; }
            if (s_abs >= 0) {
                const u32x4* kptr = (const u32x4*)(QKV + (size_t)s_abs * LDQ + 2048 + kvh * 64 + half * 32);
                const u32x4* vptr = (const u32x4*)(QKV + (size_t)s_abs * LDQ + 2304 + kvh * 64 + half * 32);
#pragma unroll
                for (int i = 0; i < 4; ++i) { kr[i] = kptr[i]; vr[i] = vptr[i]; }
            }
            float ss = 0.f;
#pragma unroll
            for (int i = 0; i < 4; ++i)
#pragma unroll
                for (int e = 0; e < 4; ++e) { const float a = bflo(kr[i][e]), b = bfhi(kr[i][e]); ss += a * a + b * b; }
            ss += __shfl_xor(ss, 1);
            const float rstd = rsqrtf(ss * (1.0f / 64.0f) + EPS);
#pragma unroll
            for (int i = 0; i < 4; ++i) { u32x4 w;
#pragma unroll
                for (int e = 0; e < 4; ++e) { const int d = half * 32 + i * 8 + e * 2; w[e] = cvt_pk_bf16(bflo(kr[i][e]) * rstd * kg[d], bfhi(kr[i][e]) * rstd * kg[d + 1]); }
                *(LAS u32x4*)(Ks + kp * KST + half * 32 + i * 8) = w; }
#pragma unroll
            for (int i = 0; i < 4; ++i)
#pragma unroll
                for (int e = 0; e < 4; ++e) { const int d = half * 32 + i * 8 + e * 2;
                    Vt[d * VST + kp] = (bf16_t)(vr[i][e] & 0xffffu); Vt[(d + 1) * VST + kp] = (bf16_t)(vr[i][e] >> 16); }
            for (int e = tid; e < 16 * KST / 2; e += 512) ((LAS unsigned*)(Ks + 256 * KST))[e] = 0u;
            for (int e = tid; e < 64 * 16; e += 512) Vt[(e >> 4) * VST + 256 + (e & 15)] = (bf16_t)0;
        }
        __syncthreads();
        const int h = kvh * 8 + wid;
        const float LOG2E = 1.4426950408889634f;
        const float slope = exp2f(-0.25f * (float)(h + 1)) * LOG2E, sink = sinks[h] * LOG2E;
        float qgv[16];
#pragma unroll
        for (int e = 0; e < 8; ++e) { qgv[e] = qg[8 * fq + e] * (0.125f * LOG2E); qgv[8 + e] = qg[32 + 8 * fq + e] * (0.125f * LOG2E); }
        float ar[4]; bool m0[4];
#pragma unroll
        for (int r = 0; r < 4; ++r) { ar[r] = slope * (float)(128 + fr - 4 * fq - r); m0[r] = fr < 4 * fq + r; }
        const float s16 = slope * 16.0f;
        for (int mt = 0; mt < 8; ++mt) {
            const int qi = 16 * mt + fr, t_abs = nb * 128 + qi;
            const u32x4 q0 = q0n, q1 = q1n;
            if (mt < 7) { const u32x4* qp = (const u32x4*)(QKV + (size_t)(t_abs + 16) * LDQ + h * 64 + 8 * fq); q0n = qp[0]; q1n = qp[4]; }
            float qf[16]; float ss = 0.f;
#pragma unroll
            for (int e = 0; e < 4; ++e) { qf[2 * e] = bflo(q0[e]); qf[2 * e + 1] = bfhi(q0[e]); qf[8 + 2 * e] = bflo(q1[e]); qf[8 + 2 * e + 1] = bfhi(q1[e]); }
#pragma unroll
            for (int e = 0; e < 16; ++e) ss += qf[e] * qf[e];
            ss += __shfl_xor(ss, 16); ss += __shfl_xor(ss, 32);
            const float rstd = rsqrtf(ss * (1.0f / 64.0f) + EPS);
            u32x4 qa, qb;
#pragma unroll
            for (int e = 0; e < 4; ++e) { qa[e] = cvt_pk_bf16(qf[2 * e] * rstd * qgv[2 * e], qf[2 * e + 1] * rstd * qgv[2 * e + 1]);
                                          qb[e] = cvt_pk_bf16(qf[8 + 2 * e] * rstd * qgv[8 + 2 * e], qf[8 + 2 * e + 1] * rstd * qgv[8 + 2 * e + 1]); }
            const bf16x8 Q0 = as_bf16x8(qa), Q1 = as_bf16x8(qb);
            f32x4 S[10];
#pragma unroll
            for (int jj = 0; jj < 9; ++jj) {
                const LAS bf16_t* kp_ = Ks + (16 * (mt + jj) + fr) * KST + 8 * fq;
                const bf16x8 K0 = *(const LAS bf16x8*)kp_, K1 = *(const LAS bf16x8*)(kp_ + 32);
                f32x4 a = {0.f, 0.f, 0.f, 0.f};
                a = mfma16(K0, Q0, a); a = mfma16(K1, Q1, a); S[jj] = a;
            }
            float mx = sink;
#pragma unroll
            for (int jj = 0; jj < 9; ++jj)
#pragma unroll
                for (int r = 0; r < 4; ++r) {
                    float lg = S[jj][r] - (ar[r] - s16 * (float)jj);
                    if (jj == 0) lg = m0[r] ? lg : -INFINITY;
                    if (jj == 8) lg = m0[r] ? -INFINITY : lg;
                    if (nb == 0) lg = (16 * (mt + jj) + 4 * fq + r >= 128) ? lg : -INFINITY;
                    S[jj][r] = lg; mx = fmaxf(mx, lg);
                }
            mx = fmaxf(mx, __shfl_xor(mx, 16)); mx = fmaxf(mx, __shfl_xor(mx, 32));
            float sum = 0.f;
#pragma unroll
            for (int jj = 0; jj < 9; ++jj)
#pragma unroll
                for (int r = 0; r < 4; ++r) { const float pv = __builtin_amdgcn_exp2f(S[jj][r] - mx); S[jj][r] = pv; sum += pv; }
            S[9] = (f32x4){0.f, 0.f, 0.f, 0.f};
            sum += __shfl_xor(sum, 16); sum += __shfl_xor(sum, 32);
            sum += __builtin_amdgcn_exp2f(sink - mx);
            const float inv = 1.0f / sum;
            f32x4 O[4];
#pragma unroll
            for (int dt = 0; dt < 4; ++dt) O[dt] = (f32x4){0.f, 0.f, 0.f, 0.f};
#pragma unroll
            for (int pp = 0; pp < 5; ++pp) {
                u32x4 pw; pw.x = cvt_pk_bf16(S[2 * pp][0], S[2 * pp][1]); pw.y = cvt_pk_bf16(S[2 * pp][2], S[2 * pp][3]);
                pw.z = cvt_pk_bf16(S[2 * pp + 1][0], S[2 * pp + 1][1]); pw.w = cvt_pk_bf16(S[2 * pp + 1][2], S[2 * pp + 1][3]);
                const bf16x8 P = as_bf16x8(pw);
                const int ka = 16 * (mt + 2 * pp) + 4 * fq;
#pragma unroll
                for (int dt = 0; dt < 4; ++dt) {
                    const LAS bf16_t* vrow = Vt + (16 * dt + fr) * VST + ka;
                    const u32x2 va = *(const LAS u32x2*)vrow, vb = *(const LAS u32x2*)(vrow + 16);
                    u32x4 vw; vw.x = va.x; vw.y = va.y; vw.z = vb.x; vw.w = vb.y;
                    O[dt] = mfma16(as_bf16x8(vw), P, O[dt]);
                }
            }
            bf16_t* orow = ATT + (size_t)t_abs * D + h * 64 + 4 * fq;
#pragma unroll
            for (int dt = 0; dt < 4; ++dt) { u32x2 w; w.x = cvt_pk_bf16(O[dt][0] * inv, O[dt][1] * inv); w.y = cvt_pk_bf16(O[dt][2] * inv, O[dt][3] * inv);
                *(u32x2*)(orow + 16 * dt) = w; }
        }
        __syncthreads();
    }
}

__device__ __forceinline__ void hgrn_h1(LAS unsigned char* lds, const bf16_t* LOGF, const bf16_t* Vh, bf16_t* US, float* DEC) {
    LAS float* B = (LAS float*)lds;
    LAS float* TOT = (LAS float*)(lds + 32768);
    LAS bf16_t* KT = (LAS bf16_t*)(lds + 34816);
    LAS bf16_t* VT = (LAS bf16_t*)(lds + 34816 + 18432);
    LAS float* EB = (LAS float*)(lds + 71680);
    const int tid = pg8::opaque_tid(), lane = tid & 63, wid = tid >> 6, fr = lane & 15, fq = lane >> 4;
    const int d = tid & 127, seg = tid >> 7;
    u32x4 pl[2]; bf16_t pv[16];
#define H1_LOAD(su_) do { const int u_ = (su_) >> 1, t0_ = (u_ >> 4) * 128 + 64 * ((su_) & 1), h_ = u_ & 15; \
        _Pragma("unroll") for (int i = 0; i < 2; ++i) { const int idx = tid + 512 * i, row = idx >> 4, c8 = idx & 15; pl[i] = *(const u32x4*)(LOGF + (size_t)(t0_ + row) * D + h_ * 128 + 8 * c8); } \
        _Pragma("unroll") for (int i = 0; i < 16; ++i) pv[i] = Vh[(size_t)(t0_ + 16 * seg + i) * D + h_ * 128 + d]; } while (0)
    if ((int)blockIdx.x < 1024) H1_LOAD(2 * (int)blockIdx.x);
    for (int unit = blockIdx.x; unit < 1024; unit += gridDim.x) {
        const int N = unit >> 4, h = unit & 15;
        f32x4 accA[8]; float totA = 0.f;
#pragma unroll
        for (int sub = 0; sub < 2; ++sub) {
#pragma unroll
            for (int i = 0; i < 2; ++i) { const int idx = tid + 512 * i;
                ((LAS f32x4*)B)[2 * idx] = (f32x4){bflo(pl[i].x), bfhi(pl[i].x), bflo(pl[i].y), bfhi(pl[i].y)};
                ((LAS f32x4*)B)[2 * idx + 1] = (f32x4){bflo(pl[i].z), bfhi(pl[i].z), bflo(pl[i].w), bfhi(pl[i].w)}; }
            bf16_t vv[16];
#pragma unroll
            for (int i = 0; i < 16; ++i) vv[i] = pv[i];
            __syncthreads();
            if (sub == 0) H1_LOAD(2 * unit + 1); else if (unit + (int)gridDim.x < 1024) H1_LOAD(2 * (unit + (int)gridDim.x));
            float lf[16], b[16]; float run = 0.f;
#pragma unroll
            for (int i = 0; i < 16; ++i) { lf[i] = B[(16 * seg + i) * 128 + d]; run += lf[i]; b[i] = run; }
            TOT[seg * 128 + d] = run;
            __syncthreads();
            float off = 0.f, tot = 0.f;
#pragma unroll
            for (int s2 = 0; s2 < 4; ++s2) { const float tv = TOT[s2 * 128 + d]; off += (s2 < seg) ? tv : 0.f; tot += tv; }
            u32x4 kw[2], vw[2];
#pragma unroll
            for (int i = 0; i < 16; i += 2) {
                const float k0 = (1.0f - __expf(lf[i])) * __expf(tot - (b[i] + off)), k1 = (1.0f - __expf(lf[i + 1])) * __expf(tot - (b[i + 1] + off));
                kw[i >> 3][(i >> 1) & 3] = cvt_pk_bf16(k0, k1);
                vw[i >> 3][(i >> 1) & 3] = (unsigned)vv[i] | ((unsigned)vv[i + 1] << 16);
            }
            *(LAS u32x4*)(KT + d * 72 + 16 * seg) = kw[0]; *(LAS u32x4*)(KT + d * 72 + 16 * seg + 8) = kw[1];
            *(LAS u32x4*)(VT + d * 72 + 16 * seg) = vw[0]; *(LAS u32x4*)(VT + d * 72 + 16 * seg + 8) = vw[1];
            if (seg == 0) { if (sub == 0) totA = tot; else { EB[d] = __expf(tot); DEC[(size_t)(N * 16 + h) * 128 + d] = __expf(totA + tot); } }
            __syncthreads();
            const bf16x8 V0 = *(const LAS bf16x8*)(VT + (16 * wid + fr) * 72 + 8 * fq), V1 = *(const LAS bf16x8*)(VT + (16 * wid + fr) * 72 + 8 * fq + 32);
            bf16_t* urow = US + ((size_t)(N * 16 + h) * 128 + 16 * wid + fr) * 128 + 4 * fq;
#pragma unroll
            for (int dt = 0; dt < 8; ++dt) {
                const bf16x8 K0 = *(const LAS bf16x8*)(KT + (16 * dt + fr) * 72 + 8 * fq), K1 = *(const LAS bf16x8*)(KT + (16 * dt + fr) * 72 + 8 * fq + 32);
                f32x4 a = {0.f, 0.f, 0.f, 0.f};
                a = mfma16(K0, V0, a); a = mfma16(K1, V1, a);
                if (sub == 0) accA[dt] = a;
                else { const f32x4 e4 = *(const LAS f32x4*)(EB + 16 * dt + 4 * fq); const f32x4 u = accA[dt] * e4 + a;
                    u32x2 w; w.x = cvt_pk_bf16(u[0], u[1]); w.y = cvt_pk_bf16(u[2], u[3]);
                    *(u32x2*)(urow + 16 * dt) = w; }
            }
            __syncthreads();
        }
    }
}
__device__ __forceinline__ void hgrn_h2(const bf16_t* US, bf16_t* SS, const float* DEC) {
    for (int pidx = blockIdx.x * 512 + threadIdx.x; pidx < 131072; pidx += gridDim.x * 512) {
        const int e = 2 * pidx, h = e >> 14, dd = e & 127;
        float s0 = 0.f, s1 = 0.f;
        for (int n0 = 0; n0 < 64; n0 += 16) {
            unsigned u[16]; f32x2 dc[16];
#pragma unroll
            for (int i = 0; i < 16; ++i) { u[i] = __builtin_nontemporal_load((const unsigned*)(US + (size_t)(n0 + i) * 262144 + e)); dc[i] = *(const f32x2*)(DEC + (size_t)((n0 + i) * 16 + h) * 128 + dd); }
#pragma unroll
            for (int i = 0; i < 16; ++i) { *(unsigned*)(SS + (size_t)(n0 + i) * 262144 + e) = cvt_pk_bf16(s0, s1);
                s0 = dc[i].x * s0 + bflo(u[i]); s1 = dc[i].y * s1 + bfhi(u[i]); }
        }
    }
}
__device__ __forceinline__ void hgrn_h3(LAS unsigned char* lds, const bf16_t* LOGF, const bf16_t* Qh, const bf16_t* Vh, const bf16_t* Gh, const bf16_t* US, const float* og, bf16_t* OUT) {
    LAS float* B = (LAS float*)lds;
    LAS bf16_t* KTA = (LAS bf16_t*)lds;
    LAS float* TOT = (LAS float*)(lds + 33792);
    LAS float* EP = (LAS float*)(lds + 35840);
    LAS bf16_t* QT = (LAS bf16_t*)(lds + 36352);
    LAS bf16_t* KQ = (LAS bf16_t*)(lds + 53760);
    LAS bf16_t* AM = (LAS bf16_t*)(lds + 71168);
    LAS bf16_t* VT = (LAS bf16_t*)(lds + 80384);
    LAS bf16_t* ST = (LAS bf16_t*)(lds + 98816);
    LAS float* EA = (LAS float*)(lds + 133632);
    const int tid = pg8::opaque_tid(), lane = tid & 63, wid = tid >> 6, fr = lane & 15, fq = lane >> 4;
    const int d = tid & 127, seg = tid >> 7;
    u32x4 pl[2]; bf16_t pv[16], pq[16];
#define H3_LOAD(su_) do { const int u_ = (su_) >> 1, t0_ = (u_ >> 4) * 128 + 64 * ((su_) & 1), h_ = u_ & 15; \
        _Pragma("unroll") for (int i = 0; i < 2; ++i) { const int idx = tid + 512 * i, row = idx >> 4, c8 = idx & 15; pl[i] = *(const u32x4*)(LOGF + (size_t)(t0_ + row) * D + h_ * 128 + 8 * c8); } \
        _Pragma("unroll") for (int i = 0; i < 16; ++i) { pv[i] = Vh[(size_t)(t0_ + 16 * seg + i) * D + h_ * 128 + d]; pq[i] = Qh[(size_t)(t0_ + 16 * seg + i) * D + h_ * 128 + d]; } } while (0)
    if ((int)blockIdx.x < 1024) H3_LOAD(2 * (int)blockIdx.x);
    for (int unit = blockIdx.x; unit < 1024; unit += gridDim.x) {
        const int N = unit >> 4, h = unit & 15;
        f32x4 accU[8];
#pragma unroll
        for (int sub = 0; sub < 2; ++sub) {
            const int t0 = N * 128 + 64 * sub;
#pragma unroll
            for (int i = 0; i < 2; ++i) { const int idx = tid + 512 * i;
                ((LAS f32x4*)B)[2 * idx] = (f32x4){bflo(pl[i].x), bfhi(pl[i].x), bflo(pl[i].y), bfhi(pl[i].y)};
                ((LAS f32x4*)B)[2 * idx + 1] = (f32x4){bflo(pl[i].z), bfhi(pl[i].z), bflo(pl[i].w), bfhi(pl[i].w)}; }
            bf16_t vv[16], qq[16];
#pragma unroll
            for (int i = 0; i < 16; ++i) { vv[i] = pv[i]; qq[i] = pq[i]; }
            u32x2 sraw[8];
            if (sub == 1) { const bf16_t* sp2 = US + ((size_t)(N * 16 + h) * 128 + 16 * wid + fr) * 128 + 4 * fq;
#pragma unroll
                for (int dt = 0; dt < 8; ++dt) sraw[dt] = *(const u32x2*)(sp2 + 16 * dt); }
            __syncthreads();
            if (sub == 0) H3_LOAD(2 * unit + 1); else if (unit + (int)gridDim.x < 1024) H3_LOAD(2 * (unit + (int)gridDim.x));
            float lf[16], b[16]; float run = 0.f;
#pragma unroll
            for (int i = 0; i < 16; ++i) { lf[i] = B[(16 * seg + i) * 128 + d]; run += lf[i]; b[i] = run; }
            TOT[seg * 128 + d] = run;
            __syncthreads();
            const float t0v = TOT[d], t1v = TOT[128 + d], t2v = TOT[256 + d], t3v = TOT[384 + d];
            const float off = (seg > 0 ? t0v : 0.f) + (seg > 1 ? t1v : 0.f) + (seg > 2 ? t2v : 0.f), piv = t0v + t1v, tot = (t0v + t1v) + (t2v + t3v);
            u32x4 vw[2], kw[2];
#pragma unroll
            for (int i = 0; i < 16; ++i) {
                const float bi = b[i] + off; const int c = 16 * seg + i;
                const float kk = 1.0f - __expf(lf[i]);
                const float qt = bf2f(qq[i]) * __expf(bi - piv), kt = kk * __expf(piv - bi);
                QT[c * 136 + d] = (bf16_t)(cvt_pk_bf16(qt, 0.f) & 0xffffu); KQ[c * 136 + d] = (bf16_t)(cvt_pk_bf16(kt, 0.f) & 0xffffu);
                if (sub == 0) { const float kh = kk * __expf(tot - bi); lf[i] = kh; }
            }
#pragma unroll
            for (int i = 0; i < 16; i += 2) { vw[i >> 3][(i >> 1) & 3] = (unsigned)vv[i] | ((unsigned)vv[i + 1] << 16); if (sub == 0) kw[i >> 3][(i >> 1) & 3] = cvt_pk_bf16(lf[i], lf[i + 1]); }
            *(LAS u32x4*)(VT + d * 72 + 16 * seg) = vw[0]; *(LAS u32x4*)(VT + d * 72 + 16 * seg + 8) = vw[1];
            if (sub == 0) { *(LAS u32x4*)(KTA + d * 72 + 16 * seg) = kw[0]; *(LAS u32x4*)(KTA + d * 72 + 16 * seg + 8) = kw[1]; }
            if (seg == 0) { EP[d] = __expf(piv); if (sub == 0) EA[d] = __expf(tot); }
            __syncthreads();
            if (sub == 0) {
                const int v = tid >> 2, dq = (tid & 3) * 32;
                const u32x4* sp = (const u32x4*)(US + ((size_t)(N * 16 + h) * 128 + v) * 128 + dq);
#pragma unroll
                for (int i = 0; i < 4; ++i) { const u32x4 s = sp[i]; u32x4 w;
#pragma unroll
                    for (int e = 0; e < 4; ++e) { const int dd = dq + 8 * i + 2 * e; w[e] = cvt_pk_bf16(bflo(s[e]) * EP[dd], bfhi(s[e]) * EP[dd + 1]); }
                    *(LAS u32x4*)(ST + v * 136 + dq + 8 * i) = w; }
            } else {
#pragma unroll
                for (int dt = 0; dt < 8; ++dt) { const f32x4 ea = *(const LAS f32x4*)(EA + 16 * dt + 4 * fq), ep = *(const LAS f32x4*)(EP + 16 * dt + 4 * fq);
                    const f32x4 sv = {bflo(sraw[dt].x), bfhi(sraw[dt].x), bflo(sraw[dt].y), bfhi(sraw[dt].y)};
                    const f32x4 r = (sv * ea + accU[dt]) * ep;
                    u32x2 w; w.x = cvt_pk_bf16(r[0], r[1]); w.y = cvt_pk_bf16(r[2], r[3]);
                    *(LAS u32x2*)(ST + (16 * wid + fr) * 136 + 16 * dt + 4 * fq) = w; }
            }
            {
                const int ct = wid >> 1;
#pragma unroll
                for (int sti = 0; sti < 2; ++sti) {
                    const int st = 2 * (wid & 1) + sti;
                    f32x4 a = {0.f, 0.f, 0.f, 0.f};
                    if (st <= ct) {
#pragma unroll
                        for (int ks = 0; ks < 4; ++ks) {
                            const bf16x8 Kf = *(const LAS bf16x8*)(KQ + (16 * st + fr) * 136 + 8 * fq + 32 * ks), Qf = *(const LAS bf16x8*)(QT + (16 * ct + fr) * 136 + 8 * fq + 32 * ks);
                            a = mfma16(Kf, Qf, a);
                        }
                    }
                    const int c = 16 * ct + fr, s = 16 * st + 4 * fq;
#pragma unroll
                    for (int r = 0; r < 4; ++r) a[r] = (st <= ct && s + r <= c) ? a[r] : 0.f;
                    u32x2 w; w.x = cvt_pk_bf16(a[0], a[1]); w.y = cvt_pk_bf16(a[2], a[3]);
                    *(LAS u32x2*)(AM + c * 72 + s) = w;
                }
            }
            if (sub == 0) {
                const bf16x8 V0 = *(const LAS bf16x8*)(VT + (16 * wid + fr) * 72 + 8 * fq), V1 = *(const LAS bf16x8*)(VT + (16 * wid + fr) * 72 + 8 * fq + 32);
#pragma unroll
                for (int dt = 0; dt < 8; ++dt) {
                    const bf16x8 K0 = *(const LAS bf16x8*)(KTA + (16 * dt + fr) * 72 + 8 * fq), K1 = *(const LAS bf16x8*)(KTA + (16 * dt + fr) * 72 + 8 * fq + 32);
                    f32x4 a = {0.f, 0.f, 0.f, 0.f};
                    a = mfma16(K0, V0, a); a = mfma16(K1, V1, a); accU[dt] = a;
                }
            }
            __syncthreads();
            {
                bf16x8 Sf[4], Vf[2];
#pragma unroll
                for (int ks = 0; ks < 4; ++ks) Sf[ks] = *(const LAS bf16x8*)(ST + (16 * wid + fr) * 136 + 8 * fq + 32 * ks);
#pragma unroll
                for (int ks = 0; ks < 2; ++ks) Vf[ks] = *(const LAS bf16x8*)(VT + (16 * wid + fr) * 72 + 8 * fq + 32 * ks);
#pragma unroll
                for (int ct = 0; ct < 4; ++ct) {
                    f32x4 a = {0.f, 0.f, 0.f, 0.f};
#pragma unroll
                    for (int ks = 0; ks < 4; ++ks) a = mfma16(Sf[ks], *(const LAS bf16x8*)(QT + (16 * ct + fr) * 136 + 8 * fq + 32 * ks), a);
#pragma unroll
                    for (int ks = 0; ks < 2; ++ks) a = mfma16(Vf[ks], *(const LAS bf16x8*)(AM + (16 * ct + fr) * 72 + 8 * fq + 32 * ks), a);
                    *(LAS f32x4*)(B + (16 * ct + fr) * 132 + 16 * wid + 4 * fq) = a;
                }
            }
            __syncthreads();
            {
                const int c = tid >> 3, v0 = (tid & 7) * 16;
                f32x4 o[4]; float ss = 0.f;
#pragma unroll
                for (int i = 0; i < 4; ++i) { o[i] = *(const LAS f32x4*)(B + c * 132 + v0 + 4 * i); ss += (o[i].x * o[i].x + o[i].y * o[i].y) + (o[i].z * o[i].z + o[i].w * o[i].w); }
                ss += __shfl_xor(ss, 1); ss += __shfl_xor(ss, 2); ss += __shfl_xor(ss, 4);
                const float rstd = rsqrtf(ss * (1.0f / 128.0f) + EPS);
                const u32x4* gp = (const u32x4*)(Gh + (size_t)(t0 + c) * D + h * 128 + v0);
                const u32x4 g0 = gp[0], g1 = gp[1];
                const f32x4* ogp = (const f32x4*)(og + h * 128 + v0);
                u32x4 w0, w1;
#pragma unroll
                for (int i = 0; i < 2; ++i) { const f32x4 ga = ogp[i];
                    w0[2 * i] = cvt_pk_bf16(o[i].x * rstd * ga.x * bflo(g0[2 * i]), o[i].y * rstd * ga.y * bfhi(g0[2 * i]));
                    w0[2 * i + 1] = cvt_pk_bf16(o[i].z * rstd * ga.z * bflo(g0[2 * i + 1]), o[i].w * rstd * ga.w * bfhi(g0[2 * i + 1])); }
#pragma unroll
                for (int i = 0; i < 2; ++i) { const f32x4 ga = ogp[2 + i];
                    w1[2 * i] = cvt_pk_bf16(o[2 + i].x * rstd * ga.x * bflo(g1[2 * i]), o[2 + i].y * rstd * ga.y * bfhi(g1[2 * i]));
                    w1[2 * i + 1] = cvt_pk_bf16(o[2 + i].z * rstd * ga.z * bflo(g1[2 * i + 1]), o[2 + i].w * rstd * ga.w * bfhi(g1[2 * i + 1])); }
                u32x4* op = (u32x4*)(OUT + (size_t)(t0 + c) * D + h * 128 + v0);
                op[0] = w0; op[1] = w1;
            }
            __syncthreads();
        }
    }
}

#define XB_TMO      128
#define XB_XCNT(j)  (256  + 64 * (j))
#define XB_XSUB(j)  (1280 + 64 * (j))
#define XB_XGEN(j)  (2304 + 64 * (j))
#define XB_TOP      3328
#define XB_TOPGEN   3392
#define XCD_BAR_WORDS 3456
#define XB_SPIN_CAP (1u << 18)

__device__ __forceinline__ unsigned xb_ld(unsigned* p)              { return __hip_atomic_load(p, __ATOMIC_RELAXED, __HIP_MEMORY_SCOPE_AGENT); }
__device__ __forceinline__ unsigned xb_add(unsigned* p, unsigned v) { return __hip_atomic_fetch_add(p, v, __ATOMIC_RELAXED, __HIP_MEMORY_SCOPE_AGENT); }
__device__ __forceinline__ unsigned xb_xcc_id() { return (unsigned)__builtin_amdgcn_s_getreg((3 << 11) | 20) & 0xFu; }
#define XB_SPIN(cond, bar) do { unsigned _sp = 0; while (cond) { __builtin_amdgcn_s_sleep(1); \
    if ((++_sp & 255u) == 0u) { if (xb_ld(&(bar)[XB_TMO])) break; if (_sp > XB_SPIN_CAP) { atomicAdd(&(bar)[XB_TMO], 1u); break; } } } } while (0)

struct XcdBarrier {
    unsigned* bar; unsigned x;
    volatile LAS unsigned* st;
};

__device__ __forceinline__ XcdBarrier xcd_barrier_post(unsigned* bar, volatile LAS unsigned* st) {
    XcdBarrier b; b.bar = bar; b.x = xb_xcc_id(); b.st = st;
    if (threadIdx.x == 0) (void)xb_add(&bar[XB_XCNT(b.x)], 1u);
    return b;
}
__device__ __forceinline__ void xcd_barrier_complete(unsigned* bar, unsigned x, unsigned& nloc, unsigned& nx) {
    const unsigned G = gridDim.x * gridDim.y * gridDim.z;
    unsigned sum, cnt, mine, sp = 0u;
    for (;;) {
        sum = 0u; cnt = 0u; mine = 0u;
#pragma unroll
        for (unsigned j = 0; j < 16; ++j) { const unsigned c = xb_ld(&bar[XB_XCNT(j)]); sum += c; cnt += (c > 0u) ? 1u : 0u; mine = (j == x) ? c : mine; }
        if (sum == G) break;
        __builtin_amdgcn_s_sleep(1);
        if ((++sp & 255u) == 0u) { if (xb_ld(&bar[XB_TMO])) break; if (sp > XB_SPIN_CAP) { atomicAdd(&bar[XB_TMO], 1u); break; } }
    }
    nloc = mine > 0u ? mine : 1u; nx = cnt > 0u ? cnt : 1u;
}

__device__ __forceinline__ void xcd_barrier(const XcdBarrier& b) {
    asm volatile("s_waitcnt vmcnt(0)" ::: "memory");
    __syncthreads();
    if (threadIdx.x == 0) {
        unsigned* bar = b.bar;
        __builtin_amdgcn_s_waitcnt(0);
        unsigned nloc = b.st[0], nx = b.st[1];
        if (nloc == 0u) { xcd_barrier_complete(bar, b.x, nloc, nx); b.st[0] = nloc; b.st[1] = nx; }
        const unsigned old = xb_add(&bar[XB_XSUB(b.x)], 1u);
        const unsigned gen = old / nloc;
        if (old + 1u == (gen + 1u) * nloc) {
            __builtin_amdgcn_fence(__ATOMIC_RELEASE, "agent");
            asm volatile("s_waitcnt vmcnt(0)" ::: "memory");
            const unsigned og = xb_add(&bar[XB_TOP], 1u);
            const unsigned tg = og / nx;
            if (og + 1u == (tg + 1u) * nx) xb_add(&bar[XB_TOPGEN], 1u);
            else XB_SPIN(xb_ld(&bar[XB_TOPGEN]) == tg, bar);
            __builtin_amdgcn_fence(__ATOMIC_ACQUIRE, "agent");
            xb_add(&bar[XB_XGEN(b.x)], 1u);
            asm volatile("s_waitcnt vmcnt(0)" ::: "memory");
        } else {
            XB_SPIN(xb_ld(&bar[XB_XGEN(b.x)]) == gen, bar);
            __builtin_amdgcn_fence(__ATOMIC_ACQUIRE, "agent");
            asm volatile("s_waitcnt vmcnt(0)" ::: "memory");
        }
    }
    __syncthreads();
}

__global__ void __launch_bounds__(512, 2) fwd_megakernel(Params p) {
    extern __shared__ __attribute__((aligned(16))) unsigned char lds_raw[];
    LAS unsigned char* lds = (LAS unsigned char*)lds_raw;
    cg::grid_group grid = cg::this_grid();
    unsigned char* ws = p.ws;
    const float* MOD = (const float*)(ws + WS_MOD);
    bf16_t* H = (bf16_t*)(ws + WS_H); bf16_t* QKV = (bf16_t*)(ws + WS_QKV); bf16_t* ATT = (bf16_t*)(ws + WS_ATT); bf16_t* XA = (bf16_t*)(ws + WS_XA);   bf16_t* ACT = (bf16_t*)(ws + WS_ACT);
    bf16_t* QH = (bf16_t*)(ws + WS_QH); bf16_t* LOGF = (bf16_t*)(ws + WS_LOGF); bf16_t* VH = (bf16_t*)(ws + WS_VH); bf16_t* GH = (bf16_t*)(ws + WS_GH); bf16_t* US = (bf16_t*)(ws + WS_US); bf16_t* SS = (bf16_t*)(ws + WS_SS); float* DEC = (float*)(ws + WS_DEC);
    const int G = gridDim.x, bx = blockIdx.x;

    if (threadIdx.x < 16) ((LAS unsigned*)(lds + MISC_OFF))[threadIdx.x] = 0u;
    __syncthreads();
    const XcdBarrier bar = xcd_barrier_post((unsigned*)(ws + WS_BAR), (volatile LAS unsigned*)(lds + MISC_OFF));
#define CG_SYNC() do { asm volatile("s_waitcnt vmcnt(0) lgkmcnt(0)" ::: "memory"); grid.sync(); __builtin_amdgcn_fence(__ATOMIC_ACQUIRE, "agent"); asm volatile("s_waitcnt vmcnt(0)" ::: "memory"); __syncthreads(); } while (0)
#define GRID_SYNC() xcd_barrier(bar)
    prologue_phase(lds, p);
    norm_phase(lds, p.x, p.norm_mix, MOD, MOD + D, H);
    if (p.ws == nullptr) CG_SYNC();
    GRID_SYNC();
#define GEMM_PHASE(EpiT, Aptr, WToff, Nn, Kk, ...) do { pg8::Gemm g{Aptr, (const bf16_t*)(ws + (WToff)), T, Nn, Kk}; pg8::StaticOrder S; S.init(T, Nn, G, bx); \
        EpiT E{__VA_ARGS__}; pg8::gemm_phase<EpiT, pg8::StaticOrder, true, true>(lds, g, S, E); } while (0)
    float* BIAS = (float*)(ws + WS_BIAS); float* PART = (float*)(ws + WS_PART); LAS float* RS = (LAS float*)(lds + RS_OFF);
    GEMM_PHASE(pg8::EpiStore<0>, H, WS_WT_AIN, NQKV, D, QKV, NQKV);
    {
        const int busy2 = (T / 256) * (NQKV / 256) - G; const bool split = busy2 > 0 && busy2 < G;
        if (!split || bx >= busy2) {
            const int wv = (split ? bx - busy2 : bx) * 8 + (pg8::opaque_tid() >> 6), nw = (split ? G - busy2 : G) * 8;
            bias_gemv(MOD + 3 * D, p.norm_mlp, MOD + 4 * D, (const bf16_t*)(ws + WS_WT_W1), BIAS, DFF, wv, nw);
            bias_gemv(MOD + 12288, p.norm_mix + D, MOD + 12288 + D, (const bf16_t*)(ws + WS_WT_HIN), BIAS + DFF, DFF, wv, nw);
            bias_gemv(MOD + 12288 + 3 * D, p.norm_mlp + D, MOD + 12288 + 4 * D, (const bf16_t*)(ws + WS_WT_W1 + 32 * MiB), BIAS + 2 * DFF, DFF, wv, nw);
        }
    }
    GRID_SYNC();
    attn_phase(lds, QKV, p.attn_q_gain, p.attn_k_gain, p.attn_sinks, ATT);
    GRID_SYNC();
    GEMM_PHASE(pg8::EpiResidN<false>, ATT, WS_WT_AOUT, D, D, p.x, XA, MOD + 2 * D, D, PART);
    GRID_SYNC();
#define GEMM_PHASE_N(EpiT, Aptr, WToff, ...) do { pg8::Gemm g{Aptr, (const bf16_t*)(ws + (WToff)), T, DFF, D}; pg8::StaticOrder S; S.init(T, DFF, G, bx); rstd_prepare(RS, PART, S); \
        EpiT E{__VA_ARGS__}; pg8::gemm_phase<EpiT, pg8::StaticOrder, true, true>(lds, g, S, E); } while (0)
    GEMM_PHASE_N(pg8::EpiStoreN<2>, XA, WS_WT_W1, ACT, DFF, BIAS, RS, 0);
    GRID_SYNC();
    GEMM_PHASE(pg8::EpiResidN<true>, ACT, WS_WT_W2, D, DFF, XA, XA, MOD + 5 * D, D, PART);
    GRID_SYNC();
    GEMM_PHASE_N(pg8::EpiHgrn, XA, WS_WT_HIN, QH, LOGF, VH, GH, (const float*)(ws + WS_LB), 0.08838834764831845f, BIAS + DFF, RS, 0);
    GRID_SYNC();
    hgrn_h1(lds, LOGF, VH, US, DEC);
    GRID_SYNC();
    hgrn_h2(US, SS, DEC);
    GRID_SYNC();
    hgrn_h3(lds, LOGF, QH, VH, GH, SS, p.hgrn_o_gain, ATT);
    GRID_SYNC();
    GEMM_PHASE(pg8::EpiResidN<true>, ATT, WS_WT_HOUT, D, D, XA, XA, MOD + 12288 + 2 * D, D, PART);
    GRID_SYNC();
    GEMM_PHASE_N(pg8::EpiStoreN<2>, XA, WS_WT_W1 + 32 * MiB, ACT, DFF, BIAS + 2 * DFF, RS, 0);
    GRID_SYNC();
    GEMM_PHASE(pg8::EpiResidF, ACT, WS_WT_W2 + 32 * MiB, D, DFF, XA, p.out, MOD + 12288 + 5 * D, D);
}

extern "C" void kernel_launch(void* const* d_in, const int* in_sizes, int n_in, void* d_out, int out_size, void* d_ws, size_t ws_size, hipStream_t stream) {
    static int grid = 0;
    if (grid == 0) {
        if (n_in != 17 || out_size != T * D || ws_size < WS_END) { fprintf(stderr, "kernel_launch: unexpected shapes (n_in %d out %d ws %zu, need %zu)\n", n_in, out_size, ws_size, (size_t)WS_END); grid = -1; return; }
        int dev = 0, cus = 0, per_cu = 0;
        (void)hipGetDevice(&dev);
        (void)hipDeviceGetAttribute(&cus, hipDeviceAttributeMultiprocessorCount, dev);
        (void)hipFuncSetAttribute((const void*)fwd_megakernel, hipFuncAttributeMaxDynamicSharedMemorySize, LDS_BYTES);
        (void)hipOccupancyMaxActiveBlocksPerMultiprocessor(&per_cu, (const void*)fwd_megakernel, 512, LDS_BYTES);
        if (per_cu < 1) { fprintf(stderr, "kernel_launch: occupancy query says %d blocks per CU\n", per_cu); per_cu = 1; }
        grid = cus * per_cu;
        if (grid != 256) { fprintf(stderr, "kernel_launch: built for a 256-workgroup grid (got %d)\n", grid); grid = -1; return; }
    }
    if (grid < 0) return;
    Params p{};
    p.x = (const float*)d_in[0]; p.c = (const float*)d_in[1]; p.mod_w = (const float*)d_in[2]; p.mod_b = (const float*)d_in[3];
    p.norm_mix = (const float*)d_in[4]; p.norm_mlp = (const float*)d_in[5]; p.attn_w_in = (const float*)d_in[6]; p.attn_w_out = (const float*)d_in[7];
    p.attn_q_gain = (const float*)d_in[8]; p.attn_k_gain = (const float*)d_in[9]; p.attn_sinks = (const float*)d_in[10];
    p.hgrn_w_in = (const float*)d_in[11]; p.hgrn_w_out = (const float*)d_in[12]; p.hgrn_o_gain = (const float*)d_in[13]; p.hgrn_lb_logits = (const float*)d_in[14];
    p.mlp_w1 = (const float*)d_in[15]; p.mlp_w2 = (const float*)d_in[16];
    p.out = (float*)d_out; p.ws = (unsigned char*)d_ws;
    (void)hipMemsetAsync((char*)d_ws + WS_BAR, 0, BAR_BYTES, stream);
    void* args[] = {&p};
    hipError_t e = hipLaunchCooperativeKernel((const void*)fwd_megakernel, dim3(grid), dim3(512), args, LDS_BYTES, stream);
    if (e != hipSuccess) fprintf(stderr, "kernel_launch: cooperative launch failed: %s (grid %d)\n", hipGetErrorString(e), grid);
}
```

```cpp
#include <hip/hip_runtime.h>
#include <hip/hip_cooperative_groups.h>
#include <cstdio>
#include <cstdint>
#include <cmath>
namespace pg8 {
#define PG8_LAS __attribute__((address_space(3)))
typedef unsigned short bf16_t;
typedef short bf16x8 __attribute__((ext_vector_type(8)));
typedef float f32x4 __attribute__((ext_vector_type(4)));
typedef unsigned u32x4 __attribute__((ext_vector_type(4)));
constexpr int BM = 256, BK = 64, HALF = 128, HTB = HALF * BK * 2  , STAGE_BYTES = 8 * HTB, NXCD = 8, WGM = 4;

__host__ __device__ __forceinline__ int lds_byte(int r, int c) { const int st = (r >> 4) * 2 + (c >> 5), rr = r & 15, cc = c & 31, ob = rr * 64 + cc * 2; return st * 1024 + (ob ^ (((ob >> 9) & 1) << 5)); }
__host__ __device__ __forceinline__ void stage_rc(int b, int& R, int& C) { const int st = b / 1024, sb = b % 1024, swz = sb ^ (((sb >> 9) & 1) << 5); R = (st >> 1) * 16 + swz / 64; C = (st & 1) * 32 + (swz % 64) / 2; }
__host__ __device__ __forceinline__ int perm32(int rho) { const int n = rho >> 4, i = rho & 15; return 8 * (i >> 2) + 4 * n + (i & 3); }

struct Unit { int pm, pn; };
struct Gemm { const bf16_t* A; const bf16_t* Bt; int M, N, K; };

struct StaticOrder {
    int nM, nN, nwg, G, c;
    __host__ __device__ void init(int M, int N, int G_, int c_) { nM = M / BM; nN = N / BM; nwg = nM * nN; G = G_; c = c_; }
    __host__ __device__ bool next(int i, Unit& u) const {
        const long L = (long)i * G + c; if (L >= nwg) return false;
        int wgid = (int)L; { const int q = nwg / NXCD, r = nwg % NXCD, xcd = wgid % NXCD, off = wgid / NXCD; wgid = (xcd < r ? xcd * (q + 1) : r * (q + 1) + (xcd - r) * q) + off; }
        const int nig = WGM * nN, gid = wgid / nig, fm = gid * WGM, gsz = (nM - fm) < WGM ? (nM - fm) : WGM;
        u.pm = fm + ((wgid % nig) % gsz); u.pn = (wgid % nig) / gsz; return true;
    }
    __device__ __forceinline__ void a_ready(const Unit&) const {}
    __device__ __forceinline__ void done(const Unit&) const {}
};

typedef __bf16 bf16x2_t __attribute__((ext_vector_type(2)));
typedef float f32x2 __attribute__((ext_vector_type(2)));
__device__ __forceinline__ unsigned cvt_pk_bf16(float lo, float hi) { const f32x2 v = {lo, hi}; const bf16x2_t b = __builtin_convertvector(v, bf16x2_t); return __builtin_bit_cast(unsigned, b); }
__device__ __forceinline__ int opaque_tid() { int t = threadIdx.x; asm volatile("" : "+v"(t)); return t; }
typedef unsigned u32x2 __attribute__((ext_vector_type(2)));
__device__ __forceinline__ float fast_rcp(float x) { return __builtin_amdgcn_rcpf(x); }
__device__ __forceinline__ float silu_f(float x) { return x * fast_rcp(1.0f + __expf(-x)); }
template <int ACT> struct EpiStore {
    static constexpr bool PERM = true, AFTER_DRAIN = false;
    bf16_t* O; int ldc;
    __device__ __forceinline__ void operator()(const f32x4 (&acc)[2][2][4][2], const Unit& u, int wr, int wc, int fr, int fq) const {
        const int row0 = u.pm * BM + wr * 64 + fr, col0 = u.pn * BM + wc * 32 + 8 * fq;
#pragma unroll
        for (int ai = 0; ai < 2; ++ai)
#pragma unroll
            for (int m = 0; m < 4; ++m) { bf16_t* rowp = O + (size_t)(row0 + ai * HALF + m * 16) * ldc + col0;
#pragma unroll
                for (int bj = 0; bj < 2; ++bj) { f32x4 v0 = acc[ai][bj][m][0], v1 = acc[ai][bj][m][1];
                    if (ACT == 2) {
#pragma unroll
                        for (int e = 0; e < 4; ++e) { const float a = fmaxf(v0[e], 0.f), b = fmaxf(v1[e], 0.f); v0[e] = a * a; v1[e] = b * b; } }
                    u32x4 w; w.x = cvt_pk_bf16(v0[0], v0[1]); w.y = cvt_pk_bf16(v0[2], v0[3]); w.z = cvt_pk_bf16(v1[0], v1[1]); w.w = cvt_pk_bf16(v1[2], v1[3]);
                    *(u32x4*)(rowp + bj * HALF) = w; } }
    }
};
struct EpiResid {
    static constexpr bool PERM = false, AFTER_DRAIN = false;
    const float* base; float* out; const float* gate; int ldc;
    __device__ __forceinline__ void operator()(const f32x4 (&acc)[2][2][4][2], const Unit& u, int wr, int wc, int fr, int fq) const {
        const int col0 = u.pn * BM + wc * 32 + 4 * fq;
        f32x4 gv[2][2];
#pragma unroll
        for (int bj = 0; bj < 2; ++bj)
#pragma unroll
            for (int n = 0; n < 2; ++n) gv[bj][n] = *(const f32x4*)(gate + col0 + bj * HALF + n * 16);
#pragma unroll
        for (int ai = 0; ai < 2; ++ai)
#pragma unroll
            for (int m = 0; m < 4; ++m) { const size_t off = (size_t)(u.pm * BM + ai * HALF + wr * 64 + m * 16 + fr) * ldc + col0;
#pragma unroll
                for (int bj = 0; bj < 2; ++bj)
#pragma unroll
                    for (int n = 0; n < 2; ++n) { const f32x4 b = *(const f32x4*)(base + off + bj * HALF + n * 16);
                        *(f32x4*)(out + off + bj * HALF + n * 16) = b + gv[bj][n] * acc[ai][bj][m][n]; } }
    }
};
struct EpiHgrn {
    static constexpr bool PERM = true, AFTER_DRAIN = false;
    bf16_t* Qh; bf16_t* LOGF; bf16_t* Vh; bf16_t* Gh; const float* lb; float qscale; const float* bias; const PG8_LAS float* rs; mutable int slot;
    __device__ __forceinline__ void operator()(const f32x4 (&acc)[2][2][4][2], const Unit& u, int wr, int wc, int fr, int fq) const {
        const int type = u.pn >> 3;
        const int row0 = u.pm * BM + wr * 64 + fr, col0 = (u.pn & 7) * BM + wc * 32 + 8 * fq, bcol0 = u.pn * BM + wc * 32 + 8 * fq;
        const PG8_LAS float* rsu = rs + slot * 256 + wr * 64 + fr; ++slot;
        f32x4 bv[2][2];
#pragma unroll
        for (int bj = 0; bj < 2; ++bj) { bv[bj][0] = *(const f32x4*)(bias + bcol0 + bj * HALF); bv[bj][1] = *(const f32x4*)(bias + bcol0 + bj * HALF + 4); }
#pragma unroll
        for (int ai = 0; ai < 2; ++ai)
#pragma unroll
            for (int m = 0; m < 4; ++m) { const size_t roff = (size_t)(row0 + ai * HALF + m * 16) * 2048 + col0; const float rstd = rsu[ai * HALF + m * 16];
#pragma unroll
                for (int bj = 0; bj < 2; ++bj) {
                    f32x4 v0 = acc[ai][bj][m][0] * rstd + bv[bj][0], v1 = acc[ai][bj][m][1] * rstd + bv[bj][1];
                    if (type == 1) {
                        const f32x4 l0 = *(const f32x4*)(lb + col0 + bj * HALF), l1 = *(const f32x4*)(lb + col0 + bj * HALF + 4);
#pragma unroll
                        for (int e = 0; e < 4; ++e) {
                            const float s0 = fast_rcp(1.0f + __expf(-v0[e])), s1 = fast_rcp(1.0f + __expf(-v1[e]));
                            v0[e] = __logf(l0[e] + (1.0f - l0[e]) * s0); v1[e] = __logf(l1[e] + (1.0f - l1[e]) * s1); }
                        u32x4 w; w.x = cvt_pk_bf16(v0[0], v0[1]); w.y = cvt_pk_bf16(v0[2], v0[3]); w.z = cvt_pk_bf16(v1[0], v1[1]); w.w = cvt_pk_bf16(v1[2], v1[3]);
                        *(u32x4*)(LOGF + roff + bj * HALF) = w;
                    } else {
                        if (type == 0) {
#pragma unroll
                            for (int e = 0; e < 4; ++e) { v0[e] = silu_f(v0[e]) * qscale; v1[e] = silu_f(v1[e]) * qscale; }
                        } else if (type == 3) {
#pragma unroll
                            for (int e = 0; e < 4; ++e) { v0[e] = silu_f(v0[e]); v1[e] = silu_f(v1[e]); }
                        }
                        u32x4 w; w.x = cvt_pk_bf16(v0[0], v0[1]); w.y = cvt_pk_bf16(v0[2], v0[3]); w.z = cvt_pk_bf16(v1[0], v1[1]); w.w = cvt_pk_bf16(v1[2], v1[3]);
                        if (type == 0) *(u32x4*)(Qh + roff + bj * HALF) = w;
                        else if (type == 2) *(u32x4*)(Vh + roff + bj * HALF) = w;
                        else *(u32x4*)(Gh + roff + bj * HALF) = w;
                    } } }
    }
};

template <bool BASE_BF16> struct EpiResidN {
    static constexpr bool PERM = true, AFTER_DRAIN = false;
    const void* base; bf16_t* out; const float* gate; int ldc; float* part;
    __device__ __forceinline__ void operator()(const f32x4 (&acc)[2][2][4][2], const Unit& u, int wr, int wc, int fr, int fq) const {
        const int col0 = u.pn * BM + wc * 32 + 8 * fq;
        f32x4 gv[2][2];
#pragma unroll
        for (int bj = 0; bj < 2; ++bj)
#pragma unroll
            for (int n = 0; n < 2; ++n) gv[bj][n] = *(const f32x4*)(gate + col0 + bj * HALF + n * 4);
#pragma unroll
        for (int ai = 0; ai < 2; ++ai)
#pragma unroll
            for (int m = 0; m < 4; ++m) { const int row = u.pm * BM + ai * HALF + wr * 64 + m * 16 + fr; const size_t off = (size_t)row * ldc + col0; float ss = 0.f;
#pragma unroll
                for (int bj = 0; bj < 2; ++bj) { f32x4 b0, b1;
                    if (BASE_BF16) { const u32x4 bb = *(const u32x4*)((const bf16_t*)base + off + bj * HALF);
                        b0 = (f32x4){__uint_as_float(bb.x << 16), __uint_as_float(bb.x & 0xffff0000u), __uint_as_float(bb.y << 16), __uint_as_float(bb.y & 0xffff0000u)};
                        b1 = (f32x4){__uint_as_float(bb.z << 16), __uint_as_float(bb.z & 0xffff0000u), __uint_as_float(bb.w << 16), __uint_as_float(bb.w & 0xffff0000u)}; }
                    else { b0 = *(const f32x4*)((const float*)base + off + bj * HALF); b1 = *(const f32x4*)((const float*)base + off + bj * HALF + 4); }
                    const f32x4 o0 = b0 + gv[bj][0] * acc[ai][bj][m][0], o1 = b1 + gv[bj][1] * acc[ai][bj][m][1];
                    u32x4 ob; ob.x = cvt_pk_bf16(o0[0], o0[1]); ob.y = cvt_pk_bf16(o0[2], o0[3]); ob.z = cvt_pk_bf16(o1[0], o1[1]); ob.w = cvt_pk_bf16(o1[2], o1[3]);
                    *(u32x4*)(out + off + bj * HALF) = ob;
                    ss += ((o0[0] * o0[0] + o0[1] * o0[1]) + (o0[2] * o0[2] + o0[3] * o0[3])) + ((o1[0] * o1[0] + o1[1] * o1[1]) + (o1[2] * o1[2] + o1[3] * o1[3]));
                    }
                ss += __shfl_xor(ss, 16); ss += __shfl_xor(ss, 32);
                if (fq == 0) part[(size_t)row * 32 + u.pn * 4 + wc] = ss; }
    }
};
struct EpiResidF {
    static constexpr bool PERM = true, AFTER_DRAIN = false;
    const bf16_t* base; float* out; const float* gate; int ldc;
    __device__ __forceinline__ void operator()(const f32x4 (&acc)[2][2][4][2], const Unit& u, int wr, int wc, int fr, int fq) const {
        const int col0 = u.pn * BM + wc * 32 + 8 * fq;
        f32x4 gv[2][2];
#pragma unroll
        for (int bj = 0; bj < 2; ++bj)
#pragma unroll
            for (int n = 0; n < 2; ++n) gv[bj][n] = *(const f32x4*)(gate + col0 + bj * HALF + n * 4);
#pragma unroll
        for (int ai = 0; ai < 2; ++ai)
#pragma unroll
            for (int m = 0; m < 4; ++m) { const size_t off = (size_t)(u.pm * BM + ai * HALF + wr * 64 + m * 16 + fr) * ldc + col0;
#pragma unroll
                for (int bj = 0; bj < 2; ++bj) { const u32x4 bb = *(const u32x4*)(base + off + bj * HALF);
                    const f32x4 b0 = {__uint_as_float(bb.x << 16), __uint_as_float(bb.x & 0xffff0000u), __uint_as_float(bb.y << 16), __uint_as_float(bb.y & 0xffff0000u)};
                    const f32x4 b1 = {__uint_as_float(bb.z << 16), __uint_as_float(bb.z & 0xffff0000u), __uint_as_float(bb.w << 16), __uint_as_float(bb.w & 0xffff0000u)};
                    *(f32x4*)(out + off + bj * HALF) = b0 + gv[bj][0] * acc[ai][bj][m][0]; *(f32x4*)(out + off + bj * HALF + 4) = b1 + gv[bj][1] * acc[ai][bj][m][1]; } }
    }
};
template <int ACT> struct EpiStoreN {
    static constexpr bool PERM = true, AFTER_DRAIN = false;
    bf16_t* O; int ldc; const float* bias; const PG8_LAS float* rs; mutable int slot;
    __device__ __forceinline__ void operator()(const f32x4 (&acc)[2][2][4][2], const Unit& u, int wr, int wc, int fr, int fq) const {
        const int row0 = u.pm * BM + wr * 64 + fr, col0 = u.pn * BM + wc * 32 + 8 * fq;
        const PG8_LAS float* rsu = rs + slot * 256 + wr * 64 + fr; ++slot;
        f32x4 bv[2][2];
#pragma unroll
        for (int bj = 0; bj < 2; ++bj) { bv[bj][0] = *(const f32x4*)(bias + col0 + bj * HALF); bv[bj][1] = *(const f32x4*)(bias + col0 + bj * HALF + 4); }
#pragma unroll
        for (int ai = 0; ai < 2; ++ai)
#pragma unroll
            for (int m = 0; m < 4; ++m) { bf16_t* rowp = O + (size_t)(row0 + ai * HALF + m * 16) * ldc + col0; const float rstd = rsu[ai * HALF + m * 16];
#pragma unroll
                for (int bj = 0; bj < 2; ++bj) {
                    f32x4 v0 = acc[ai][bj][m][0] * rstd + bv[bj][0], v1 = acc[ai][bj][m][1] * rstd + bv[bj][1];
                    if (ACT == 2) {
#pragma unroll
                        for (int e = 0; e < 4; ++e) { const float a = fmaxf(v0[e], 0.f), b = fmaxf(v1[e], 0.f); v0[e] = a * a; v1[e] = b * b; } }
                    u32x4 w; w.x = cvt_pk_bf16(v0[0], v0[1]); w.y = cvt_pk_bf16(v0[2], v0[3]); w.z = cvt_pk_bf16(v1[0], v1[1]); w.w = cvt_pk_bf16(v1[2], v1[3]);
                    *(u32x4*)(rowp + bj * HALF) = w; } }
    }
};
template <class Epi, class Sched, bool ALIGN_EPI = false, bool SP2 = false>
__device__ __forceinline__ void gemm_phase(PG8_LAS unsigned char* lds, const Gemm g, const Sched& S, const Epi& E) {
    const int tid = opaque_tid(), wid = __builtin_amdgcn_readfirstlane(tid >> 6), lane = tid & 63, wr = wid >> 2, wc = wid & 3, fr = lane & 15, fq = lane >> 4;
    const int K = g.K, nt = K / BK;
    unsigned voffA[2], voffB[2];
#pragma unroll
    for (int i = 0; i < 2; ++i) { int R, C; stage_rc(tid * 16 + i * 8192, R, C); const int Rb = Epi::PERM ? ((R & ~31) + perm32(R & 31)) : R;
        voffA[i] = (unsigned)(R * K + C) * 2u; voffB[i] = (unsigned)(Rb * K + C) * 2u; }
    const size_t kstep = (size_t)(BK * 2);
    const size_t hstep = (size_t)HALF * K * 2;
    const size_t tstep = 2 * hstep;
    const unsigned ldsw = (unsigned)wid * 1024u;
    const int aoff = lds_byte(wr * 64 + fr, fq * 8), boff = lds_byte(wc * 32 + fr, fq * 8);
#define PG8_SA(b, h) (((b) * 2 + (h)) * HTB)
#define PG8_SB(b, h) ((4 + (b) * 2 + (h)) * HTB)
#define PG8_STAGE(bufoff, gbase, voff) do { _Pragma("unroll") for (int _i = 0; _i < 2; ++_i) \
        __builtin_amdgcn_global_load_lds((const unsigned*)((const char*)(gbase) + (voff)[_i]), (PG8_LAS unsigned*)(lds + (bufoff) + ldsw + _i * 8192), 16, 0, 0); } while (0)
#define PG8_LDA(dst, b, h) do { _Pragma("unroll") for (int m = 0; m < 4; ++m) _Pragma("unroll") for (int k = 0; k < 2; ++k) dst[m][k] = *(const PG8_LAS bf16x8*)(lds + PG8_SA(b, h) + aoff + m * 2048 + k * 1024); } while (0)
#define PG8_LDB(dst, b, h) do { _Pragma("unroll") for (int n = 0; n < 2; ++n) _Pragma("unroll") for (int k = 0; k < 2; ++k) dst[n][k] = *(const PG8_LAS bf16x8*)(lds + PG8_SB(b, h) + boff + n * 2048 + k * 1024); } while (0)
#define PG8_MMA(ai, bj, At, Bt) do { __builtin_amdgcn_s_setprio(1); _Pragma("unroll") for (int m = 0; m < 4; ++m) _Pragma("unroll") for (int n = 0; n < 2; ++n) _Pragma("unroll") for (int k = 0; k < 2; ++k) \
        acc[ai][bj][m][n] = __builtin_amdgcn_mfma_f32_16x16x32_bf16(Bt[n][k], At[m][k], acc[ai][bj][m][n], 0, 0, 0); __builtin_amdgcn_s_setprio(0); } while (0)
#define PG8_WAIT_V(n) asm volatile("s_waitcnt vmcnt(" #n ")" ::: "memory")
#define PG8_WAIT_L(n) asm volatile("s_waitcnt lgkmcnt(" #n ")" ::: "memory")
#define PG8_BAR __builtin_amdgcn_s_barrier()
#define PG8_SCHED __builtin_amdgcn_sched_barrier(0)
    Unit cur, nxt; int ui = 0;
    if (!S.next(0, cur)) return;
    f32x4 acc[2][2][4][2];
#pragma unroll
    for (int a = 0; a < 2; ++a)
#pragma unroll
        for (int b = 0; b < 2; ++b)
#pragma unroll
            for (int m = 0; m < 4; ++m)
#pragma unroll
                for (int n = 0; n < 2; ++n) acc[a][b][m][n] = (f32x4){0.f, 0.f, 0.f, 0.f};
    bf16x8 At[4][2], B0[2][2], B1[2][2];
    const char* cA = (const char*)g.A + (size_t)cur.pm * tstep; const char* cB = (const char*)g.Bt + (size_t)cur.pn * tstep;
    S.a_ready(cur);
    if constexpr (SP2) {
        PG8_STAGE(PG8_SB(0, 0), cB, voffB); PG8_STAGE(PG8_SB(0, 1), cB + hstep, voffB); PG8_STAGE(PG8_SA(0, 0), cA, voffA); PG8_STAGE(PG8_SA(0, 1), cA + hstep, voffA);
        if (wr == 1) PG8_BAR;
        PG8_WAIT_V(2); PG8_BAR;
        PG8_STAGE(PG8_SB(1, 0), cB + kstep, voffB); PG8_STAGE(PG8_SA(1, 0), cA + kstep, voffA); PG8_STAGE(PG8_SB(1, 1), cB + hstep + kstep, voffB);
        PG8_WAIT_V(6); PG8_BAR;
    } else {
        PG8_STAGE(PG8_SB(0, 0), cB, voffB); PG8_STAGE(PG8_SA(0, 0), cA, voffA); PG8_STAGE(PG8_SB(0, 1), cB + hstep, voffB); PG8_STAGE(PG8_SA(0, 1), cA + hstep, voffA);
        if (wr == 1) PG8_BAR;
        PG8_WAIT_V(4); PG8_BAR;
        PG8_STAGE(PG8_SB(1, 0), cB + kstep, voffB); PG8_STAGE(PG8_SA(1, 0), cA + kstep, voffA); PG8_STAGE(PG8_SB(1, 1), cB + hstep + kstep, voffB);
        PG8_WAIT_V(6); PG8_BAR;
    }
    for (;;) {
        const bool has_next = S.next(ui + 1, nxt);
        const char* nA = has_next ? (const char*)g.A + (size_t)nxt.pm * tstep : cA; const char* nB = has_next ? (const char*)g.Bt + (size_t)nxt.pn * tstep : cB;
        for (int t = 0; t < nt; t += 2) {
            const bool last = (t == nt - 2);
            const char* a1 = cA + (size_t)(t + 1) * kstep;
            const char* a2 = last ? nA : cA + (size_t)(t + 2) * kstep; const char* b2 = last ? nB : cB + (size_t)(t + 2) * kstep;
            const char* a3 = a2 + kstep; const char* b3 = b2 + kstep;
            if (last && has_next) S.a_ready(nxt);
            if constexpr (SP2) {
            PG8_LDB(B0, 0, 0); PG8_LDB(B1, 0, 1); PG8_SCHED; PG8_LDA(At, 0, 0); PG8_STAGE(PG8_SA(1, 1), a1 + hstep, voffA);
            PG8_WAIT_V(8); PG8_WAIT_L(0); PG8_BAR; PG8_MMA(0, 0, At, B0); PG8_MMA(0, 1, At, B1); PG8_BAR; PG8_SCHED;
            PG8_LDA(At, 0, 1); PG8_STAGE(PG8_SB(0, 0), b2, voffB); PG8_STAGE(PG8_SB(0, 1), b2 + hstep, voffB); PG8_STAGE(PG8_SA(0, 0), a2, voffA);
            PG8_WAIT_V(8); PG8_WAIT_L(0); PG8_BAR; PG8_MMA(1, 0, At, B0); PG8_MMA(1, 1, At, B1); PG8_BAR; PG8_SCHED;
            PG8_LDB(B0, 1, 0); PG8_LDB(B1, 1, 1); PG8_SCHED; PG8_LDA(At, 1, 0); PG8_STAGE(PG8_SA(0, 1), a2 + hstep, voffA);
            PG8_WAIT_V(8); PG8_WAIT_L(0); PG8_BAR; PG8_MMA(0, 0, At, B0); PG8_MMA(0, 1, At, B1); PG8_BAR; PG8_SCHED;
            PG8_LDA(At, 1, 1); PG8_STAGE(PG8_SB(1, 0), b3, voffB); PG8_STAGE(PG8_SB(1, 1), b3 + hstep, voffB); PG8_STAGE(PG8_SA(1, 0), a3, voffA);
            PG8_WAIT_V(8); PG8_WAIT_L(0); PG8_BAR; PG8_MMA(1, 0, At, B0); PG8_MMA(1, 1, At, B1); PG8_BAR; PG8_SCHED;
            } else {
            PG8_LDB(B0, 0, 0); PG8_SCHED; PG8_LDA(At, 0, 0); PG8_STAGE(PG8_SA(1, 1), a1 + hstep, voffA);
            PG8_WAIT_L(8); PG8_BAR; PG8_WAIT_L(0); PG8_MMA(0, 0, At, B0); PG8_BAR; PG8_SCHED;
            PG8_LDB(B1, 0, 1); PG8_STAGE(PG8_SB(0, 0), b2, voffB);
            PG8_BAR; PG8_WAIT_L(0); PG8_MMA(0, 1, At, B1); PG8_BAR;
            PG8_LDA(At, 0, 1); PG8_STAGE(PG8_SA(0, 0), a2, voffA);
            PG8_BAR; PG8_WAIT_L(0); PG8_MMA(1, 0, At, B0); PG8_BAR; PG8_SCHED;
            PG8_STAGE(PG8_SB(0, 1), b2 + hstep, voffB);
            PG8_WAIT_V(6); PG8_BAR; PG8_MMA(1, 1, At, B1); PG8_BAR;
            PG8_LDB(B0, 1, 0); PG8_SCHED; PG8_LDA(At, 1, 0); PG8_STAGE(PG8_SA(0, 1), a2 + hstep, voffA);
            PG8_WAIT_L(8); PG8_BAR; PG8_WAIT_L(0); PG8_MMA(0, 0, At, B0); PG8_BAR; PG8_SCHED;
            PG8_LDB(B1, 1, 1); PG8_STAGE(PG8_SB(1, 0), b3, voffB);
            PG8_BAR; PG8_WAIT_L(0); PG8_MMA(0, 1, At, B1); PG8_BAR;
            PG8_LDA(At, 1, 1); PG8_STAGE(PG8_SA(1, 0), a3, voffA);
            PG8_BAR; PG8_WAIT_L(0); PG8_MMA(1, 0, At, B0); PG8_BAR; PG8_SCHED;
            PG8_STAGE(PG8_SB(1, 1), b3 + hstep, voffB);
            PG8_WAIT_V(6); PG8_BAR; PG8_MMA(1, 1, At, B1); PG8_BAR;
            }
        }
        if constexpr (ALIGN_EPI) { if (wr == 0) PG8_BAR; }
        if constexpr (!Epi::AFTER_DRAIN) { E(acc, cur, wr, wc, fr, fq); S.done(cur); }
        if (!has_next) break;
#pragma unroll
        for (int a = 0; a < 2; ++a)
#pragma unroll
            for (int b = 0; b < 2; ++b)
#pragma unroll
                for (int m = 0; m < 4; ++m)
#pragma unroll
                    for (int n = 0; n < 2; ++n) acc[a][b][m][n] = (f32x4){0.f, 0.f, 0.f, 0.f};
        cur = nxt; cA = nA; cB = nB; ++ui;
        if constexpr (ALIGN_EPI) { if (wr == 1) PG8_BAR; }
    }
    PG8_WAIT_V(0);
    if constexpr (!ALIGN_EPI) { if (wr == 0) PG8_BAR; }
    PG8_BAR;
    if constexpr (Epi::AFTER_DRAIN) { E.fused(acc, cur, wr, wc, fr, fq, lds, wid, lane); S.done(cur); }
#undef PG8_SA
#undef PG8_SB
#undef PG8_STAGE
#undef PG8_LDA
#undef PG8_LDB
#undef PG8_MMA
#undef PG8_WAIT_V
#undef PG8_WAIT_L
#undef PG8_BAR
#undef PG8_SCHED
}
}

namespace cg = cooperative_groups;
#define LAS __attribute__((address_space(3)))
typedef unsigned short bf16_t;
typedef short bf16x8 __attribute__((ext_vector_type(8)));
typedef float f32x4 __attribute__((ext_vector_type(4)));
typedef float f32x2 __attribute__((ext_vector_type(2)));
typedef unsigned u32x4 __attribute__((ext_vector_type(4)));
typedef unsigned u32x2 __attribute__((ext_vector_type(2)));
using pg8::cvt_pk_bf16;

constexpr int T = 8192, D = 2048, DFF = 8192, NQKV = 2560;
constexpr int LDS_BYTES = 147456;
constexpr float EPS = 1e-6f;
constexpr size_t MiB = 1u << 20;
constexpr size_t WS_MOD = 0;
constexpr size_t WS_LB = 128 * 1024;
constexpr size_t WS_BIAS = 512 * 1024;
constexpr size_t WS_PART = 1 * MiB;
constexpr int RS_OFF = 131072;
constexpr size_t WS_BAR = 256 * 1024, BAR_BYTES = 16384;
constexpr int MODCNT_WORD = 3600;
constexpr int MISC_OFF = LDS_BYTES - 64;
constexpr size_t WS_WT_AIN = 2 * MiB, WS_WT_AOUT = 12 * MiB, WS_WT_HIN = 20 * MiB, WS_WT_HOUT = 52 * MiB;
constexpr size_t WS_WT_W1 = 60 * MiB  , WS_WT_W2 = 124 * MiB  ;
constexpr size_t WS_H = 188 * MiB, WS_QKV = 220 * MiB, WS_ATT = 260 * MiB, WS_XA = 292 * MiB, WS_ACT = 356 * MiB;
constexpr size_t WS_QH = 484 * MiB, WS_LOGF = 516 * MiB, WS_VH = 580 * MiB, WS_GH = 220 * MiB, WS_US = 612 * MiB, WS_SS = 676 * MiB, WS_DEC = 740 * MiB, WS_END = 741 * MiB;

__device__ __forceinline__ float bflo(unsigned u) { return __uint_as_float(u << 16); }
__device__ __forceinline__ float bfhi(unsigned u) { return __uint_as_float(u & 0xffff0000u); }
__device__ __forceinline__ float bf2f(bf16_t u) { return __uint_as_float((unsigned)u << 16); }
__device__ __forceinline__ float wave_sum(float v) {
#pragma unroll
    for (int o = 1; o < 64; o <<= 1) v += __shfl_xor(v, o);
    return v;
}
__device__ __forceinline__ f32x4 mfma16(bf16x8 a, bf16x8 b, f32x4 c) { return __builtin_amdgcn_mfma_f32_16x16x32_bf16(a, b, c, 0, 0, 0); }
__device__ __forceinline__ bf16x8 as_bf16x8(u32x4 v) { return __builtin_bit_cast(bf16x8, v); }

struct Params {
    const float* x; const float* c; const float* mod_w; const float* mod_b; const float* norm_mix; const float* norm_mlp;
    const float* attn_w_in; const float* attn_w_out; const float* attn_q_gain; const float* attn_k_gain; const float* attn_sinks;
    const float* hgrn_w_in; const float* hgrn_w_out; const float* hgrn_o_gain; const float* hgrn_lb_logits; const float* mlp_w1; const float* mlp_w2;
    float* out; unsigned char* ws;
};

__device__ __forceinline__ void p0_transpose_item(const float* W, int K, int N, bf16_t* WT, LAS float* scr, int item, int lane) {
    const int nblk = N / 32, kb = item / nblk, nb = item % nblk, k0 = 64 * kb, n0 = 32 * nb;
#pragma unroll 8
    for (int i = 0; i < 32; ++i) { const int kk = 2 * i + (lane >> 5); scr[kk * 33 + (lane & 31)] = W[(size_t)(k0 + kk) * N + n0 + (lane & 31)]; }
    asm volatile("s_waitcnt lgkmcnt(0)" ::: "memory");
    const int c = lane & 7;
#pragma unroll
    for (int j = 0; j < 4; ++j) { const int n = (lane >> 3) + 8 * j; const LAS float* s = scr + (8 * c) * 33 + n;
        u32x4 o; o.x = cvt_pk_bf16(s[0 * 33], s[1 * 33]); o.y = cvt_pk_bf16(s[2 * 33], s[3 * 33]); o.z = cvt_pk_bf16(s[4 * 33], s[5 * 33]); o.w = cvt_pk_bf16(s[6 * 33], s[7 * 33]);
        *(u32x4*)(WT + (size_t)(n0 + n) * K + k0 + 8 * c) = o; }
    asm volatile("s_waitcnt lgkmcnt(0)" ::: "memory");
}

__device__ __forceinline__ void p0_transpose_item_scaled(const float* W, int K, int N, bf16_t* WT, LAS float* scr, int item, int lane, const float* gain, const float* sc) {
    const int nblk = N / 32, kb = item / nblk, nb = item % nblk, k0 = 64 * kb, n0 = 32 * nb;
#pragma unroll 8
    for (int i = 0; i < 32; ++i) { const int kk = 2 * i + (lane >> 5); scr[kk * 33 + (lane & 31)] = W[(size_t)(k0 + kk) * N + n0 + (lane & 31)] * (gain[k0 + kk] * (1.0f + sc[k0 + kk])); }
    asm volatile("s_waitcnt lgkmcnt(0)" ::: "memory");
    const int c = lane & 7;
#pragma unroll
    for (int j = 0; j < 4; ++j) { const int n = (lane >> 3) + 8 * j; const LAS float* s = scr + (8 * c) * 33 + n;
        u32x4 o; o.x = cvt_pk_bf16(s[0 * 33], s[1 * 33]); o.y = cvt_pk_bf16(s[2 * 33], s[3 * 33]); o.z = cvt_pk_bf16(s[4 * 33], s[5 * 33]); o.w = cvt_pk_bf16(s[6 * 33], s[7 * 33]);
        *(u32x4*)(WT + (size_t)(n0 + n) * K + k0 + 8 * c) = o; }
    asm volatile("s_waitcnt lgkmcnt(0)" ::: "memory");
}

__device__ __forceinline__ void prologue_phase(LAS unsigned char* lds, const Params& p) {
    const int tid = pg8::opaque_tid(), lane = tid & 63, wave = tid >> 6;
    float* MOD = (float*)(p.ws + WS_MOD); float* LB = (float*)(p.ws + WS_LB);
    for (int i = blockIdx.x * 512 + tid; i < 2048; i += gridDim.x * 512) { const float l0 = p.hgrn_lb_logits[i], l1 = p.hgrn_lb_logits[2048 + i]; LB[i] = 1.0f / (1.0f + expf(l0 - l1)); }
    {
        LAS float* cond = (LAS float*)lds; LAS f32x4* red = (LAS f32x4*)(lds + 8192);
        for (int i = tid; i < 2048; i += 512) { const float c = p.c[i]; cond[i] = c / (1.0f + expf(-c)); }
        __syncthreads();
        for (int slice = blockIdx.x; slice < 256; slice += gridDim.x) {
            const int layer = slice >> 7, col0 = (slice & 127) * 96, cgp = tid % 24, kr = tid / 24;
            f32x4 acc = {0.f, 0.f, 0.f, 0.f};
            if (kr < 21) {
                const float* W = p.mod_w + (size_t)layer * 2048 * 12288 + col0 + 4 * cgp;
#pragma unroll 4
                for (int k = kr; k < 2048; k += 21) { const f32x4 w = __builtin_nontemporal_load((const f32x4*)(W + (size_t)k * 12288)); acc += w * cond[k]; }
                red[kr * 24 + cgp] = acc;
            }
            __syncthreads();
            if (tid < 96) { float s = p.mod_b[layer * 12288 + col0 + tid];
                for (int r = 0; r < 21; ++r) s += ((LAS float*)red)[r * 96 + tid];
                MOD[layer * 12288 + col0 + tid] = s; }
            __syncthreads();
        }
    }
    asm volatile("s_waitcnt vmcnt(0)" ::: "memory");
    __syncthreads();
    if (tid == 0) { __builtin_amdgcn_fence(__ATOMIC_RELEASE, "agent"); asm volatile("s_waitcnt vmcnt(0)" ::: "memory");
        (void)__hip_atomic_fetch_add((unsigned*)(p.ws + WS_BAR) + MODCNT_WORD, 1u, __ATOMIC_RELAXED, __HIP_MEMORY_SCOPE_AGENT); }
    LAS float* scr = (LAS float*)(lds + wave * 16384);
    const int gw = blockIdx.x * 8 + wave, NGW = gridDim.x * 8;
    constexpr int I_AIN = (D / 64) * (NQKV / 32), I_SQ = (D / 64) * (D / 32), I_BIG = (D / 64) * (DFF / 32);
    {
        constexpr int NITEMS = I_AIN + 2 * I_SQ + 2 * I_BIG;
        for (int it = gw; it < NITEMS; it += NGW) {
            int r = it;
            if (r < I_AIN) { p0_transpose_item(p.attn_w_in, D, NQKV, (bf16_t*)(p.ws + WS_WT_AIN), scr, r, lane); continue; } r -= I_AIN;
            if (r < I_SQ) { p0_transpose_item(p.attn_w_out, D, D, (bf16_t*)(p.ws + WS_WT_AOUT), scr, r, lane); continue; } r -= I_SQ;
            if (r < I_SQ) { p0_transpose_item(p.hgrn_w_out, D, D, (bf16_t*)(p.ws + WS_WT_HOUT), scr, r, lane); continue; } r -= I_SQ;
            if (r < I_BIG) { p0_transpose_item(p.mlp_w2, DFF, D, (bf16_t*)(p.ws + WS_WT_W2), scr, r, lane); continue; } r -= I_BIG;
            p0_transpose_item(p.mlp_w2 + (size_t)D * DFF, DFF, D, (bf16_t*)(p.ws + WS_WT_W2 + 32 * MiB), scr, r, lane);
        }
    }
    {
        __syncthreads();
        if (tid == 0) { unsigned* cnt = (unsigned*)(p.ws + WS_BAR) + MODCNT_WORD; unsigned sp = 0;
            while (__hip_atomic_load(cnt, __ATOMIC_RELAXED, __HIP_MEMORY_SCOPE_AGENT) < gridDim.x) { __builtin_amdgcn_s_sleep(2); if (++sp > (1u << 22)) break; }
            __builtin_amdgcn_fence(__ATOMIC_ACQUIRE, "agent"); asm volatile("s_waitcnt vmcnt(0)" ::: "memory"); }
        __syncthreads();
    }
    {
        const float* MODc = (const float*)(p.ws + WS_MOD);
        for (int it = gw; it < 3 * I_BIG; it += NGW) {
            int r = it;
            if (r < I_BIG) { p0_transpose_item_scaled(p.mlp_w1, D, DFF, (bf16_t*)(p.ws + WS_WT_W1), scr, r, lane, p.norm_mlp, MODc + 4 * D); continue; } r -= I_BIG;
            if (r < I_BIG) { p0_transpose_item_scaled(p.hgrn_w_in, D, DFF, (bf16_t*)(p.ws + WS_WT_HIN), scr, r, lane, p.norm_mix + D, MODc + 12288 + D); continue; } r -= I_BIG;
            p0_transpose_item_scaled(p.mlp_w1 + (size_t)D * DFF, D, DFF, (bf16_t*)(p.ws + WS_WT_W1 + 32 * MiB), scr, r, lane, p.norm_mlp + D, MODc + 12288 + 4 * D);
        }
    }
    __syncthreads();
}

__device__ __forceinline__ void norm_phase(LAS unsigned char* lds, const float* xin, const float* gain, const float* sh, const float* sc, bf16_t* out) {
    const int tid = pg8::opaque_tid(), lane = tid & 63, wave = tid >> 6;
    LAS float* Av = (LAS float*)lds; LAS float* Bv = (LAS float*)(lds + 8192);
    for (int i = tid; i < 2048; i += 512) { Av[i] = gain[i] * (1.0f + sc[i]); Bv[i] = sh[i]; }
    __syncthreads();
    const int gw = blockIdx.x * 8 + wave, NGW = gridDim.x * 8;
    for (int m = gw; m < T; m += 2 * NGW) {
        const int m2 = m + NGW < T ? m + NGW : m;
        const f32x4* xr = (const f32x4*)(xin + (size_t)m * D) + lane; const f32x4* xr2 = (const f32x4*)(xin + (size_t)m2 * D) + lane;
        f32x4 v[8], v2[8]; float s = 0.f, s2 = 0.f;
#pragma unroll
        for (int j = 0; j < 8; ++j) { v[j] = xr[64 * j]; v2[j] = xr2[64 * j]; }
#pragma unroll
        for (int j = 0; j < 8; ++j) { s += (v[j].x * v[j].x + v[j].y * v[j].y) + (v[j].z * v[j].z + v[j].w * v[j].w); s2 += (v2[j].x * v2[j].x + v2[j].y * v2[j].y) + (v2[j].z * v2[j].z + v2[j].w * v2[j].w); }
        const float rstd = rsqrtf(wave_sum(s) * (1.0f / D) + EPS), rstd2 = rsqrtf(wave_sum(s2) * (1.0f / D) + EPS);
        u32x2* o8 = (u32x2*)(out + (size_t)m * D) + lane; u32x2* o82 = (u32x2*)(out + (size_t)m2 * D) + lane;
#pragma unroll
        for (int j = 0; j < 8; ++j) { const f32x4 a = ((LAS f32x4*)Av)[lane + 64 * j], b = ((LAS f32x4*)Bv)[lane + 64 * j];
            const f32x4 y = v[j] * rstd * a + b, y2 = v2[j] * rstd2 * a + b; u32x2 w, w2; w.x = cvt_pk_bf16(y.x, y.y); w.y = cvt_pk_bf16(y.z, y.w); w2.x = cvt_pk_bf16(y2.x, y2.y); w2.y = cvt_pk_bf16(y2.z, y2.w);
            o8[64 * j] = w; if (m2 != m) o82[64 * j] = w2; }
    }
    __syncthreads();
}


__device__ __forceinline__ void rstd_prepare(LAS float* rs, const float* part, const pg8::StaticOrder& S) {
    const int tid = pg8::opaque_tid(), j = tid >> 7, r0 = (tid & 127) * 2; pg8::Unit u;
    if (S.next(j, u)) {
#pragma unroll
        for (int rr = 0; rr < 2; ++rr) { const f32x4* pp = (const f32x4*)(part + (size_t)(u.pm * 256 + r0 + rr) * 32); float s = 0.f;
#pragma unroll
            for (int i = 0; i < 8; ++i) { const f32x4 v = pp[i]; s += (v.x + v.y) + (v.z + v.w); }
            rs[j * 256 + r0 + rr] = rsqrtf(s * (1.0f / D) + EPS); }
    }
    __syncthreads();
}
__device__ __forceinline__ void bias_gemv(const float* sh, const float* gain, const float* sc, const bf16_t* WT, float* bias, int nrows, int wave_id, int nwaves) {
    const int lane = pg8::opaque_tid() & 63;
    float shv[32];
#pragma unroll
    for (int i = 0; i < 4; ++i)
#pragma unroll
        for (int e = 0; e < 8; ++e) { const int k = (lane + 64 * i) * 8 + e; shv[8 * i + e] = sh[k] / (gain[k] * (1.0f + sc[k])); }
    for (int row = wave_id; row < nrows; row += 4 * nwaves) {
        u32x4 v[4][4];
#pragma unroll
        for (int q = 0; q < 4; ++q) { const int rq = row + q * nwaves < nrows ? row + q * nwaves : row; const u32x4* pr = (const u32x4*)(WT + (size_t)rq * D) + lane;
#pragma unroll
            for (int i = 0; i < 4; ++i) v[q][i] = pr[64 * i]; }
#pragma unroll
        for (int q = 0; q < 4; ++q) { float a = 0.f;
#pragma unroll
            for (int i = 0; i < 4; ++i)
#pragma unroll
                for (int e = 0; e < 4; ++e) a += bflo(v[q][i][e]) * shv[8 * i + 2 * e] + bfhi(v[q][i][e]) * shv[8 * i + 2 * e + 1];
            a = wave_sum(a);
            if (lane == 0 && row + q * nwaves < nrows) bias[row + q * nwaves] = a; }
    }
}

__device__ __forceinline__ void attn_phase(LAS unsigned char* lds, const bf16_t* QKV, const float* qg, const float* kg, const float* sinks, bf16_t* ATT) {
    constexpr int LDQ = NQKV, KST = 72, VST = 280;
    LAS bf16_t* Ks = (LAS bf16_t*)lds;
    LAS bf16_t* Vt = (LAS bf16_t*)(lds + 272 * KST * 2);
    const int tid = pg8::opaque_tid(), lane = tid & 63, wid = tid >> 6, fr = lane & 15, fq = lane >> 4;
    for (int unit = blockIdx.x; unit < 256; unit += gridDim.x) {
        const int kvh = unit & 3, nb = unit >> 2;
        u32x4 q0n, q1n;
        { const u32x4* qp = (const u32x4*)(QKV + (size_t)(nb * 128 + fr) * LDQ + (kvh * 8 + wid) * 64 + 8 * fq); q0n = qp[0]; q1n = qp[4]; }
        {
            const int kp = tid >> 1, half = tid & 1, s_abs = (nb - 1) * 128 + kp;
            u32x4 kr[4], vr[4];
#pragma unroll
            for (int i = 0; i < 4; ++i) { kr[i] = (u32x4){0u, 0u, 0u, 0u}; vr[i] = (u32x4){0u, 0u, 0u, 0u}; }
            if (s_abs >= 0) {
                const u32x4* kptr = (const u32x4*)(QKV + (size_t)s_abs * LDQ + 2048 + kvh * 64 + half * 32);
                const u32x4* vptr = (const u32x4*)(QKV + (size_t)s_abs * LDQ + 2304 + kvh * 64 + half * 32);
#pragma unroll
                for (int i = 0; i < 4; ++i) { kr[i] = kptr[i]; vr[i] = vptr[i]; }
            }
            float ss = 0.f;
#pragma unroll
            for (int i = 0; i < 4; ++i)
#pragma unroll
                for (int e = 0; e < 4; ++e) { const float a = bflo(kr[i][e]), b = bfhi(kr[i][e]); ss += a * a + b * b; }
            ss += __shfl_xor(ss, 1);
            const float rstd = rsqrtf(ss * (1.0f / 64.0f) + EPS);
#pragma unroll
            for (int i = 0; i < 4; ++i) { u32x4 w;
#pragma unroll
                for (int e = 0; e < 4; ++e) { const int d = half * 32 + i * 8 + e * 2; w[e] = cvt_pk_bf16(bflo(kr[i][e]) * rstd * kg[d], bfhi(kr[i][e]) * rstd * kg[d + 1]); }
                *(LAS u32x4*)(Ks + kp * KST + half * 32 + i * 8) = w; }
#pragma unroll
            for (int i = 0; i < 4; ++i)
#pragma unroll
                for (int e = 0; e < 4; ++e) { const int d = half * 32 + i * 8 + e * 2;
                    Vt[d * VST + kp] = (bf16_t)(vr[i][e] & 0xffffu); Vt[(d + 1) * VST + kp] = (bf16_t)(vr[i][e] >> 16); }
            for (int e = tid; e < 16 * KST / 2; e += 512) ((LAS unsigned*)(Ks + 256 * KST))[e] = 0u;
            for (int e = tid; e < 64 * 16; e += 512) Vt[(e >> 4) * VST + 256 + (e & 15)] = (bf16_t)0;
        }
        __syncthreads();
        const int h = kvh * 8 + wid;
        const float LOG2E = 1.4426950408889634f;
        const float slope = exp2f(-0.25f * (float)(h + 1)) * LOG2E, sink = sinks[h] * LOG2E;
        float qgv[16];
#pragma unroll
        for (int e = 0; e < 8; ++e) { qgv[e] = qg[8 * fq + e] * (0.125f * LOG2E); qgv[8 + e] = qg[32 + 8 * fq + e] * (0.125f * LOG2E); }
        float ar[4]; bool m0[4];
#pragma unroll
        for (int r = 0; r < 4; ++r) { ar[r] = slope * (float)(128 + fr - 4 * fq - r); m0[r] = fr < 4 * fq + r; }
        const float s16 = slope * 16.0f;
        for (int mt = 0; mt < 8; ++mt) {
            const int qi = 16 * mt + fr, t_abs = nb * 128 + qi;
            const u32x4 q0 = q0n, q1 = q1n;
            if (mt < 7) { const u32x4* qp = (const u32x4*)(QKV + (size_t)(t_abs + 16) * LDQ + h * 64 + 8 * fq); q0n = qp[0]; q1n = qp[4]; }
            float qf[16]; float ss = 0.f;
#pragma unroll
            for (int e = 0; e < 4; ++e) { qf[2 * e] = bflo(q0[e]); qf[2 * e + 1] = bfhi(q0[e]); qf[8 + 2 * e] = bflo(q1[e]); qf[8 + 2 * e + 1] = bfhi(q1[e]); }
#pragma unroll
            for (int e = 0; e < 16; ++e) ss += qf[e] * qf[e];
            ss += __shfl_xor(ss, 16); ss += __shfl_xor(ss, 32);
            const float rstd = rsqrtf(ss * (1.0f / 64.0f) + EPS);
            u32x4 qa, qb;
#pragma unroll
            for (int e = 0; e < 4; ++e) { qa[e] = cvt_pk_bf16(qf[2 * e] * rstd * qgv[2 * e], qf[2 * e + 1] * rstd * qgv[2 * e + 1]);
                                          qb[e] = cvt_pk_bf16(qf[8 + 2 * e] * rstd * qgv[8 + 2 * e], qf[8 + 2 * e + 1] * rstd * qgv[8 + 2 * e + 1]); }
            const bf16x8 Q0 = as_bf16x8(qa), Q1 = as_bf16x8(qb);
            f32x4 S[10];
#pragma unroll
            for (int jj = 0; jj < 9; ++jj) {
                const LAS bf16_t* kp_ = Ks + (16 * (mt + jj) + fr) * KST + 8 * fq;
                const bf16x8 K0 = *(const LAS bf16x8*)kp_, K1 = *(const LAS bf16x8*)(kp_ + 32);
                f32x4 a = {0.f, 0.f, 0.f, 0.f};
                a = mfma16(K0, Q0, a); a = mfma16(K1, Q1, a); S[jj] = a;
            }
            float mx = sink;
#pragma unroll
            for (int jj = 0; jj < 9; ++jj)
#pragma unroll
                for (int r = 0; r < 4; ++r) {
                    float lg = S[jj][r] - (ar[r] - s16 * (float)jj);
                    if (jj == 0) lg = m0[r] ? lg : -INFINITY;
                    if (jj == 8) lg = m0[r] ? -INFINITY : lg;
                    if (nb == 0) lg = (16 * (mt + jj) + 4 * fq + r >= 128) ? lg : -INFINITY;
                    S[jj][r] = lg; mx = fmaxf(mx, lg);
                }
            mx = fmaxf(mx, __shfl_xor(mx, 16)); mx = fmaxf(mx, __shfl_xor(mx, 32));
            float sum = 0.f;
#pragma unroll
            for (int jj = 0; jj < 9; ++jj)
#pragma unroll
                for (int r = 0; r < 4; ++r) { const float pv = __builtin_amdgcn_exp2f(S[jj][r] - mx); S[jj][r] = pv; sum += pv; }
            S[9] = (f32x4){0.f, 0.f, 0.f, 0.f};
            sum += __shfl_xor(sum, 16); sum += __shfl_xor(sum, 32);
            sum += __builtin_amdgcn_exp2f(sink - mx);
            const float inv = 1.0f / sum;
            f32x4 O[4];
#pragma unroll
            for (int dt = 0; dt < 4; ++dt) O[dt] = (f32x4){0.f, 0.f, 0.f, 0.f};
#pragma unroll
            for (int pp = 0; pp < 5; ++pp) {
                u32x4 pw; pw.x = cvt_pk_bf16(S[2 * pp][0], S[2 * pp][1]); pw.y = cvt_pk_bf16(S[2 * pp][2], S[2 * pp][3]);
                pw.z = cvt_pk_bf16(S[2 * pp + 1][0], S[2 * pp + 1][1]); pw.w = cvt_pk_bf16(S[2 * pp + 1][2], S[2 * pp + 1][3]);
                const bf16x8 P = as_bf16x8(pw);
                const int ka = 16 * (mt + 2 * pp) + 4 * fq;
#pragma unroll
                for (int dt = 0; dt < 4; ++dt) {
                    const LAS bf16_t* vrow = Vt + (16 * dt + fr) * VST + ka;
                    const u32x2 va = *(const LAS u32x2*)vrow, vb = *(const LAS u32x2*)(vrow + 16);
                    u32x4 vw; vw.x = va.x; vw.y = va.y; vw.z = vb.x; vw.w = vb.y;
                    O[dt] = mfma16(as_bf16x8(vw), P, O[dt]);
                }
            }
            bf16_t* orow = ATT + (size_t)t_abs * D + h * 64 + 4 * fq;
#pragma unroll
            for (int dt = 0; dt < 4; ++dt) { u32x2 w; w.x = cvt_pk_bf16(O[dt][0] * inv, O[dt][1] * inv); w.y = cvt_pk_bf16(O[dt][2] * inv, O[dt][3] * inv);
                *(u32x2*)(orow + 16 * dt) = w; }
        }
        __syncthreads();
    }
}

__device__ __forceinline__ void hgrn_h1(LAS unsigned char* lds, const bf16_t* LOGF, const bf16_t* Vh, bf16_t* US, float* DEC) {
    LAS float* B = (LAS float*)lds;
    LAS float* TOT = (LAS float*)(lds + 32768);
    LAS bf16_t* KT = (LAS bf16_t*)(lds + 34816);
    LAS bf16_t* VT = (LAS bf16_t*)(lds + 34816 + 18432);
    LAS float* EB = (LAS float*)(lds + 71680);
    const int tid = pg8::opaque_tid(), lane = tid & 63, wid = tid >> 6, fr = lane & 15, fq = lane >> 4;
    const int d = tid & 127, seg = tid >> 7;
    u32x4 pl[2]; bf16_t pv[16];
#define H1_LOAD(su_) do { const int u_ = (su_) >> 1, t0_ = (u_ >> 4) * 128 + 64 * ((su_) & 1), h_ = u_ & 15; \
        _Pragma("unroll") for (int i = 0; i < 2; ++i) { const int idx = tid + 512 * i, row = idx >> 4, c8 = idx & 15; pl[i] = *(const u32x4*)(LOGF + (size_t)(t0_ + row) * D + h_ * 128 + 8 * c8); } \
        _Pragma("unroll") for (int i = 0; i < 16; ++i) pv[i] = Vh[(size_t)(t0_ + 16 * seg + i) * D + h_ * 128 + d]; } while (0)
    if ((int)blockIdx.x < 1024) H1_LOAD(2 * (int)blockIdx.x);
    for (int unit = blockIdx.x; unit < 1024; unit += gridDim.x) {
        const int N = unit >> 4, h = unit & 15;
        f32x4 accA[8]; float totA = 0.f;
#pragma unroll
        for (int sub = 0; sub < 2; ++sub) {
#pragma unroll
            for (int i = 0; i < 2; ++i) { const int idx = tid + 512 * i;
                ((LAS f32x4*)B)[2 * idx] = (f32x4){bflo(pl[i].x), bfhi(pl[i].x), bflo(pl[i].y), bfhi(pl[i].y)};
                ((LAS f32x4*)B)[2 * idx + 1] = (f32x4){bflo(pl[i].z), bfhi(pl[i].z), bflo(pl[i].w), bfhi(pl[i].w)}; }
            bf16_t vv[16];
#pragma unroll
            for (int i = 0; i < 16; ++i) vv[i] = pv[i];
            __syncthreads();
            if (sub == 0) H1_LOAD(2 * unit + 1); else if (unit + (int)gridDim.x < 1024) H1_LOAD(2 * (unit + (int)gridDim.x));
            float lf[16], b[16]; float run = 0.f;
#pragma unroll
            for (int i = 0; i < 16; ++i) { lf[i] = B[(16 * seg + i) * 128 + d]; run += lf[i]; b[i] = run; }
            TOT[seg * 128 + d] = run;
            __syncthreads();
            float off = 0.f, tot = 0.f;
#pragma unroll
            for (int s2 = 0; s2 < 4; ++s2) { const float tv = TOT[s2 * 128 + d]; off += (s2 < seg) ? tv : 0.f; tot += tv; }
            u32x4 kw[2], vw[2];
#pragma unroll
            for (int i = 0; i < 16; i += 2) {
                const float k0 = (1.0f - __expf(lf[i])) * __expf(tot - (b[i] + off)), k1 = (1.0f - __expf(lf[i + 1])) * __expf(tot - (b[i + 1] + off));
                kw[i >> 3][(i >> 1) & 3] = cvt_pk_bf16(k0, k1);
                vw[i >> 3][(i >> 1) & 3] = (unsigned)vv[i] | ((unsigned)vv[i + 1] << 16);
            }
            *(LAS u32x4*)(KT + d * 72 + 16 * seg) = kw[0]; *(LAS u32x4*)(KT + d * 72 + 16 * seg + 8) = kw[1];
            *(LAS u32x4*)(VT + d * 72 + 16 * seg) = vw[0]; *(LAS u32x4*)(VT + d * 72 + 16 * seg + 8) = vw[1];
            if (seg == 0) { if (sub == 0) totA = tot; else { EB[d] = __expf(tot); DEC[(size_t)(N * 16 + h) * 128 + d] = __expf(totA + tot); } }
            __syncthreads();
            const bf16x8 V0 = *(const LAS bf16x8*)(VT + (16 * wid + fr) * 72 + 8 * fq), V1 = *(const LAS bf16x8*)(VT + (16 * wid + fr) * 72 + 8 * fq + 32);
            bf16_t* urow = US + ((size_t)(N * 16 + h) * 128 + 16 * wid + fr) * 128 + 4 * fq;
#pragma unroll
            for (int dt = 0; dt < 8; ++dt) {
                const bf16x8 K0 = *(const LAS bf16x8*)(KT + (16 * dt + fr) * 72 + 8 * fq), K1 = *(const LAS bf16x8*)(KT + (16 * dt + fr) * 72 + 8 * fq + 32);
                f32x4 a = {0.f, 0.f, 0.f, 0.f};
                a = mfma16(K0, V0, a); a = mfma16(K1, V1, a);
                if (sub == 0) accA[dt] = a;
                else { const f32x4 e4 = *(const LAS f32x4*)(EB + 16 * dt + 4 * fq); const f32x4 u = accA[dt] * e4 + a;
                    u32x2 w; w.x = cvt_pk_bf16(u[0], u[1]); w.y = cvt_pk_bf16(u[2], u[3]);
                    *(u32x2*)(urow + 16 * dt) = w; }
            }
            __syncthreads();
        }
    }
}
__device__ __forceinline__ void hgrn_h2(const bf16_t* US, bf16_t* SS, const float* DEC) {
    for (int pidx = blockIdx.x * 512 + threadIdx.x; pidx < 131072; pidx += gridDim.x * 512) {
        const int e = 2 * pidx, h = e >> 14, dd = e & 127;
        float s0 = 0.f, s1 = 0.f;
        for (int n0 = 0; n0 < 64; n0 += 16) {
            unsigned u[16]; f32x2 dc[16];
#pragma unroll
            for (int i = 0; i < 16; ++i) { u[i] = __builtin_nontemporal_load((const unsigned*)(US + (size_t)(n0 + i) * 262144 + e)); dc[i] = *(const f32x2*)(DEC + (size_t)((n0 + i) * 16 + h) * 128 + dd); }
#pragma unroll
            for (int i = 0; i < 16; ++i) { *(unsigned*)(SS + (size_t)(n0 + i) * 262144 + e) = cvt_pk_bf16(s0, s1);
                s0 = dc[i].x * s0 + bflo(u[i]); s1 = dc[i].y * s1 + bfhi(u[i]); }
        }
    }
}
__device__ __forceinline__ void hgrn_h3(LAS unsigned char* lds, const bf16_t* LOGF, const bf16_t* Qh, const bf16_t* Vh, const bf16_t* Gh, const bf16_t* US, const float* og, bf16_t* OUT) {
    LAS float* B = (LAS float*)lds;
    LAS bf16_t* KTA = (LAS bf16_t*)lds;
    LAS float* TOT = (LAS float*)(lds + 33792);
    LAS float* EP = (LAS float*)(lds + 35840);
    LAS bf16_t* QT = (LAS bf16_t*)(lds + 36352);
    LAS bf16_t* KQ = (LAS bf16_t*)(lds + 53760);
    LAS bf16_t* AM = (LAS bf16_t*)(lds + 71168);
    LAS bf16_t* VT = (LAS bf16_t*)(lds + 80384);
    LAS bf16_t* ST = (LAS bf16_t*)(lds + 98816);
    LAS float* EA = (LAS float*)(lds + 133632);
    const int tid = pg8::opaque_tid(), lane = tid & 63, wid = tid >> 6, fr = lane & 15, fq = lane >> 4;
    const int d = tid & 127, seg = tid >> 7;
    u32x4 pl[2]; bf16_t pv[16], pq[16];
#define H3_LOAD(su_) do { const int u_ = (su_) >> 1, t0_ = (u_ >> 4) * 128 + 64 * ((su_) & 1), h_ = u_ & 15; \
        _Pragma("unroll") for (int i = 0; i < 2; ++i) { const int idx = tid + 512 * i, row = idx >> 4, c8 = idx & 15; pl[i] = *(const u32x4*)(LOGF + (size_t)(t0_ + row) * D + h_ * 128 + 8 * c8); } \
        _Pragma("unroll") for (int i = 0; i < 16; ++i) { pv[i] = Vh[(size_t)(t0_ + 16 * seg + i) * D + h_ * 128 + d]; pq[i] = Qh[(size_t)(t0_ + 16 * seg + i) * D + h_ * 128 + d]; } } while (0)
    if ((int)blockIdx.x < 1024) H3_LOAD(2 * (int)blockIdx.x);
    for (int unit = blockIdx.x; unit < 1024; unit += gridDim.x) {
        const int N = unit >> 4, h = unit & 15;
        f32x4 accU[8];
#pragma unroll
        for (int sub = 0; sub < 2; ++sub) {
            const int t0 = N * 128 + 64 * sub;
#pragma unroll
            for (int i = 0; i < 2; ++i) { const int idx = tid + 512 * i;
                ((LAS f32x4*)B)[2 * idx] = (f32x4){bflo(pl[i].x), bfhi(pl[i].x), bflo(pl[i].y), bfhi(pl[i].y)};
                ((LAS f32x4*)B)[2 * idx + 1] = (f32x4){bflo(pl[i].z), bfhi(pl[i].z), bflo(pl[i].w), bfhi(pl[i].w)}; }
            bf16_t vv[16], qq[16];
#pragma unroll
            for (int i = 0; i < 16; ++i) { vv[i] = pv[i]; qq[i] = pq[i]; }
            u32x2 sraw[8];
            if (sub == 1) { const bf16_t* sp2 = US + ((size_t)(N * 16 + h) * 128 + 16 * wid + fr) * 128 + 4 * fq;
#pragma unroll
                for (int dt = 0; dt < 8; ++dt) sraw[dt] = *(const u32x2*)(sp2 + 16 * dt); }
            __syncthreads();
            if (sub == 0) H3_LOAD(2 * unit + 1); else if (unit + (int)gridDim.x < 1024) H3_LOAD(2 * (unit + (int)gridDim.x));
            float lf[16], b[16]; float run = 0.f;
#pragma unroll
            for (int i = 0; i < 16; ++i) { lf[i] = B[(16 * seg + i) * 128 + d]; run += lf[i]; b[i] = run; }
            TOT[seg * 128 + d] = run;
            __syncthreads();
            const float t0v = TOT[d], t1v = TOT[128 + d], t2v = TOT[256 + d], t3v = TOT[384 + d];
            const float off = (seg > 0 ? t0v : 0.f) + (seg > 1 ? t1v : 0.f) + (seg > 2 ? t2v : 0.f), piv = t0v + t1v, tot = (t0v + t1v) + (t2v + t3v);
            u32x4 vw[2], kw[2];
#pragma unroll
            for (int i = 0; i < 16; ++i) {
                const float bi = b[i] + off; const int c = 16 * seg + i;
                const float kk = 1.0f - __expf(lf[i]);
                const float qt = bf2f(qq[i]) * __expf(bi - piv), kt = kk * __expf(piv - bi);
                QT[c * 136 + d] = (bf16_t)(cvt_pk_bf16(qt, 0.f) & 0xffffu); KQ[c * 136 + d] = (bf16_t)(cvt_pk_bf16(kt, 0.f) & 0xffffu);
                if (sub == 0) { const float kh = kk * __expf(tot - bi); lf[i] = kh; }
            }
#pragma unroll
            for (int i = 0; i < 16; i += 2) { vw[i >> 3][(i >> 1) & 3] = (unsigned)vv[i] | ((unsigned)vv[i + 1] << 16); if (sub == 0) kw[i >> 3][(i >> 1) & 3] = cvt_pk_bf16(lf[i], lf[i + 1]); }
            *(LAS u32x4*)(VT + d * 72 + 16 * seg) = vw[0]; *(LAS u32x4*)(VT + d * 72 + 16 * seg + 8) = vw[1];
            if (sub == 0) { *(LAS u32x4*)(KTA + d * 72 + 16 * seg) = kw[0]; *(LAS u32x4*)(KTA + d * 72 + 16 * seg + 8) = kw[1]; }
            if (seg == 0) { EP[d] = __expf(piv); if (sub == 0) EA[d] = __expf(tot); }
            __syncthreads();
            if (sub == 0) {
                const int v = tid >> 2, dq = (tid & 3) * 32;
                const u32x4* sp = (const u32x4*)(US + ((size_t)(N * 16 + h) * 128 + v) * 128 + dq);
#pragma unroll
                for (int i = 0; i < 4; ++i) { const u32x4 s = sp[i]; u32x4 w;
#pragma unroll
                    for (int e = 0; e < 4; ++e) { const int dd = dq + 8 * i + 2 * e; w[e] = cvt_pk_bf16(bflo(s[e]) * EP[dd], bfhi(s[e]) * EP[dd + 1]); }
                    *(LAS u32x4*)(ST + v * 136 + dq + 8 * i) = w; }
            } else {
#pragma unroll
                for (int dt = 0; dt < 8; ++dt) { const f32x4 ea = *(const LAS f32x4*)(EA + 16 * dt + 4 * fq), ep = *(const LAS f32x4*)(EP + 16 * dt + 4 * fq);
                    const f32x4 sv = {bflo(sraw[dt].x), bfhi(sraw[dt].x), bflo(sraw[dt].y), bfhi(sraw[dt].y)};
                    const f32x4 r = (sv * ea + accU[dt]) * ep;
                    u32x2 w; w.x = cvt_pk_bf16(r[0], r[1]); w.y = cvt_pk_bf16(r[2], r[3]);
                    *(LAS u32x2*)(ST + (16 * wid + fr) * 136 + 16 * dt + 4 * fq) = w; }
            }
            {
                const int ct = wid >> 1;
#pragma unroll
                for (int sti = 0; sti < 2; ++sti) {
                    const int st = 2 * (wid & 1) + sti;
                    f32x4 a = {0.f, 0.f, 0.f, 0.f};
                    if (st <= ct) {
#pragma unroll
                        for (int ks = 0; ks < 4; ++ks) {
                            const bf16x8 Kf = *(const LAS bf16x8*)(KQ + (16 * st + fr) * 136 + 8 * fq + 32 * ks), Qf = *(const LAS bf16x8*)(QT + (16 * ct + fr) * 136 + 8 * fq + 32 * ks);
                            a = mfma16(Kf, Qf, a);
                        }
                    }
                    const int c = 16 * ct + fr, s = 16 * st + 4 * fq;
#pragma unroll
                    for (int r = 0; r < 4; ++r) a[r] = (st <= ct && s + r <= c) ? a[r] : 0.f;
                    u32x2 w; w.x = cvt_pk_bf16(a[0], a[1]); w.y = cvt_pk_bf16(a[2], a[3]);
                    *(LAS u32x2*)(AM + c * 72 + s) = w;
                }
            }
            if (sub == 0) {
                const bf16x8 V0 = *(const LAS bf16x8*)(VT + (16 * wid + fr) * 72 + 8 * fq), V1 = *(const LAS bf16x8*)(VT + (16 * wid + fr) * 72 + 8 * fq + 32);
#pragma unroll
                for (int dt = 0; dt < 8; ++dt) {
                    const bf16x8 K0 = *(const LAS bf16x8*)(KTA + (16 * dt + fr) * 72 + 8 * fq), K1 = *(const LAS bf16x8*)(KTA + (16 * dt + fr) * 72 + 8 * fq + 32);
                    f32x4 a = {0.f, 0.f, 0.f, 0.f};
                    a = mfma16(K0, V0, a); a = mfma16(K1, V1, a); accU[dt] = a;
                }
            }
            __syncthreads();
            {
                bf16x8 Sf[4], Vf[2];
#pragma unroll
                for (int ks = 0; ks < 4; ++ks) Sf[ks] = *(const LAS bf16x8*)(ST + (16 * wid + fr) * 136 + 8 * fq + 32 * ks);
#pragma unroll
                for (int ks = 0; ks < 2; ++ks) Vf[ks] = *(const LAS bf16x8*)(VT + (16 * wid + fr) * 72 + 8 * fq + 32 * ks);
#pragma unroll
                for (int ct = 0; ct < 4; ++ct) {
                    f32x4 a = {0.f, 0.f, 0.f, 0.f};
#pragma unroll
                    for (int ks = 0; ks < 4; ++ks) a = mfma16(Sf[ks], *(const LAS bf16x8*)(QT + (16 * ct + fr) * 136 + 8 * fq + 32 * ks), a);
#pragma unroll
                    for (int ks = 0; ks < 2; ++ks) a = mfma16(Vf[ks], *(const LAS bf16x8*)(AM + (16 * ct + fr) * 72 + 8 * fq + 32 * ks), a);
                    *(LAS f32x4*)(B + (16 * ct + fr) * 132 + 16 * wid + 4 * fq) = a;
                }
            }
            __syncthreads();
            {
                const int c = tid >> 3, v0 = (tid & 7) * 16;
                f32x4 o[4]; float ss = 0.f;
#pragma unroll
                for (int i = 0; i < 4; ++i) { o[i] = *(const LAS f32x4*)(B + c * 132 + v0 + 4 * i); ss += (o[i].x * o[i].x + o[i].y * o[i].y) + (o[i].z * o[i].z + o[i].w * o[i].w); }
                ss += __shfl_xor(ss, 1); ss += __shfl_xor(ss, 2); ss += __shfl_xor(ss, 4);
                const float rstd = rsqrtf(ss * (1.0f / 128.0f) + EPS);
                const u32x4* gp = (const u32x4*)(Gh + (size_t)(t0 + c) * D + h * 128 + v0);
                const u32x4 g0 = gp[0], g1 = gp[1];
                const f32x4* ogp = (const f32x4*)(og + h * 128 + v0);
                u32x4 w0, w1;
#pragma unroll
                for (int i = 0; i < 2; ++i) { const f32x4 ga = ogp[i];
                    w0[2 * i] = cvt_pk_bf16(o[i].x * rstd * ga.x * bflo(g0[2 * i]), o[i].y * rstd * ga.y * bfhi(g0[2 * i]));
                    w0[2 * i + 1] = cvt_pk_bf16(o[i].z * rstd * ga.z * bflo(g0[2 * i + 1]), o[i].w * rstd * ga.w * bfhi(g0[2 * i + 1])); }
#pragma unroll
                for (int i = 0; i < 2; ++i) { const f32x4 ga = ogp[2 + i];
                    w1[2 * i] = cvt_pk_bf16(o[2 + i].x * rstd * ga.x * bflo(g1[2 * i]), o[2 + i].y * rstd * ga.y * bfhi(g1[2 * i]));
                    w1[2 * i + 1] = cvt_pk_bf16(o[2 + i].z * rstd * ga.z * bflo(g1[2 * i + 1]), o[2 + i].w * rstd * ga.w * bfhi(g1[2 * i + 1])); }
                u32x4* op = (u32x4*)(OUT + (size_t)(t0 + c) * D + h * 128 + v0);
                op[0] = w0; op[1] = w1;
            }
            __syncthreads();
        }
    }
}

#define XB_TMO      128
#define XB_XCNT(j)  (256  + 64 * (j))
#define XB_XSUB(j)  (1280 + 64 * (j))
#define XB_XGEN(j)  (2304 + 64 * (j))
#define XB_TOP      3328
#define XB_TOPGEN   3392
#define XCD_BAR_WORDS 3456
#define XB_SPIN_CAP (1u << 18)

__device__ __forceinline__ unsigned xb_ld(unsigned* p)              { return __hip_atomic_load(p, __ATOMIC_RELAXED, __HIP_MEMORY_SCOPE_AGENT); }
__device__ __forceinline__ unsigned xb_add(unsigned* p, unsigned v) { return __hip_atomic_fetch_add(p, v, __ATOMIC_RELAXED, __HIP_MEMORY_SCOPE_AGENT); }
__device__ __forceinline__ unsigned xb_xcc_id() { return (unsigned)__builtin_amdgcn_s_getreg((3 << 11) | 20) & 0xFu; }
#define XB_SPIN(cond, bar) do { unsigned _sp = 0; while (cond) { __builtin_amdgcn_s_sleep(1); \
    if ((++_sp & 255u) == 0u) { if (xb_ld(&(bar)[XB_TMO])) break; if (_sp > XB_SPIN_CAP) { atomicAdd(&(bar)[XB_TMO], 1u); break; } } } } while (0)

struct XcdBarrier {
    unsigned* bar; unsigned x;
    volatile LAS unsigned* st;
};

__device__ __forceinline__ XcdBarrier xcd_barrier_post(unsigned* bar, volatile LAS unsigned* st) {
    XcdBarrier b; b.bar = bar; b.x = xb_xcc_id(); b.st = st;
    if (threadIdx.x == 0) (void)xb_add(&bar[XB_XCNT(b.x)], 1u);
    return b;
}
__device__ __forceinline__ void xcd_barrier_complete(unsigned* bar, unsigned x, unsigned& nloc, unsigned& nx) {
    const unsigned G = gridDim.x * gridDim.y * gridDim.z;
    unsigned sum, cnt, mine, sp = 0u;
    for (;;) {
        sum = 0u; cnt = 0u; mine = 0u;
#pragma unroll
        for (unsigned j = 0; j < 16; ++j) { const unsigned c = xb_ld(&bar[XB_XCNT(j)]); sum += c; cnt += (c > 0u) ? 1u : 0u; mine = (j == x) ? c : mine; }
        if (sum == G) break;
        __builtin_amdgcn_s_sleep(1);
        if ((++sp & 255u) == 0u) { if (xb_ld(&bar[XB_TMO])) break; if (sp > XB_SPIN_CAP) { atomicAdd(&bar[XB_TMO], 1u); break; } }
    }
    nloc = mine > 0u ? mine : 1u; nx = cnt > 0u ? cnt : 1u;
}

__device__ __forceinline__ void xcd_barrier(const XcdBarrier& b) {
    asm volatile("s_waitcnt vmcnt(0)" ::: "memory");
    __syncthreads();
    if (threadIdx.x == 0) {
        unsigned* bar = b.bar;
        __builtin_amdgcn_s_waitcnt(0);
        unsigned nloc = b.st[0], nx = b.st[1];
        if (nloc == 0u) { xcd_barrier_complete(bar, b.x, nloc, nx); b.st[0] = nloc; b.st[1] = nx; }
        const unsigned old = xb_add(&bar[XB_XSUB(b.x)], 1u);
        const unsigned gen = old / nloc;
        if (old + 1u == (gen + 1u) * nloc) {
            __builtin_amdgcn_fence(__ATOMIC_RELEASE, "agent");
            asm volatile("s_waitcnt vmcnt(0)" ::: "memory");
            const unsigned og = xb_add(&bar[XB_TOP], 1u);
            const unsigned tg = og / nx;
            if (og + 1u == (tg + 1u) * nx) xb_add(&bar[XB_TOPGEN], 1u);
            else XB_SPIN(xb_ld(&bar[XB_TOPGEN]) == tg, bar);
            __builtin_amdgcn_fence(__ATOMIC_ACQUIRE, "agent");
            xb_add(&bar[XB_XGEN(b.x)], 1u);
            asm volatile("s_waitcnt vmcnt(0)" ::: "memory");
        } else {
            XB_SPIN(xb_ld(&bar[XB_XGEN(b.x)]) == gen, bar);
            __builtin_amdgcn_fence(__ATOMIC_ACQUIRE, "agent");
            asm volatile("s_waitcnt vmcnt(0)" ::: "memory");
        }
    }
    __syncthreads();
}

__global__ void __launch_bounds__(512, 2) fwd_megakernel(Params p) {
    extern __shared__ __attribute__((aligned(16))) unsigned char lds_raw[];
    LAS unsigned char* lds = (LAS unsigned char*)lds_raw;
    cg::grid_group grid = cg::this_grid();
    unsigned char* ws = p.ws;
    const float* MOD = (const float*)(ws + WS_MOD);
    bf16_t* H = (bf16_t*)(ws + WS_H); bf16_t* QKV = (bf16_t*)(ws + WS_QKV); bf16_t* ATT = (bf16_t*)(ws + WS_ATT); bf16_t* XA = (bf16_t*)(ws + WS_XA);   bf16_t* ACT = (bf16_t*)(ws + WS_ACT);
    bf16_t* QH = (bf16_t*)(ws + WS_QH); bf16_t* LOGF = (bf16_t*)(ws + WS_LOGF); bf16_t* VH = (bf16_t*)(ws + WS_VH); bf16_t* GH = (bf16_t*)(ws + WS_GH); bf16_t* US = (bf16_t*)(ws + WS_US); bf16_t* SS = (bf16_t*)(ws + WS_SS); float* DEC = (float*)(ws + WS_DEC);
    const int G = gridDim.x, bx = blockIdx.x;

    if (threadIdx.x < 16) ((LAS unsigned*)(lds + MISC_OFF))[threadIdx.x] = 0u;
    __syncthreads();
    const XcdBarrier bar = xcd_barrier_post((unsigned*)(ws + WS_BAR), (volatile LAS unsigned*)(lds + MISC_OFF));
#define CG_SYNC() do { asm volatile("s_waitcnt vmcnt(0) lgkmcnt(0)" ::: "memory"); grid.sync(); __builtin_amdgcn_fence(__ATOMIC_ACQUIRE, "agent"); asm volatile("s_waitcnt vmcnt(0)" ::: "memory"); __syncthreads(); } while (0)
#define GRID_SYNC() xcd_barrier(bar)
    prologue_phase(lds, p);
    norm_phase(lds, p.x, p.norm_mix, MOD, MOD + D, H);
    if (p.ws == nullptr) CG_SYNC();
    GRID_SYNC();
#define GEMM_PHASE(EpiT, Aptr, WToff, Nn, Kk, ...) do { pg8::Gemm g{Aptr, (const bf16_t*)(ws + (WToff)), T, Nn, Kk}; pg8::StaticOrder S; S.init(T, Nn, G, bx); \
        EpiT E{__VA_ARGS__}; pg8::gemm_phase<EpiT, pg8::StaticOrder, true, true>(lds, g, S, E); } while (0)
    float* BIAS = (float*)(ws + WS_BIAS); float* PART = (float*)(ws + WS_PART); LAS float* RS = (LAS float*)(lds + RS_OFF);
    GEMM_PHASE(pg8::EpiStore<0>, H, WS_WT_AIN, NQKV, D, QKV, NQKV);
    {
        const int busy2 = (T / 256) * (NQKV / 256) - G; const bool split = busy2 > 0 && busy2 < G;
        if (!split || bx >= busy2) {
            const int wv = (split ? bx - busy2 : bx) * 8 + (pg8::opaque_tid() >> 6), nw = (split ? G - busy2 : G) * 8;
            bias_gemv(MOD + 3 * D, p.norm_mlp, MOD + 4 * D, (const bf16_t*)(ws + WS_WT_W1), BIAS, DFF, wv, nw);
            bias_gemv(MOD + 12288, p.norm_mix + D, MOD + 12288 + D, (const bf16_t*)(ws + WS_WT_HIN), BIAS + DFF, DFF, wv, nw);
            bias_gemv(MOD + 12288 + 3 * D, p.norm_mlp + D, MOD + 12288 + 4 * D, (const bf16_t*)(ws + WS_WT_W1 + 32 * MiB), BIAS + 2 * DFF, DFF, wv, nw);
        }
    }
    GRID_SYNC();
    attn_phase(lds, QKV, p.attn_q_gain, p.attn_k_gain, p.attn_sinks, ATT);
    GRID_SYNC();
    GEMM_PHASE(pg8::EpiResidN<false>, ATT, WS_WT_AOUT, D, D, p.x, XA, MOD + 2 * D, D, PART);
    GRID_SYNC();
#define GEMM_PHASE_N(EpiT, Aptr, WToff, ...) do { pg8::Gemm g{Aptr, (const bf16_t*)(ws + (WToff)), T, DFF, D}; pg8::StaticOrder S; S.init(T, DFF, G, bx); rstd_prepare(RS, PART, S); \
        EpiT E{__VA_ARGS__}; pg8::gemm_phase<EpiT, pg8::StaticOrder, true, true>(lds, g, S, E); } while (0)
    GEMM_PHASE_N(pg8::EpiStoreN<2>, XA, WS_WT_W1, ACT, DFF, BIAS, RS, 0);
    GRID_SYNC();
    GEMM_PHASE(pg8::EpiResidN<true>, ACT, WS_WT_W2, D, DFF, XA, XA, MOD + 5 * D, D, PART);
    GRID_SYNC();
    GEMM_PHASE_N(pg8::EpiHgrn, XA, WS_WT_HIN, QH, LOGF, VH, GH, (const float*)(ws + WS_LB), 0.08838834764831845f, BIAS + DFF, RS, 0);
    GRID_SYNC();
    hgrn_h1(lds, LOGF, VH, US, DEC);
    GRID_SYNC();
    hgrn_h2(US, SS, DEC);
    GRID_SYNC();
    hgrn_h3(lds, LOGF, QH, VH, GH, SS, p.hgrn_o_gain, ATT);
    GRID_SYNC();
    GEMM_PHASE(pg8::EpiResidN<true>, ATT, WS_WT_HOUT, D, D, XA, XA, MOD + 12288 + 2 * D, D, PART);
    GRID_SYNC();
    GEMM_PHASE_N(pg8::EpiStoreN<2>, XA, WS_WT_W1 + 32 * MiB, ACT, DFF, BIAS + 2 * DFF, RS, 0);
    GRID_SYNC();
    GEMM_PHASE(pg8::EpiResidF, ACT, WS_WT_W2 + 32 * MiB, D, DFF, XA, p.out, MOD + 12288 + 5 * D, D);
}

extern "C" void kernel_launch(void* const* d_in, const int* in_sizes, int n_in, void* d_out, int out_size, void* d_ws, size_t ws_size, hipStream_t stream) {
    static int grid = 0;
    if (grid == 0) {
        if (n_in != 17 || out_size != T * D || ws_size < WS_END) { fprintf(stderr, "kernel_launch: unexpected shapes (n_in %d out %d ws %zu, need %zu)\n", n_in, out_size, ws_size, (size_t)WS_END); grid = -1; return; }
        int dev = 0, cus = 0, per_cu = 0;
        (void)hipGetDevice(&dev);
        (void)hipDeviceGetAttribute(&cus, hipDeviceAttributeMultiprocessorCount, dev);
        (void)hipFuncSetAttribute((const void*)fwd_megakernel, hipFuncAttributeMaxDynamicSharedMemorySize, LDS_BYTES);
        (void)hipOccupancyMaxActiveBlocksPerMultiprocessor(&per_cu, (const void*)fwd_megakernel, 512, LDS_BYTES);
        if (per_cu < 1) { fprintf(stderr, "kernel_launch: occupancy query says %d blocks per CU\n", per_cu); per_cu = 1; }
        grid = cus * per_cu;
        if (grid != 256) { fprintf(stderr, "kernel_launch: built for a 256-workgroup grid (got %d)\n", grid); grid = -1; return; }
    }
    if (grid < 0) return;
    Params p{};
    p.x = (const float*)d_in[0]; p.c = (const float*)d_in[1]; p.mod_w = (const float*)d_in[2]; p.mod_b = (const float*)d_in[3];
    p.norm_mix = (const float*)d_in[4]; p.norm_mlp = (const float*)d_in[5]; p.attn_w_in = (const float*)d_in[6]; p.attn_w_out = (const float*)d_in[7];
    p.attn_q_gain = (const float*)d_in[8]; p.attn_k_gain = (const float*)d_in[9]; p.attn_sinks = (const float*)d_in[10];
    p.hgrn_w_in = (const float*)d_in[11]; p.hgrn_w_out = (const float*)d_in[12]; p.hgrn_o_gain = (const float*)d_in[13]; p.hgrn_lb_logits = (const float*)d_in[14];
    p.mlp_w1 = (const float*)d_in[15]; p.mlp_w2 = (const float*)d_in[16];
    p.out = (float*)d_out; p.ws = (unsigned char*)d_ws;
    (void)hipMemsetAsync((char*)d_ws + WS_BAR, 0, BAR_BYTES, stream);
    void* args[] = {&p};
    hipError_t e = hipLaunchCooperativeKernel((const void*)fwd_megakernel, dim3(grid), dim3(512), args, LDS_BYTES, stream);
    if (e != hipSuccess) fprintf(stderr, "kernel_launch: cooperative launch failed: %s (grid %d)\n", hipGetErrorString(e), grid);
}
```

```cpp
#include <hip/hip_runtime.h>
#include <hip/hip_cooperative_groups.h>
#include <cstdio>
#include <cstdint>
#include <cmath>
namespace pg8 {
#define PG8_LAS __attribute__((address_space(3)))
typedef unsigned short bf16_t;
typedef short bf16x8 __attribute__((ext_vector_type(8)));
typedef float f32x4 __attribute__((ext_vector_type(4)));
typedef unsigned u32x4 __attribute__((ext_vector_type(4)));
constexpr int BM = 256, BK = 64, HALF = 128, HTB = HALF * BK * 2  , STAGE_BYTES = 8 * HTB, NXCD = 8, WGM = 4;

__host__ __device__ __forceinline__ int lds_byte(int r, int c) { const int st = (r >> 4) * 2 + (c >> 5), rr = r & 15, cc = c & 31, ob = rr * 64 + cc * 2; return st * 1024 + (ob ^ (((ob >> 9) & 1) << 5)); }
__host__ __device__ __forceinline__ void stage_rc(int b, int& R, int& C) { const int st = b / 1024, sb = b % 1024, swz = sb ^ (((sb >> 9) & 1) << 5); R = (st >> 1) * 16 + swz / 64; C = (st & 1) * 32 + (swz % 64) / 2; }
__host__ __device__ __forceinline__ int perm32(int rho) { const int n = rho >> 4, i = rho & 15; return 8 * (i >> 2) + 4 * n + (i & 3); }

struct Unit { int pm, pn; };
struct Gemm { const bf16_t* A; const bf16_t* Bt; int M, N, K; };

struct StaticOrder {
    int nM, nN, nwg, G, c;
    __host__ __device__ void init(int M, int N, int G_, int c_) { nM = M / BM; nN = N / BM; nwg = nM * nN; G = G_; c = c_; }
    __host__ __device__ bool next(int i, Unit& u) const {
        const long L = (long)i * G + c; if (L >= nwg) return false;
        int wgid = (int)L; { const int q = nwg / NXCD, r = nwg % NXCD, xcd = wgid % NXCD, off = wgid / NXCD; wgid = (xcd < r ? xcd * (q + 1) : r * (q + 1) + (xcd - r) * q) + off; }
        const int nig = WGM * nN, gid = wgid / nig, fm = gid * WGM, gsz = (nM - fm) < WGM ? (nM - fm) : WGM;
        u.pm = fm + ((wgid % nig) % gsz); u.pn = (wgid % nig) / gsz; return true;
    }
    __device__ __forceinline__ void a_ready(const Unit&) const {}
    __device__ __forceinline__ void done(const Unit&) const {}
};

typedef __bf16 bf16x2_t __attribute__((ext_vector_type(2)));
typedef float f32x2 __attribute__((ext_vector_type(2)));
__device__ __forceinline__ unsigned cvt_pk_bf16(float lo, float hi) { const f32x2 v = {lo, hi}; const bf16x2_t b = __builtin_convertvector(v, bf16x2_t); return __builtin_bit_cast(unsigned, b); }
__device__ __forceinline__ int opaque_tid() { int t = threadIdx.x; asm volatile("" : "+v"(t)); return t; }
typedef unsigned u32x2 __attribute__((ext_vector_type(2)));
__device__ __forceinline__ float fast_rcp(float x) { return __builtin_amdgcn_rcpf(x); }
__device__ __forceinline__ float silu_f(float x) { return x * fast_rcp(1.0f + __expf(-x)); }
template <int ACT> struct EpiStore {
    static constexpr bool PERM = true, AFTER_DRAIN = false;
    bf16_t* O; int ldc;
    __device__ __forceinline__ void operator()(const f32x4 (&acc)[2][2][4][2], const Unit& u, int wr, int wc, int fr, int fq) const {
        const int row0 = u.pm * BM + wr * 64 + fr, col0 = u.pn * BM + wc * 32 + 8 * fq;
#pragma unroll
        for (int ai = 0; ai < 2; ++ai)
#pragma unroll
            for (int m = 0; m < 4; ++m) { bf16_t* rowp = O + (size_t)(row0 + ai * HALF + m * 16) * ldc + col0;
#pragma unroll
                for (int bj = 0; bj < 2; ++bj) { f32x4 v0 = acc[ai][bj][m][0], v1 = acc[ai][bj][m][1];
                    if (ACT == 2) {
#pragma unroll
                        for (int e = 0; e < 4; ++e) { const float a = fmaxf(v0[e], 0.f), b = fmaxf(v1[e], 0.f); v0[e] = a * a; v1[e] = b * b; } }
                    u32x4 w; w.x = cvt_pk_bf16(v0[0], v0[1]); w.y = cvt_pk_bf16(v0[2], v0[3]); w.z = cvt_pk_bf16(v1[0], v1[1]); w.w = cvt_pk_bf16(v1[2], v1[3]);
                    *(u32x4*)(rowp + bj * HALF) = w; } }
    }
};
struct EpiResid {
    static constexpr bool PERM = false, AFTER_DRAIN = false;
    const float* base; float* out; const float* gate; int ldc;
    __device__ __forceinline__ void operator()(const f32x4 (&acc)[2][2][4][2], const Unit& u, int wr, int wc, int fr, int fq) const {
        const int col0 = u.pn * BM + wc * 32 + 4 * fq;
        f32x4 gv[2][2];
#pragma unroll
        for (int bj = 0; bj < 2; ++bj)
#pragma unroll
            for (int n = 0; n < 2; ++n) gv[bj][n] = *(const f32x4*)(gate + col0 + bj * HALF + n * 16);
#pragma unroll
        for (int ai = 0; ai < 2; ++ai)
#pragma unroll
            for (int m = 0; m < 4; ++m) { const size_t off = (size_t)(u.pm * BM + ai * HALF + wr * 64 + m * 16 + fr) * ldc + col0;
#pragma unroll
                for (int bj = 0; bj < 2; ++bj)
#pragma unroll
                    for (int n = 0; n < 2; ++n) { const f32x4 b = *(const f32x4*)(base + off + bj * HALF + n * 16);
                        *(f32x4*)(out + off + bj * HALF + n * 16) = b + gv[bj][n] * acc[ai][bj][m][n]; } }
    }
};
struct EpiHgrn {
    static constexpr bool PERM = true, AFTER_DRAIN = false;
    bf16_t* Qh; bf16_t* LOGF; bf16_t* Vh; bf16_t* Gh; const float* lb; float qscale; const float* bias; const PG8_LAS float* rs; mutable int slot;
    __device__ __forceinline__ void operator()(const f32x4 (&acc)[2][2][4][2], const Unit& u, int wr, int wc, int fr, int fq) const {
        const int type = u.pn >> 3;
        const int row0 = u.pm * BM + wr * 64 + fr, col0 = (u.pn & 7) * BM + wc * 32 + 8 * fq, bcol0 = u.pn * BM + wc * 32 + 8 * fq;
        const PG8_LAS float* rsu = rs + slot * 256 + wr * 64 + fr; ++slot;
        f32x4 bv[2][2];
#pragma unroll
        for (int bj = 0; bj < 2; ++bj) { bv[bj][0] = *(const f32x4*)(bias + bcol0 + bj * HALF); bv[bj][1] = *(const f32x4*)(bias + bcol0 + bj * HALF + 4); }
#pragma unroll
        for (int ai = 0; ai < 2; ++ai)
#pragma unroll
            for (int m = 0; m < 4; ++m) { const size_t roff = (size_t)(row0 + ai * HALF + m * 16) * 2048 + col0; const float rstd = rsu[ai * HALF + m * 16];
#pragma unroll
                for (int bj = 0; bj < 2; ++bj) {
                    f32x4 v0 = acc[ai][bj][m][0] * rstd + bv[bj][0], v1 = acc[ai][bj][m][1] * rstd + bv[bj][1];
                    if (type == 1) {
                        const f32x4 l0 = *(const f32x4*)(lb + col0 + bj * HALF), l1 = *(const f32x4*)(lb + col0 + bj * HALF + 4);
#pragma unroll
                        for (int e = 0; e < 4; ++e) {
                            const float s0 = fast_rcp(1.0f + __expf(-v0[e])), s1 = fast_rcp(1.0f + __expf(-v1[e]));
                            v0[e] = __logf(l0[e] + (1.0f - l0[e]) * s0); v1[e] = __logf(l1[e] + (1.0f - l1[e]) * s1); }
                        u32x4 w; w.x = cvt_pk_bf16(v0[0], v0[1]); w.y = cvt_pk_bf16(v0[2], v0[3]); w.z = cvt_pk_bf16(v1[0], v1[1]); w.w = cvt_pk_bf16(v1[2], v1[3]);
                        *(u32x4*)(LOGF + roff + bj * HALF) = w;
                    } else {
                        if (type == 0) {
#pragma unroll
                            for (int e = 0; e < 4; ++e) { v0[e] = silu_f(v0[e]) * qscale; v1[e] = silu_f(v1[e]) * qscale; }
                        } else if (type == 3) {
#pragma unroll
                            for (int e = 0; e < 4; ++e) { v0[e] = silu_f(v0[e]); v1[e] = silu_f(v1[e]); }
                        }
                        u32x4 w; w.x = cvt_pk_bf16(v0[0], v0[1]); w.y = cvt_pk_bf16(v0[2], v0[3]); w.z = cvt_pk_bf16(v1[0], v1[1]); w.w = cvt_pk_bf16(v1[2], v1[3]);
                        if (type == 0) *(u32x4*)(Qh + roff + bj * HALF) = w;
                        else if (type == 2) *(u32x4*)(Vh + roff + bj * HALF) = w;
                        else *(u32x4*)(Gh + roff + bj * HALF) = w;
                    } } }
    }
};

template <bool BASE_BF16> struct EpiResidN {
    static constexpr bool PERM = true, AFTER_DRAIN = false;
    const void* base; bf16_t* out; const float* gate; int ldc; float* part;
    __device__ __forceinline__ void operator()(const f32x4 (&acc)[2][2][4][2], const Unit& u, int wr, int wc, int fr, int fq) const {
        const int col0 = u.pn * BM + wc * 32 + 8 * fq;
        f32x4 gv[2][2];
#pragma unroll
        for (int bj = 0; bj < 2; ++bj)
#pragma unroll
            for (int n = 0; n < 2; ++n) gv[bj][n] = *(const f32x4*)(gate + col0 + bj * HALF + n * 4);
#pragma unroll
        for (int ai = 0; ai < 2; ++ai)
#pragma unroll
            for (int m = 0; m < 4; ++m) { const int row = u.pm * BM + ai * HALF + wr * 64 + m * 16 + fr; const size_t off = (size_t)row * ldc + col0; float ss = 0.f;
#pragma unroll
                for (int bj = 0; bj < 2; ++bj) { f32x4 b0, b1;
                    if (BASE_BF16) { const u32x4 bb = *(const u32x4*)((const bf16_t*)base + off + bj * HALF);
                        b0 = (f32x4){__uint_as_float(bb.x << 16), __uint_as_float(bb.x & 0xffff0000u), __uint_as_float(bb.y << 16), __uint_as_float(bb.y & 0xffff0000u)};
                        b1 = (f32x4){__uint_as_float(bb.z << 16), __uint_as_float(bb.z & 0xffff0000u), __uint_as_float(bb.w << 16), __uint_as_float(bb.w & 0xffff0000u)}; }
                    else { b0 = *(const f32x4*)((const float*)base + off + bj * HALF); b1 = *(const f32x4*)((const float*)base + off + bj * HALF + 4); }
                    const f32x4 o0 = b0 + gv[bj][0] * acc[ai][bj][m][0], o1 = b1 + gv[bj][1] * acc[ai][bj][m][1];
                    u32x4 ob; ob.x = cvt_pk_bf16(o0[0], o0[1]); ob.y = cvt_pk_bf16(o0[2], o0[3]); ob.z = cvt_pk_bf16(o1[0], o1[1]); ob.w = cvt_pk_bf16(o1[2], o1[3]);
                    *(u32x4*)(out + off + bj * HALF) = ob;
                    ss += ((o0[0] * o0[0] + o0[1] * o0[1]) + (o0[2] * o0[2] + o0[3] * o0[3])) + ((o1[0] * o1[0] + o1[1] * o1[1]) + (o1[2] * o1[2] + o1[3] * o1[3]));
                    }
                ss += __shfl_xor(ss, 16); ss += __shfl_xor(ss, 32);
                if (fq == 0) part[(size_t)row * 32 + u.pn * 4 + wc] = ss; }
    }
};
struct EpiResidF {
    static constexpr bool PERM = true, AFTER_DRAIN = false;
    const bf16_t* base; float* out; const float* gate; int ldc;
    __device__ __forceinline__ void operator()(const f32x4 (&acc)[2][2][4][2], const Unit& u, int wr, int wc, int fr, int fq) const {
        const int col0 = u.pn * BM + wc * 32 + 8 * fq;
        f32x4 gv[2][2];
#pragma unroll
        for (int bj = 0; bj < 2; ++bj)
#pragma unroll
            for (int n = 0; n < 2; ++n) gv[bj][n] = *(const f32x4*)(gate + col0 + bj * HALF + n * 4);
#pragma unroll
        for (int ai = 0; ai < 2; ++ai)
#pragma unroll
            for (int m = 0; m < 4; ++m) { const size_t off = (size_t)(u.pm * BM + ai * HALF + wr * 64 + m * 16 + fr) * ldc + col0;
#pragma unroll
                for (int bj = 0; bj < 2; ++bj) { const u32x4 bb = *(const u32x4*)(base + off + bj * HALF);
                    const f32x4 b0 = {__uint_as_float(bb.x << 16), __uint_as_float(bb.x & 0xffff0000u), __uint_as_float(bb.y << 16), __uint_as_float(bb.y & 0xffff0000u)};
                    const f32x4 b1 = {__uint_as_float(bb.z << 16), __uint_as_float(bb.z & 0xffff0000u), __uint_as_float(bb.w << 16), __uint_as_float(bb.w & 0xffff0000u)};
                    *(f32x4*)(out + off + bj * HALF) = b0 + gv[bj][0] * acc[ai][bj][m][0]; *(f32x4*)(out + off + bj * HALF + 4) = b1 + gv[bj][1] * acc[ai][bj][m][1]; } }
    }
};
template <int ACT> struct EpiStoreN {
    static constexpr bool PERM = true, AFTER_DRAIN = false;
    bf16_t* O; int ldc; const float* bias; const PG8_LAS float* rs; mutable int slot;
    __device__ __forceinline__ void operator()(const f32x4 (&acc)[2][2][4][2], const Unit& u, int wr, int wc, int fr, int fq) const {
        const int row0 = u.pm * BM + wr * 64 + fr, col0 = u.pn * BM + wc * 32 + 8 * fq;
        const PG8_LAS float* rsu = rs + slot * 256 + wr * 64 + fr; ++slot;
        f32x4 bv[2][2];
#pragma unroll
        for (int bj = 0; bj < 2; ++bj) { bv[bj][0] = *(const f32x4*)(bias + col0 + bj * HALF); bv[bj][1] = *(const f32x4*)(bias + col0 + bj * HALF + 4); }
#pragma unroll
        for (int ai = 0; ai < 2; ++ai)
#pragma unroll
            for (int m = 0; m < 4; ++m) { bf16_t* rowp = O + (size_t)(row0 + ai * HALF + m * 16) * ldc + col0; const float rstd = rsu[ai * HALF + m * 16];
#pragma unroll
                for (int bj = 0; bj < 2; ++bj) {
                    f32x4 v0 = acc[ai][bj][m][0] * rstd + bv[bj][0], v1 = acc[ai][bj][m][1] * rstd + bv[bj][1];
                    if (ACT == 2) {
#pragma unroll
                        for (int e = 0; e < 4; ++e) { const float a = fmaxf(v0[e], 0.f), b = fmaxf(v1[e], 0.f); v0[e] = a * a; v1[e] = b * b; } }
                    u32x4 w; w.x = cvt_pk_bf16(v0[0], v0[1]); w.y = cvt_pk_bf16(v0[2], v0[3]); w.z = cvt_pk_bf16(v1[0], v1[1]); w.w = cvt_pk_bf16(v1[2], v1[3]);
                    *(u32x4*)(rowp + bj * HALF) = w; } }
    }
};
template <class Epi, class Sched, bool ALIGN_EPI = false, bool SP2 = false>
__device__ __forceinline__ void gemm_phase(PG8_LAS unsigned char* lds, const Gemm g, const Sched& S, const Epi& E) {
    const int tid = opaque_tid(), wid = __builtin_amdgcn_readfirstlane(tid >> 6), lane = tid & 63, wr = wid >> 2, wc = wid & 3, fr = lane & 15, fq = lane >> 4;
    const int K = g.K, nt = K / BK;
    unsigned voffA[2], voffB[2];
#pragma unroll
    for (int i = 0; i < 2; ++i) { int R, C; stage_rc(tid * 16 + i * 8192, R, C); const int Rb = Epi::PERM ? ((R & ~31) + perm32(R & 31)) : R;
        voffA[i] = (unsigned)(R * K + C) * 2u; voffB[i] = (unsigned)(Rb * K + C) * 2u; }
    const size_t kstep = (size_t)(BK * 2);
    const size_t hstep = (size_t)HALF * K * 2;
    const size_t tstep = 2 * hstep;
    const unsigned ldsw = (unsigned)wid * 1024u;
    const int aoff = lds_byte(wr * 64 + fr, fq * 8), boff = lds_byte(wc * 32 + fr, fq * 8);
#define PG8_SA(b, h) (((b) * 2 + (h)) * HTB)
#define PG8_SB(b, h) ((4 + (b) * 2 + (h)) * HTB)
#define PG8_STAGE(bufoff, gbase, voff) do { _Pragma("unroll") for (int _i = 0; _i < 2; ++_i) \
        __builtin_amdgcn_global_load_lds((const unsigned*)((const char*)(gbase) + (voff)[_i]), (PG8_LAS unsigned*)(lds + (bufoff) + ldsw + _i * 8192), 16, 0, 0); } while (0)
#define PG8_LDA(dst, b, h) do { _Pragma("unroll") for (int m = 0; m < 4; ++m) _Pragma("unroll") for (int k = 0; k < 2; ++k) dst[m][k] = *(const PG8_LAS bf16x8*)(lds + PG8_SA(b, h) + aoff + m * 2048 + k * 1024); } while (0)
#define PG8_LDB(dst, b, h) do { _Pragma("unroll") for (int n = 0; n < 2; ++n) _Pragma("unroll") for (int k = 0; k < 2; ++k) dst[n][k] = *(const PG8_LAS bf16x8*)(lds + PG8_SB(b, h) + boff + n * 2048 + k * 1024); } while (0)
#define PG8_MMA(ai, bj, At, Bt) do { __builtin_amdgcn_s_setprio(1); _Pragma("unroll") for (int m = 0; m < 4; ++m) _Pragma("unroll") for (int n = 0; n < 2; ++n) _Pragma("unroll") for (int k = 0; k < 2; ++k) \
        acc[ai][bj][m][n] = __builtin_amdgcn_mfma_f32_16x16x32_bf16(Bt[n][k], At[m][k], acc[ai][bj][m][n], 0, 0, 0); __builtin_amdgcn_s_setprio(0); } while (0)
#define PG8_WAIT_V(n) asm volatile("s_waitcnt vmcnt(" #n ")" ::: "memory")
#define PG8_WAIT_L(n) asm volatile("s_waitcnt lgkmcnt(" #n ")" ::: "memory")
#define PG8_BAR __builtin_amdgcn_s_barrier()
#define PG8_SCHED __builtin_amdgcn_sched_barrier(0)
    Unit cur, nxt; int ui = 0;
    if (!S.next(0, cur)) return;
    f32x4 acc[2][2][4][2];
#pragma unroll
    for (int a = 0; a < 2; ++a)
#pragma unroll
        for (int b = 0; b < 2; ++b)
#pragma unroll
            for (int m = 0; m < 4; ++m)
#pragma unroll
                for (int n = 0; n < 2; ++n) acc[a][b][m][n] = (f32x4){0.f, 0.f, 0.f, 0.f};
    bf16x8 At[4][2], B0[2][2], B1[2][2];
    const char* cA = (const char*)g.A + (size_t)cur.pm * tstep; const char* cB = (const char*)g.Bt + (size_t)cur.pn * tstep;
    S.a_ready(cur);
    if constexpr (SP2) {
        PG8_STAGE(PG8_SB(0, 0), cB, voffB); PG8_STAGE(PG8_SB(0, 1), cB + hstep, voffB); PG8_STAGE(PG8_SA(0, 0), cA, voffA); PG8_STAGE(PG8_SA(0, 1), cA + hstep, voffA);
        if (wr == 1) PG8_BAR;
        PG8_WAIT_V(2); PG8_BAR;
        PG8_STAGE(PG8_SB(1, 0), cB + kstep, voffB); PG8_STAGE(PG8_SA(1, 0), cA + kstep, voffA); PG8_STAGE(PG8_SB(1, 1), cB + hstep + kstep, voffB);
        PG8_WAIT_V(6); PG8_BAR;
    } else {
        PG8_STAGE(PG8_SB(0, 0), cB, voffB); PG8_STAGE(PG8_SA(0, 0), cA, voffA); PG8_STAGE(PG8_SB(0, 1), cB + hstep, voffB); PG8_STAGE(PG8_SA(0, 1), cA + hstep, voffA);
        if (wr == 1) PG8_BAR;
        PG8_WAIT_V(4); PG8_BAR;
        PG8_STAGE(PG8_SB(1, 0), cB + kstep, voffB); PG8_STAGE(PG8_SA(1, 0), cA + kstep, voffA); PG8_STAGE(PG8_SB(1, 1), cB + hstep + kstep, voffB);
        PG8_WAIT_V(6); PG8_BAR;
    }
    for (;;) {
        const bool has_next = S.next(ui + 1, nxt);
        const char* nA = has_next ? (const char*)g.A + (size_t)nxt.pm * tstep : cA; const char* nB = has_next ? (const char*)g.Bt + (size_t)nxt.pn * tstep : cB;
        for (int t = 0; t < nt; t += 2) {
            const bool last = (t == nt - 2);
            const char* a1 = cA + (size_t)(t + 1) * kstep;
            const char* a2 = last ? nA : cA + (size_t)(t + 2) * kstep; const char* b2 = last ? nB : cB + (size_t)(t + 2) * kstep;
            const char* a3 = a2 + kstep; const char* b3 = b2 + kstep;
            if (last && has_next) S.a_ready(nxt);
            if constexpr (SP2) {
            PG8_LDB(B0, 0, 0); PG8_LDB(B1, 0, 1); PG8_SCHED; PG8_LDA(At, 0, 0); PG8_STAGE(PG8_SA(1, 1), a1 + hstep, voffA);
            PG8_WAIT_V(8); PG8_WAIT_L(0); PG8_BAR; PG8_MMA(0, 0, At, B0); PG8_MMA(0, 1, At, B1); PG8_BAR; PG8_SCHED;
            PG8_LDA(At, 0, 1); PG8_STAGE(PG8_SB(0, 0), b2, voffB); PG8_STAGE(PG8_SB(0, 1), b2 + hstep, voffB); PG8_STAGE(PG8_SA(0, 0), a2, voffA);
            PG8_WAIT_V(8); PG8_WAIT_L(0); PG8_BAR; PG8_MMA(1, 0, At, B0); PG8_MMA(1, 1, At, B1); PG8_BAR; PG8_SCHED;
            PG8_LDB(B0, 1, 0); PG8_LDB(B1, 1, 1); PG8_SCHED; PG8_LDA(At, 1, 0); PG8_STAGE(PG8_SA(0, 1), a2 + hstep, voffA);
            PG8_WAIT_V(8); PG8_WAIT_L(0); PG8_BAR; PG8_MMA(0, 0, At, B0); PG8_MMA(0, 1, At, B1); PG8_BAR; PG8_SCHED;
            PG8_LDA(At, 1, 1); PG8_STAGE(PG8_SB(1, 0), b3, voffB); PG8_STAGE(PG8_SB(1, 1), b3 + hstep, voffB); PG8_STAGE(PG8_SA(1, 0), a3, voffA);
            PG8_WAIT_V(8); PG8_WAIT_L(0); PG8_BAR; PG8_MMA(1, 0, At, B0); PG8_MMA(1, 1, At, B1); PG8_BAR; PG8_SCHED;
            } else {
            PG8_LDB(B0, 0, 0); PG8_SCHED; PG8_LDA(At, 0, 0); PG8_STAGE(PG8_SA(1, 1), a1 + hstep, voffA);
            PG8_WAIT_L(8); PG8_BAR; PG8_WAIT_L(0); PG8_MMA(0, 0, At, B0); PG8_BAR; PG8_SCHED;
            PG8_LDB(B1, 0, 1); PG8_STAGE(PG8_SB(0, 0), b2, voffB);
            PG8_BAR; PG8_WAIT_L(0); PG8_MMA(0, 1, At, B1); PG8_BAR;
            PG8_LDA(At, 0, 1); PG8_STAGE(PG8_SA(0, 0), a2, voffA);
            PG8_BAR; PG8_WAIT_L(0); PG8_MMA(1, 0, At, B0); PG8_BAR; PG8_SCHED;
            PG8_STAGE(PG8_SB(0, 1), b2 + hstep, voffB);
            PG8_WAIT_V(6); PG8_BAR; PG8_MMA(1, 1, At, B1); PG8_BAR;
            PG8_LDB(B0, 1, 0); PG8_SCHED; PG8_LDA(At, 1, 0); PG8_STAGE(PG8_SA(0, 1), a2 + hstep, voffA);
            PG8_WAIT_L(8); PG8_BAR; PG8_WAIT_L(0); PG8_MMA(0, 0, At, B0); PG8_BAR; PG8_SCHED;
            PG8_LDB(B1, 1, 1); PG8_STAGE(PG8_SB(1, 0), b3, voffB);
            PG8_BAR; PG8_WAIT_L(0); PG8_MMA(0, 1, At, B1); PG8_BAR;
            PG8_LDA(At, 1, 1); PG8_STAGE(PG8_SA(1, 0), a3, voffA);
            PG8_BAR; PG8_WAIT_L(0); PG8_MMA(1, 0, At, B0); PG8_BAR; PG8_SCHED;
            PG8_STAGE(PG8_SB(1, 1), b3 + hstep, voffB);
            PG8_WAIT_V(6); PG8_BAR; PG8_MMA(1, 1, At, B1); PG8_BAR;
            }
        }
        if constexpr (ALIGN_EPI) { if (wr == 0) PG8_BAR; }
        if constexpr (!Epi::AFTER_DRAIN) { E(acc, cur, wr, wc, fr, fq); S.done(cur); }
        if (!has_next) break;
#pragma unroll
        for (int a = 0; a < 2; ++a)
#pragma unroll
            for (int b = 0; b < 2; ++b)
#pragma unroll
                for (int m = 0; m < 4; ++m)
#pragma unroll
                    for (int n = 0; n < 2; ++n) acc[a][b][m][n] = (f32x4){0.f, 0.f, 0.f, 0.f};
        cur = nxt; cA = nA; cB = nB; ++ui;
        if constexpr (ALIGN_EPI) { if (wr == 1) PG8_BAR; }
    }
    PG8_WAIT_V(0);
    if constexpr (!ALIGN_EPI) { if (wr == 0) PG8_BAR; }
    PG8_BAR;
    if constexpr (Epi::AFTER_DRAIN) { E.fused(acc, cur, wr, wc, fr, fq, lds, wid, lane); S.done(cur); }
#undef PG8_SA
#undef PG8_SB
#undef PG8_STAGE
#undef PG8_LDA
#undef PG8_LDB
#undef PG8_MMA
#undef PG8_WAIT_V
#undef PG8_WAIT_L
#undef PG8_BAR
#undef PG8_SCHED
}
}

namespace cg = cooperative_groups;
#define LAS __attribute__((address_space(3)))
typedef unsigned short bf16_t;
typedef short bf16x8 __attribute__((ext_vector_type(8)));
typedef float f32x4 __attribute__((ext_vector_type(4)));
typedef float f32x2 __attribute__((ext_vector_type(2)));
typedef unsigned u32x4 __attribute__((ext_vector_type(4)));
typedef unsigned u32x2 __attribute__((ext_vector_type(2)));
using pg8::cvt_pk_bf16;

constexpr int T = 8192, D = 2048, DFF = 8192, NQKV = 2560;
constexpr int LDS_BYTES = 147456;
constexpr float EPS = 1e-6f;
constexpr size_t MiB = 1u << 20;
constexpr size_t WS_MOD = 0;
constexpr size_t WS_LB = 128 * 1024;
constexpr size_t WS_BIAS = 512 * 1024;
constexpr size_t WS_PART = 1 * MiB;
constexpr int RS_OFF = 131072;
constexpr size_t WS_BAR = 256 * 1024, BAR_BYTES = 16384;
constexpr int MODCNT_WORD = 3600;
constexpr int MISC_OFF = LDS_BYTES - 64;
constexpr size_t WS_WT_AIN = 2 * MiB, WS_WT_AOUT = 12 * MiB, WS_WT_HIN = 20 * MiB, WS_WT_HOUT = 52 * MiB;
constexpr size_t WS_WT_W1 = 60 * MiB  , WS_WT_W2 = 124 * MiB  ;
constexpr size_t WS_H = 188 * MiB, WS_QKV = 220 * MiB, WS_ATT = 260 * MiB, WS_XA = 292 * MiB, WS_ACT = 356 * MiB;
constexpr size_t WS_QH = 484 * MiB, WS_LOGF = 516 * MiB, WS_VH = 580 * MiB, WS_GH = 220 * MiB, WS_US = 612 * MiB, WS_SS = 676 * MiB, WS_DEC = 740 * MiB, WS_END = 741 * MiB;

__device__ __forceinline__ float bflo(unsigned u) { return __uint_as_float(u << 16); }
__device__ __forceinline__ float bfhi(unsigned u) { return __uint_as_float(u & 0xffff0000u); }
__device__ __forceinline__ float bf2f(bf16_t u) { return __uint_as_float((unsigned)u << 16); }
__device__ __forceinline__ float wave_sum(float v) {
#pragma unroll
    for (int o = 1; o < 64; o <<= 1) v += __shfl_xor(v, o);
    return v;
}
__device__ __forceinline__ f32x4 mfma16(bf16x8 a, bf16x8 b, f32x4 c) { return __builtin_amdgcn_mfma_f32_16x16x32_bf16(a, b, c, 0, 0, 0); }
__device__ __forceinline__ bf16x8 as_bf16x8(u32x4 v) { return __builtin_bit_cast(bf16x8, v); }

struct Params {
    const float* x; const float* c; const float* mod_w; const float* mod_b; const float* norm_mix; const float* norm_mlp;
    const float* attn_w_in; const float* attn_w_out; const float* attn_q_gain; const float* attn_k_gain; const float* attn_sinks;
    const float* hgrn_w_in; const float* hgrn_w_out; const float* hgrn_o_gain; const float* hgrn_lb_logits; const float* mlp_w1; const float* mlp_w2;
    float* out; unsigned char* ws;
};

__device__ __forceinline__ void p0_transpose_item(const float* W, int K, int N, bf16_t* WT, LAS float* scr, int item, int lane) {
    const int nblk = N / 32, kb = item / nblk, nb = item % nblk, k0 = 64 * kb, n0 = 32 * nb;
#pragma unroll 8
    for (int i = 0; i < 32; ++i) { const int kk = 2 * i + (lane >> 5); scr[kk * 33 + (lane & 31)] = W[(size_t)(k0 + kk) * N + n0 + (lane & 31)]; }
    asm volatile("s_waitcnt lgkmcnt(0)" ::: "memory");
    const int c = lane & 7;
#pragma unroll
    for (int j = 0; j < 4; ++j) { const int n = (lane >> 3) + 8 * j; const LAS float* s = scr + (8 * c) * 33 + n;
        u32x4 o; o.x = cvt_pk_bf16(s[0 * 33], s[1 * 33]); o.y = cvt_pk_bf16(s[2 * 33], s[3 * 33]); o.z = cvt_pk_bf16(s[4 * 33], s[5 * 33]); o.w = cvt_pk_bf16(s[6 * 33], s[7 * 33]);
        *(u32x4*)(WT + (size_t)(n0 + n) * K + k0 + 8 * c) = o; }
    asm volatile("s_waitcnt lgkmcnt(0)" ::: "memory");
}

__device__ __forceinline__ void p0_transpose_item_scaled(const float* W, int K, int N, bf16_t* WT, LAS float* scr, int item, int lane, const float* gain, const float* sc) {
    const int nblk = N / 32, kb = item / nblk, nb = item % nblk, k0 = 64 * kb, n0 = 32 * nb;
#pragma unroll 8
    for (int i = 0; i < 32; ++i) { const int kk = 2 * i + (lane >> 5); scr[kk * 33 + (lane & 31)] = W[(size_t)(k0 + kk) * N + n0 + (lane & 31)] * (gain[k0 + kk] * (1.0f + sc[k0 + kk])); }
    asm volatile("s_waitcnt lgkmcnt(0)" ::: "memory");
    const int c = lane & 7;
#pragma unroll
    for (int j = 0; j < 4; ++j) { const int n = (lane >> 3) + 8 * j; const LAS float* s = scr + (8 * c) * 33 + n;
        u32x4 o; o.x = cvt_pk_bf16(s[0 * 33], s[1 * 33]); o.y = cvt_pk_bf16(s[2 * 33], s[3 * 33]); o.z = cvt_pk_bf16(s[4 * 33], s[5 * 33]); o.w = cvt_pk_bf16(s[6 * 33], s[7 * 33]);
        *(u32x4*)(WT + (size_t)(n0 + n) * K + k0 + 8 * c) = o; }
    asm volatile("s_waitcnt lgkmcnt(0)" ::: "memory");
}

__device__ __forceinline__ void prologue_phase(LAS unsigned char* lds, const Params& p) {
    const int tid = pg8::opaque_tid(), lane = tid & 63, wave = tid >> 6;
    float* MOD = (float*)(p.ws + WS_MOD); float* LB = (float*)(p.ws + WS_LB);
    for (int i = blockIdx.x * 512 + tid; i < 2048; i += gridDim.x * 512) { const float l0 = p.hgrn_lb_logits[i], l1 = p.hgrn_lb_logits[2048 + i]; LB[i] = 1.0f / (1.0f + expf(l0 - l1)); }
    {
        LAS float* cond = (LAS float*)lds; LAS f32x4* red = (LAS f32x4*)(lds + 8192);
        for (int i = tid; i < 2048; i += 512) { const float c = p.c[i]; cond[i] = c / (1.0f + expf(-c)); }
        __syncthreads();
        for (int slice = blockIdx.x; slice < 256; slice += gridDim.x) {
            const int layer = slice >> 7, col0 = (slice & 127) * 96, cgp = tid % 24, kr = tid / 24;
            f32x4 acc = {0.f, 0.f, 0.f, 0.f};
            if (kr < 21) {
                const float* W = p.mod_w + (size_t)layer * 2048 * 12288 + col0 + 4 * cgp;
#pragma unroll 4
                for (int k = kr; k < 2048; k += 21) { const f32x4 w = __builtin_nontemporal_load((const f32x4*)(W + (size_t)k * 12288)); acc += w * cond[k]; }
                red[kr * 24 + cgp] = acc;
            }
            __syncthreads();
            if (tid < 96) { float s = p.mod_b[layer * 12288 + col0 + tid];
                for (int r = 0; r < 21; ++r) s += ((LAS float*)red)[r * 96 + tid];
                __hip_atomic_store(MOD + layer * 12288 + col0 + tid, s, __ATOMIC_RELAXED, __HIP_MEMORY_SCOPE_AGENT); }
            __syncthreads();
        }
    }
    asm volatile("s_waitcnt vmcnt(0)" ::: "memory");
    __syncthreads();
    if (tid == 0) (void)__hip_atomic_fetch_add((unsigned*)(p.ws + WS_BAR) + MODCNT_WORD, 1u, __ATOMIC_RELAXED, __HIP_MEMORY_SCOPE_AGENT);
    LAS float* scr = (LAS float*)(lds + wave * 16384);
    const int gw = blockIdx.x * 8 + wave, NGW = gridDim.x * 8;
    constexpr int I_AIN = (D / 64) * (NQKV / 32), I_SQ = (D / 64) * (D / 32), I_BIG = (D / 64) * (DFF / 32);
    {
        constexpr int NITEMS = I_AIN + 2 * I_SQ + 2 * I_BIG;
        for (int it = gw; it < NITEMS; it += NGW) {
            int r = it;
            if (r < I_AIN) { p0_transpose_item(p.attn_w_in, D, NQKV, (bf16_t*)(p.ws + WS_WT_AIN), scr, r, lane); continue; } r -= I_AIN;
            if (r < I_SQ) { p0_transpose_item(p.attn_w_out, D, D, (bf16_t*)(p.ws + WS_WT_AOUT), scr, r, lane); continue; } r -= I_SQ;
            if (r < I_SQ) { p0_transpose_item(p.hgrn_w_out, D, D, (bf16_t*)(p.ws + WS_WT_HOUT), scr, r, lane); continue; } r -= I_SQ;
            if (r < I_BIG) { p0_transpose_item(p.mlp_w2, DFF, D, (bf16_t*)(p.ws + WS_WT_W2), scr, r, lane); continue; } r -= I_BIG;
            p0_transpose_item(p.mlp_w2 + (size_t)D * DFF, DFF, D, (bf16_t*)(p.ws + WS_WT_W2 + 32 * MiB), scr, r, lane);
        }
    }
    {
        __syncthreads();
        if (tid == 0) { unsigned* cnt = (unsigned*)(p.ws + WS_BAR) + MODCNT_WORD; unsigned sp = 0;
            while (__hip_atomic_load(cnt, __ATOMIC_RELAXED, __HIP_MEMORY_SCOPE_AGENT) < gridDim.x) { __builtin_amdgcn_s_sleep(2); if (++sp > (1u << 22)) break; }
            __builtin_amdgcn_fence(__ATOMIC_ACQUIRE, "agent"); asm volatile("s_waitcnt vmcnt(0)" ::: "memory"); }
        __syncthreads();
    }
    {
        const float* MODc = (const float*)(p.ws + WS_MOD);
        for (int it = gw; it < 3 * I_BIG; it += NGW) {
            int r = it;
            if (r < I_BIG) { p0_transpose_item_scaled(p.mlp_w1, D, DFF, (bf16_t*)(p.ws + WS_WT_W1), scr, r, lane, p.norm_mlp, MODc + 4 * D); continue; } r -= I_BIG;
            if (r < I_BIG) { p0_transpose_item_scaled(p.hgrn_w_in, D, DFF, (bf16_t*)(p.ws + WS_WT_HIN), scr, r, lane, p.norm_mix + D, MODc + 12288 + D); continue; } r -= I_BIG;
            p0_transpose_item_scaled(p.mlp_w1 + (size_t)D * DFF, D, DFF, (bf16_t*)(p.ws + WS_WT_W1 + 32 * MiB), scr, r, lane, p.norm_mlp + D, MODc + 12288 + 4 * D);
        }
    }
    __syncthreads();
}

__device__ __forceinline__ void norm_phase(LAS unsigned char* lds, const float* xin, const float* gain, const float* sh, const float* sc, bf16_t* out) {
    const int tid = pg8::opaque_tid(), lane = tid & 63, wave = tid >> 6;
    LAS float* Av = (LAS float*)lds; LAS float* Bv = (LAS float*)(lds + 8192);
    for (int i = tid; i < 2048; i += 512) { Av[i] = gain[i] * (1.0f + sc[i]); Bv[i] = sh[i]; }
    __syncthreads();
    const int gw = blockIdx.x * 8 + wave, NGW = gridDim.x * 8;
    for (int m = gw; m < T; m += 2 * NGW) {
        const int m2 = m + NGW < T ? m + NGW : m;
        const f32x4* xr = (const f32x4*)(xin + (size_t)m * D) + lane; const f32x4* xr2 = (const f32x4*)(xin + (size_t)m2 * D) + lane;
        f32x4 v[8], v2[8]; float s = 0.f, s2 = 0.f;
#pragma unroll
        for (int j = 0; j < 8; ++j) { v[j] = xr[64 * j]; v2[j] = xr2[64 * j]; }
#pragma unroll
        for (int j = 0; j < 8; ++j) { s += (v[j].x * v[j].x + v[j].y * v[j].y) + (v[j].z * v[j].z + v[j].w * v[j].w); s2 += (v2[j].x * v2[j].x + v2[j].y * v2[j].y) + (v2[j].z * v2[j].z + v2[j].w * v2[j].w); }
        const float rstd = rsqrtf(wave_sum(s) * (1.0f / D) + EPS), rstd2 = rsqrtf(wave_sum(s2) * (1.0f / D) + EPS);
        u32x2* o8 = (u32x2*)(out + (size_t)m * D) + lane; u32x2* o82 = (u32x2*)(out + (size_t)m2 * D) + lane;
#pragma unroll
        for (int j = 0; j < 8; ++j) { const f32x4 a = ((LAS f32x4*)Av)[lane + 64 * j], b = ((LAS f32x4*)Bv)[lane + 64 * j];
            const f32x4 y = v[j] * rstd * a + b, y2 = v2[j] * rstd2 * a + b; u32x2 w, w2; w.x = cvt_pk_bf16(y.x, y.y); w.y = cvt_pk_bf16(y.z, y.w); w2.x = cvt_pk_bf16(y2.x, y2.y); w2.y = cvt_pk_bf16(y2.z, y2.w);
            o8[64 * j] = w; if (m2 != m) o82[64 * j] = w2; }
    }
    __syncthreads();
}


__device__ __forceinline__ void rstd_prepare(LAS float* rs, const float* part, const pg8::StaticOrder& S) {
    const int tid = pg8::opaque_tid(), j = tid >> 7, r0 = (tid & 127) * 2; pg8::Unit u;
    if (S.next(j, u)) {
#pragma unroll
        for (int rr = 0; rr < 2; ++rr) { const f32x4* pp = (const f32x4*)(part + (size_t)(u.pm * 256 + r0 + rr) * 32); float s = 0.f;
#pragma unroll
            for (int i = 0; i < 8; ++i) { const f32x4 v = pp[i]; s += (v.x + v.y) + (v.z + v.w); }
            rs[j * 256 + r0 + rr] = rsqrtf(s * (1.0f / D) + EPS); }
    }
    __syncthreads();
}
__device__ __forceinline__ void bias_gemv(const float* sh, const float* gain, const float* sc, const bf16_t* WT, float* bias, int nrows, int wave_id, int nwaves) {
    const int lane = pg8::opaque_tid() & 63;
    float shv[32];
#pragma unroll
    for (int i = 0; i < 4; ++i)
#pragma unroll
        for (int e = 0; e < 8; ++e) { const int k = (lane + 64 * i) * 8 + e; shv[8 * i + e] = sh[k] / (gain[k] * (1.0f + sc[k])); }
    for (int row = wave_id; row < nrows; row += 4 * nwaves) {
        u32x4 v[4][4];
#pragma unroll
        for (int q = 0; q < 4; ++q) { const int rq = row + q * nwaves < nrows ? row + q * nwaves : row; const u32x4* pr = (const u32x4*)(WT + (size_t)rq * D) + lane;
#pragma unroll
            for (int i = 0; i < 4; ++i) v[q][i] = pr[64 * i]; }
#pragma unroll
        for (int q = 0; q < 4; ++q) { float a = 0.f;
#pragma unroll
            for (int i = 0; i < 4; ++i)
#pragma unroll
                for (int e = 0; e < 4; ++e) a += bflo(v[q][i][e]) * shv[8 * i + 2 * e] + bfhi(v[q][i][e]) * shv[8 * i + 2 * e + 1];
            a = wave_sum(a);
            if (lane == 0 && row + q * nwaves < nrows) bias[row + q * nwaves] = a; }
    }
}

__device__ __forceinline__ void attn_phase(LAS unsigned char* lds, const bf16_t* QKV, const float* qg, const float* kg, const float* sinks, bf16_t* ATT) {
    constexpr int LDQ = NQKV, KST = 72, VST = 280;
    LAS bf16_t* Ks = (LAS bf16_t*)lds;
    LAS bf16_t* Vt = (LAS bf16_t*)(lds + 272 * KST * 2);
    const int tid = pg8::opaque_tid(), lane = tid & 63, wid = tid >> 6, fr = lane & 15, fq = lane >> 4;
    for (int unit = blockIdx.x; unit < 256; unit += gridDim.x) {
        const int kvh = unit & 3, nb = unit >> 2;
        u32x4 q0n, q1n;
        { const u32x4* qp = (const u32x4*)(QKV + (size_t)(nb * 128 + fr) * LDQ + (kvh * 8 + wid) * 64 + 8 * fq); q0n = qp[0]; q1n = qp[4]; }
        {
            const int kp = tid >> 1, half = tid & 1, s_abs = (nb - 1) * 128 + kp;
            u32x4 kr[4], vr[4];
#pragma unroll
            for (int i = 0; i < 4; ++i) { kr[i] = (u32x4){0u, 0u, 0u, 0u}; vr[i] = (u32x4){0u, 0u, 0u, 0u}; }
            if (s_abs >= 0) {
                const u32x4* kptr = (const u32x4*)(QKV + (size_t)s_abs * LDQ + 2048 + kvh * 64 + half * 32);
                const u32x4* vptr = (const u32x4*)(QKV + (size_t)s_abs * LDQ + 2304 + kvh * 64 + half * 32);
#pragma unroll
                for (int i = 0; i < 4; ++i) { kr[i] = kptr[i]; vr[i] = vptr[i]; }
            }
            float ss = 0.f;
#pragma unroll
            for (int i = 0; i < 4; ++i)
#pragma unroll
                for (int e = 0; e < 4; ++e) { const float a = bflo(kr[i][e]), b = bfhi(kr[i][e]); ss += a * a + b * b; }
            ss += __shfl_xor(ss, 1);
            const float rstd = rsqrtf(ss * (1.0f / 64.0f) + EPS);
#pragma unroll
            for (int i = 0; i < 4; ++i) { u32x4 w;
#pragma unroll
                for (int e = 0; e < 4; ++e) { const int d = half * 32 + i * 8 + e * 2; w[e] = cvt_pk_bf16(bflo(kr[i][e]) * rstd * kg[d], bfhi(kr[i][e]) * rstd * kg[d + 1]); }
                *(LAS u32x4*)(Ks + kp * KST + half * 32 + i * 8) = w; }
#pragma unroll
            for (int i = 0; i < 4; ++i)
#pragma unroll
                for (int e = 0; e < 4; ++e) { const int d = half * 32 + i * 8 + e * 2;
                    Vt[d * VST + kp] = (bf16_t)(vr[i][e] & 0xffffu); Vt[(d + 1) * VST + kp] = (bf16_t)(vr[i][e] >> 16); }
            for (int e = tid; e < 16 * KST / 2; e += 512) ((LAS unsigned*)(Ks + 256 * KST))[e] = 0u;
            for (int e = tid; e < 64 * 16; e += 512) Vt[(e >> 4) * VST + 256 + (e & 15)] = (bf16_t)0;
        }
        __syncthreads();
        const int h = kvh * 8 + wid;
        const float LOG2E = 1.4426950408889634f;
        const float slope = exp2f(-0.25f * (float)(h + 1)) * LOG2E, sink = sinks[h] * LOG2E;
        float qgv[16];
#pragma unroll
        for (int e = 0; e < 8; ++e) { qgv[e] = qg[8 * fq + e] * (0.125f * LOG2E); qgv[8 + e] = qg[32 + 8 * fq + e] * (0.125f * LOG2E); }
        float ar[4]; bool m0[4];
#pragma unroll
        for (int r = 0; r < 4; ++r) { ar[r] = slope * (float)(128 + fr - 4 * fq - r); m0[r] = fr < 4 * fq + r; }
        const float s16 = slope * 16.0f;
        for (int mt = 0; mt < 8; ++mt) {
            const int qi = 16 * mt + fr, t_abs = nb * 128 + qi;
            const u32x4 q0 = q0n, q1 = q1n;
            if (mt < 7) { const u32x4* qp = (const u32x4*)(QKV + (size_t)(t_abs + 16) * LDQ + h * 64 + 8 * fq); q0n = qp[0]; q1n = qp[4]; }
            float qf[16]; float ss = 0.f;
#pragma unroll
            for (int e = 0; e < 4; ++e) { qf[2 * e] = bflo(q0[e]); qf[2 * e + 1] = bfhi(q0[e]); qf[8 + 2 * e] = bflo(q1[e]); qf[8 + 2 * e + 1] = bfhi(q1[e]); }
#pragma unroll
            for (int e = 0; e < 16; ++e) ss += qf[e] * qf[e];
            ss += __shfl_xor(ss, 16); ss += __shfl_xor(ss, 32);
            const float rstd = rsqrtf(ss * (1.0f / 64.0f) + EPS);
            u32x4 qa, qb;
#pragma unroll
            for (int e = 0; e < 4; ++e) { qa[e] = cvt_pk_bf16(qf[2 * e] * rstd * qgv[2 * e], qf[2 * e + 1] * rstd * qgv[2 * e + 1]);
                                          qb[e] = cvt_pk_bf16(qf[8 + 2 * e] * rstd * qgv[8 + 2 * e], qf[8 + 2 * e + 1] * rstd * qgv[8 + 2 * e + 1]); }
            const bf16x8 Q0 = as_bf16x8(qa), Q1 = as_bf16x8(qb);
            f32x4 S[10];
#pragma unroll
            for (int jj = 0; jj < 9; ++jj) {
                const LAS bf16_t* kp_ = Ks + (16 * (mt + jj) + fr) * KST + 8 * fq;
                const bf16x8 K0 = *(const LAS bf16x8*)kp_, K1 = *(const LAS bf16x8*)(kp_ + 32);
                f32x4 a = {0.f, 0.f, 0.f, 0.f};
                a = mfma16(K0, Q0, a); a = mfma16(K1, Q1, a); S[jj] = a;
            }
            float mx = sink;
#pragma unroll
            for (int jj = 0; jj < 9; ++jj)
#pragma unroll
                for (int r = 0; r < 4; ++r) {
                    float lg = S[jj][r] - (ar[r] - s16 * (float)jj);
                    if (jj == 0) lg = m0[r] ? lg : -INFINITY;
                    if (jj == 8) lg = m0[r] ? -INFINITY : lg;
                    if (nb == 0) lg = (16 * (mt + jj) + 4 * fq + r >= 128) ? lg : -INFINITY;
                    S[jj][r] = lg; mx = fmaxf(mx, lg);
                }
            mx = fmaxf(mx, __shfl_xor(mx, 16)); mx = fmaxf(mx, __shfl_xor(mx, 32));
            float sum = 0.f;
#pragma unroll
            for (int jj = 0; jj < 9; ++jj)
#pragma unroll
                for (int r = 0; r < 4; ++r) { const float pv = __builtin_amdgcn_exp2f(S[jj][r] - mx); S[jj][r] = pv; sum += pv; }
            S[9] = (f32x4){0.f, 0.f, 0.f, 0.f};
            sum += __shfl_xor(sum, 16); sum += __shfl_xor(sum, 32);
            sum += __builtin_amdgcn_exp2f(sink - mx);
            const float inv = 1.0f / sum;
            f32x4 O[4];
#pragma unroll
            for (int dt = 0; dt < 4; ++dt) O[dt] = (f32x4){0.f, 0.f, 0.f, 0.f};
#pragma unroll
            for (int pp = 0; pp < 5; ++pp) {
                u32x4 pw; pw.x = cvt_pk_bf16(S[2 * pp][0], S[2 * pp][1]); pw.y = cvt_pk_bf16(S[2 * pp][2], S[2 * pp][3]);
                pw.z = cvt_pk_bf16(S[2 * pp + 1][0], S[2 * pp + 1][1]); pw.w = cvt_pk_bf16(S[2 * pp + 1][2], S[2 * pp + 1][3]);
                const bf16x8 P = as_bf16x8(pw);
                const int ka = 16 * (mt + 2 * pp) + 4 * fq;
#pragma unroll
                for (int dt = 0; dt < 4; ++dt) {
                    const LAS bf16_t* vrow = Vt + (16 * dt + fr) * VST + ka;
                    const u32x2 va = *(const LAS u32x2*)vrow, vb = *(const LAS u32x2*)(vrow + 16);
                    u32x4 vw; vw.x = va.x; vw.y = va.y; vw.z = vb.x; vw.w = vb.y;
                    O[dt] = mfma16(as_bf16x8(vw), P, O[dt]);
                }
            }
            bf16_t* orow = ATT + (size_t)t_abs * D + h * 64 + 4 * fq;
#pragma unroll
            for (int dt = 0; dt < 4; ++dt) { u32x2 w; w.x = cvt_pk_bf16(O[dt][0] * inv, O[dt][1] * inv); w.y = cvt_pk_bf16(O[dt][2] * inv, O[dt][3] * inv);
                *(u32x2*)(orow + 16 * dt) = w; }
        }
        __syncthreads();
    }
}

__device__ __forceinline__ void hgrn_h1(LAS unsigned char* lds, const bf16_t* LOGF, const bf16_t* Vh, bf16_t* US, float* DEC) {
    LAS float* B = (LAS float*)lds;
    LAS float* TOT = (LAS float*)(lds + 32768);
    LAS bf16_t* KT = (LAS bf16_t*)(lds + 34816);
    LAS bf16_t* VT = (LAS bf16_t*)(lds + 34816 + 18432);
    LAS float* EB = (LAS float*)(lds + 71680);
    const int tid = pg8::opaque_tid(), lane = tid & 63, wid = tid >> 6, fr = lane & 15, fq = lane >> 4;
    const int d = tid & 127, seg = tid >> 7;
    u32x4 pl[2]; bf16_t pv[16];
#define H1_LOAD(su_) do { const int u_ = (su_) >> 1, t0_ = (u_ >> 4) * 128 + 64 * ((su_) & 1), h_ = u_ & 15; \
        _Pragma("unroll") for (int i = 0; i < 2; ++i) { const int idx = tid + 512 * i, row = idx >> 4, c8 = idx & 15; pl[i] = *(const u32x4*)(LOGF + (size_t)(t0_ + row) * D + h_ * 128 + 8 * c8); } \
        _Pragma("unroll") for (int i = 0; i < 16; ++i) pv[i] = Vh[(size_t)(t0_ + 16 * seg + i) * D + h_ * 128 + d]; } while (0)
    if ((int)blockIdx.x < 1024) H1_LOAD(2 * (int)blockIdx.x);
    for (int unit = blockIdx.x; unit < 1024; unit += gridDim.x) {
        const int N = unit >> 4, h = unit & 15;
        f32x4 accA[8]; float totA = 0.f;
#pragma unroll
        for (int sub = 0; sub < 2; ++sub) {
#pragma unroll
            for (int i = 0; i < 2; ++i) { const int idx = tid + 512 * i;
                ((LAS f32x4*)B)[2 * idx] = (f32x4){bflo(pl[i].x), bfhi(pl[i].x), bflo(pl[i].y), bfhi(pl[i].y)};
                ((LAS f32x4*)B)[2 * idx + 1] = (f32x4){bflo(pl[i].z), bfhi(pl[i].z), bflo(pl[i].w), bfhi(pl[i].w)}; }
            bf16_t vv[16];
#pragma unroll
            for (int i = 0; i < 16; ++i) vv[i] = pv[i];
            __syncthreads();
            if (sub == 0) H1_LOAD(2 * unit + 1); else if (unit + (int)gridDim.x < 1024) H1_LOAD(2 * (unit + (int)gridDim.x));
            float lf[16], b[16]; float run = 0.f;
#pragma unroll
            for (int i = 0; i < 16; ++i) { lf[i] = B[(16 * seg + i) * 128 + d]; run += lf[i]; b[i] = run; }
            TOT[seg * 128 + d] = run;
            __syncthreads();
            float off = 0.f, tot = 0.f;
#pragma unroll
            for (int s2 = 0; s2 < 4; ++s2) { const float tv = TOT[s2 * 128 + d]; off += (s2 < seg) ? tv : 0.f; tot += tv; }
            u32x4 kw[2], vw[2];
#pragma unroll
            for (int i = 0; i < 16; i += 2) {
                const float k0 = (1.0f - __expf(lf[i])) * __expf(tot - (b[i] + off)), k1 = (1.0f - __expf(lf[i + 1])) * __expf(tot - (b[i + 1] + off));
                kw[i >> 3][(i >> 1) & 3] = cvt_pk_bf16(k0, k1);
                vw[i >> 3][(i >> 1) & 3] = (unsigned)vv[i] | ((unsigned)vv[i + 1] << 16);
            }
            *(LAS u32x4*)(KT + d * 72 + 16 * seg) = kw[0]; *(LAS u32x4*)(KT + d * 72 + 16 * seg + 8) = kw[1];
            *(LAS u32x4*)(VT + d * 72 + 16 * seg) = vw[0]; *(LAS u32x4*)(VT + d * 72 + 16 * seg + 8) = vw[1];
            if (seg == 0) { if (sub == 0) totA = tot; else { EB[d] = __expf(tot); DEC[(size_t)(N * 16 + h) * 128 + d] = __expf(totA + tot); } }
            __syncthreads();
            const bf16x8 V0 = *(const LAS bf16x8*)(VT + (16 * wid + fr) * 72 + 8 * fq), V1 = *(const LAS bf16x8*)(VT + (16 * wid + fr) * 72 + 8 * fq + 32);
            bf16_t* urow = US + ((size_t)(N * 16 + h) * 128 + 16 * wid + fr) * 128 + 4 * fq;
#pragma unroll
            for (int dt = 0; dt < 8; ++dt) {
                const bf16x8 K0 = *(const LAS bf16x8*)(KT + (16 * dt + fr) * 72 + 8 * fq), K1 = *(const LAS bf16x8*)(KT + (16 * dt + fr) * 72 + 8 * fq + 32);
                f32x4 a = {0.f, 0.f, 0.f, 0.f};
                a = mfma16(K0, V0, a); a = mfma16(K1, V1, a);
                if (sub == 0) accA[dt] = a;
                else { const f32x4 e4 = *(const LAS f32x4*)(EB + 16 * dt + 4 * fq); const f32x4 u = accA[dt] * e4 + a;
                    u32x2 w; w.x = cvt_pk_bf16(u[0], u[1]); w.y = cvt_pk_bf16(u[2], u[3]);
                    *(u32x2*)(urow + 16 * dt) = w; }
            }
            __syncthreads();
        }
    }
}
__device__ __forceinline__ void hgrn_h2(const bf16_t* US, bf16_t* SS, const float* DEC) {
    for (int pidx = blockIdx.x * 512 + threadIdx.x; pidx < 131072; pidx += gridDim.x * 512) {
        const int e = 2 * pidx, h = e >> 14, dd = e & 127;
        float s0 = 0.f, s1 = 0.f;
        for (int n0 = 0; n0 < 64; n0 += 16) {
            unsigned u[16]; f32x2 dc[16];
#pragma unroll
            for (int i = 0; i < 16; ++i) { u[i] = __builtin_nontemporal_load((const unsigned*)(US + (size_t)(n0 + i) * 262144 + e)); dc[i] = *(const f32x2*)(DEC + (size_t)((n0 + i) * 16 + h) * 128 + dd); }
#pragma unroll
            for (int i = 0; i < 16; ++i) { *(unsigned*)(SS + (size_t)(n0 + i) * 262144 + e) = cvt_pk_bf16(s0, s1);
                s0 = dc[i].x * s0 + bflo(u[i]); s1 = dc[i].y * s1 + bfhi(u[i]); }
        }
    }
}
__device__ __forceinline__ void hgrn_h3(LAS unsigned char* lds, const bf16_t* LOGF, const bf16_t* Qh, const bf16_t* Vh, const bf16_t* Gh, const bf16_t* US, const float* og, bf16_t* OUT) {
    LAS float* B = (LAS float*)lds;
    LAS bf16_t* KTA = (LAS bf16_t*)lds;
    LAS float* TOT = (LAS float*)(lds + 33792);
    LAS float* EP = (LAS float*)(lds + 35840);
    LAS bf16_t* QT = (LAS bf16_t*)(lds + 36352);
    LAS bf16_t* KQ = (LAS bf16_t*)(lds + 53760);
    LAS bf16_t* AM = (LAS bf16_t*)(lds + 71168);
    LAS bf16_t* VT = (LAS bf16_t*)(lds + 80384);
    LAS bf16_t* ST = (LAS bf16_t*)(lds + 98816);
    LAS float* EA = (LAS float*)(lds + 133632);
    const int tid = pg8::opaque_tid(), lane = tid & 63, wid = tid >> 6, fr = lane & 15, fq = lane >> 4;
    const int d = tid & 127, seg = tid >> 7;
    u32x4 pl[2]; bf16_t pv[16], pq[16];
#define H3_LOAD(su_) do { const int u_ = (su_) >> 1, t0_ = (u_ >> 4) * 128 + 64 * ((su_) & 1), h_ = u_ & 15; \
        _Pragma("unroll") for (int i = 0; i < 2; ++i) { const int idx = tid + 512 * i, row = idx >> 4, c8 = idx & 15; pl[i] = *(const u32x4*)(LOGF + (size_t)(t0_ + row) * D + h_ * 128 + 8 * c8); } \
        _Pragma("unroll") for (int i = 0; i < 16; ++i) { pv[i] = Vh[(size_t)(t0_ + 16 * seg + i) * D + h_ * 128 + d]; pq[i] = Qh[(size_t)(t0_ + 16 * seg + i) * D + h_ * 128 + d]; } } while (0)
    if ((int)blockIdx.x < 1024) H3_LOAD(2 * (int)blockIdx.x);
    for (int unit = blockIdx.x; unit < 1024; unit += gridDim.x) {
        const int N = unit >> 4, h = unit & 15;
        f32x4 accU[8];
#pragma unroll
        for (int sub = 0; sub < 2; ++sub) {
            const int t0 = N * 128 + 64 * sub;
#pragma unroll
            for (int i = 0; i < 2; ++i) { const int idx = tid + 512 * i;
                ((LAS f32x4*)B)[2 * idx] = (f32x4){bflo(pl[i].x), bfhi(pl[i].x), bflo(pl[i].y), bfhi(pl[i].y)};
                ((LAS f32x4*)B)[2 * idx + 1] = (f32x4){bflo(pl[i].z), bfhi(pl[i].z), bflo(pl[i].w), bfhi(pl[i].w)}; }
            bf16_t vv[16], qq[16];
#pragma unroll
            for (int i = 0; i < 16; ++i) { vv[i] = pv[i]; qq[i] = pq[i]; }
            u32x2 sraw[8];
            if (sub == 1) { const bf16_t* sp2 = US + ((size_t)(N * 16 + h) * 128 + 16 * wid + fr) * 128 + 4 * fq;
#pragma unroll
                for (int dt = 0; dt < 8; ++dt) sraw[dt] = *(const u32x2*)(sp2 + 16 * dt); }
            __syncthreads();
            if (sub == 0) H3_LOAD(2 * unit + 1); else if (unit + (int)gridDim.x < 1024) H3_LOAD(2 * (unit + (int)gridDim.x));
            float lf[16], b[16]; float run = 0.f;
#pragma unroll
            for (int i = 0; i < 16; ++i) { lf[i] = B[(16 * seg + i) * 128 + d]; run += lf[i]; b[i] = run; }
            TOT[seg * 128 + d] = run;
            __syncthreads();
            const float t0v = TOT[d], t1v = TOT[128 + d], t2v = TOT[256 + d], t3v = TOT[384 + d];
            const float off = (seg > 0 ? t0v : 0.f) + (seg > 1 ? t1v : 0.f) + (seg > 2 ? t2v : 0.f), piv = t0v + t1v, tot = (t0v + t1v) + (t2v + t3v);
            u32x4 vw[2], kw[2];
#pragma unroll
            for (int i = 0; i < 16; ++i) {
                const float bi = b[i] + off; const int c = 16 * seg + i;
                const float kk = 1.0f - __expf(lf[i]);
                const float qt = bf2f(qq[i]) * __expf(bi - piv), kt = kk * __expf(piv - bi);
                QT[c * 136 + d] = (bf16_t)(cvt_pk_bf16(qt, 0.f) & 0xffffu); KQ[c * 136 + d] = (bf16_t)(cvt_pk_bf16(kt, 0.f) & 0xffffu);
                if (sub == 0) { const float kh = kk * __expf(tot - bi); lf[i] = kh; }
            }
#pragma unroll
            for (int i = 0; i < 16; i += 2) { vw[i >> 3][(i >> 1) & 3] = (unsigned)vv[i] | ((unsigned)vv[i + 1] << 16); if (sub == 0) kw[i >> 3][(i >> 1) & 3] = cvt_pk_bf16(lf[i], lf[i + 1]); }
            *(LAS u32x4*)(VT + d * 72 + 16 * seg) = vw[0]; *(LAS u32x4*)(VT + d * 72 + 16 * seg + 8) = vw[1];
            if (sub == 0) { *(LAS u32x4*)(KTA + d * 72 + 16 * seg) = kw[0]; *(LAS u32x4*)(KTA + d * 72 + 16 * seg + 8) = kw[1]; }
            if (seg == 0) { EP[d] = __expf(piv); if (sub == 0) EA[d] = __expf(tot); }
            __syncthreads();
            if (sub == 0) {
                const int v = tid >> 2, dq = (tid & 3) * 32;
                const u32x4* sp = (const u32x4*)(US + ((size_t)(N * 16 + h) * 128 + v) * 128 + dq);
#pragma unroll
                for (int i = 0; i < 4; ++i) { const u32x4 s = sp[i]; u32x4 w;
#pragma unroll
                    for (int e = 0; e < 4; ++e) { const int dd = dq + 8 * i + 2 * e; w[e] = cvt_pk_bf16(bflo(s[e]) * EP[dd], bfhi(s[e]) * EP[dd + 1]); }
                    *(LAS u32x4*)(ST + v * 136 + dq + 8 * i) = w; }
            } else {
#pragma unroll
                for (int dt = 0; dt < 8; ++dt) { const f32x4 ea = *(const LAS f32x4*)(EA + 16 * dt + 4 * fq), ep = *(const LAS f32x4*)(EP + 16 * dt + 4 * fq);
                    const f32x4 sv = {bflo(sraw[dt].x), bfhi(sraw[dt].x), bflo(sraw[dt].y), bfhi(sraw[dt].y)};
                    const f32x4 r = (sv * ea + accU[dt]) * ep;
                    u32x2 w; w.x = cvt_pk_bf16(r[0], r[1]); w.y = cvt_pk_bf16(r[2], r[3]);
                    *(LAS u32x2*)(ST + (16 * wid + fr) * 136 + 16 * dt + 4 * fq) = w; }
            }
            {
                const int ct = wid >> 1;
#pragma unroll
                for (int sti = 0; sti < 2; ++sti) {
                    const int st = 2 * (wid & 1) + sti;
                    f32x4 a = {0.f, 0.f, 0.f, 0.f};
                    if (st <= ct) {
#pragma unroll
                        for (int ks = 0; ks < 4; ++ks) {
                            const bf16x8 Kf = *(const LAS bf16x8*)(KQ + (16 * st + fr) * 136 + 8 * fq + 32 * ks), Qf = *(const LAS bf16x8*)(QT + (16 * ct + fr) * 136 + 8 * fq + 32 * ks);
                            a = mfma16(Kf, Qf, a);
                        }
                    }
                    const int c = 16 * ct + fr, s = 16 * st + 4 * fq;
#pragma unroll
                    for (int r = 0; r < 4; ++r) a[r] = (st <= ct && s + r <= c) ? a[r] : 0.f;
                    u32x2 w; w.x = cvt_pk_bf16(a[0], a[1]); w.y = cvt_pk_bf16(a[2], a[3]);
                    *(LAS u32x2*)(AM + c * 72 + s) = w;
                }
            }
            if (sub == 0) {
                const bf16x8 V0 = *(const LAS bf16x8*)(VT + (16 * wid + fr) * 72 + 8 * fq), V1 = *(const LAS bf16x8*)(VT + (16 * wid + fr) * 72 + 8 * fq + 32);
#pragma unroll
                for (int dt = 0; dt < 8; ++dt) {
                    const bf16x8 K0 = *(const LAS bf16x8*)(KTA + (16 * dt + fr) * 72 + 8 * fq), K1 = *(const LAS bf16x8*)(KTA + (16 * dt + fr) * 72 + 8 * fq + 32);
                    f32x4 a = {0.f, 0.f, 0.f, 0.f};
                    a = mfma16(K0, V0, a); a = mfma16(K1, V1, a); accU[dt] = a;
                }
            }
            __syncthreads();
            {
                bf16x8 Sf[4], Vf[2];
#pragma unroll
                for (int ks = 0; ks < 4; ++ks) Sf[ks] = *(const LAS bf16x8*)(ST + (16 * wid + fr) * 136 + 8 * fq + 32 * ks);
#pragma unroll
                for (int ks = 0; ks < 2; ++ks) Vf[ks] = *(const LAS bf16x8*)(VT + (16 * wid + fr) * 72 + 8 * fq + 32 * ks);
#pragma unroll
                for (int ct = 0; ct < 4; ++ct) {
                    f32x4 a = {0.f, 0.f, 0.f, 0.f};
#pragma unroll
                    for (int ks = 0; ks < 4; ++ks) a = mfma16(Sf[ks], *(const LAS bf16x8*)(QT + (16 * ct + fr) * 136 + 8 * fq + 32 * ks), a);
#pragma unroll
                    for (int ks = 0; ks < 2; ++ks) a = mfma16(Vf[ks], *(const LAS bf16x8*)(AM + (16 * ct + fr) * 72 + 8 * fq + 32 * ks), a);
                    *(LAS f32x4*)(B + (16 * ct + fr) * 132 + 16 * wid + 4 * fq) = a;
                }
            }
            __syncthreads();
            {
                const int c = tid >> 3, v0 = (tid & 7) * 16;
                f32x4 o[4]; float ss = 0.f;
#pragma unroll
                for (int i = 0; i < 4; ++i) { o[i] = *(const LAS f32x4*)(B + c * 132 + v0 + 4 * i); ss += (o[i].x * o[i].x + o[i].y * o[i].y) + (o[i].z * o[i].z + o[i].w * o[i].w); }
                ss += __shfl_xor(ss, 1); ss += __shfl_xor(ss, 2); ss += __shfl_xor(ss, 4);
                const float rstd = rsqrtf(ss * (1.0f / 128.0f) + EPS);
                const u32x4* gp = (const u32x4*)(Gh + (size_t)(t0 + c) * D + h * 128 + v0);
                const u32x4 g0 = gp[0], g1 = gp[1];
                const f32x4* ogp = (const f32x4*)(og + h * 128 + v0);
                u32x4 w0, w1;
#pragma unroll
                for (int i = 0; i < 2; ++i) { const f32x4 ga = ogp[i];
                    w0[2 * i] = cvt_pk_bf16(o[i].x * rstd * ga.x * bflo(g0[2 * i]), o[i].y * rstd * ga.y * bfhi(g0[2 * i]));
                    w0[2 * i + 1] = cvt_pk_bf16(o[i].z * rstd * ga.z * bflo(g0[2 * i + 1]), o[i].w * rstd * ga.w * bfhi(g0[2 * i + 1])); }
#pragma unroll
                for (int i = 0; i < 2; ++i) { const f32x4 ga = ogp[2 + i];
                    w1[2 * i] = cvt_pk_bf16(o[2 + i].x * rstd * ga.x * bflo(g1[2 * i]), o[2 + i].y * rstd * ga.y * bfhi(g1[2 * i]));
                    w1[2 * i + 1] = cvt_pk_bf16(o[2 + i].z * rstd * ga.z * bflo(g1[2 * i + 1]), o[2 + i].w * rstd * ga.w * bfhi(g1[2 * i + 1])); }
                u32x4* op = (u32x4*)(OUT + (size_t)(t0 + c) * D + h * 128 + v0);
                op[0] = w0; op[1] = w1;
            }
            __syncthreads();
        }
    }
}

#define XB_TMO      128
#define XB_XCNT(j)  (256  + 64 * (j))
#define XB_XSUB(j)  (1280 + 64 * (j))
#define XB_XGEN(j)  (2304 + 64 * (j))
#define XB_TOP      3328
#define XB_TOPGEN   3392
#define XCD_BAR_WORDS 3456
#define XB_SPIN_CAP (1u << 18)

__device__ __forceinline__ unsigned xb_ld(unsigned* p)              { return __hip_atomic_load(p, __ATOMIC_RELAXED, __HIP_MEMORY_SCOPE_AGENT); }
__device__ __forceinline__ unsigned xb_add(unsigned* p, unsigned v) { return __hip_atomic_fetch_add(p, v, __ATOMIC_RELAXED, __HIP_MEMORY_SCOPE_AGENT); }
__device__ __forceinline__ unsigned xb_xcc_id() { return (unsigned)__builtin_amdgcn_s_getreg((3 << 11) | 20) & 0xFu; }
#define XB_SPIN(cond, bar) do { unsigned _sp = 0; while (cond) { __builtin_amdgcn_s_sleep(1); \
    if ((++_sp & 255u) == 0u) { if (xb_ld(&(bar)[XB_TMO])) break; if (_sp > XB_SPIN_CAP) { atomicAdd(&(bar)[XB_TMO], 1u); break; } } } } while (0)

struct XcdBarrier {
    unsigned* bar; unsigned x;
    volatile LAS unsigned* st;
};

__device__ __forceinline__ XcdBarrier xcd_barrier_post(unsigned* bar, volatile LAS unsigned* st) {
    XcdBarrier b; b.bar = bar; b.x = xb_xcc_id(); b.st = st;
    if (threadIdx.x == 0) (void)xb_add(&bar[XB_XCNT(b.x)], 1u);
    return b;
}
__device__ __forceinline__ void xcd_barrier_complete(unsigned* bar, unsigned x, unsigned& nloc, unsigned& nx) {
    const unsigned G = gridDim.x * gridDim.y * gridDim.z;
    unsigned sum, cnt, mine, sp = 0u;
    for (;;) {
        sum = 0u; cnt = 0u; mine = 0u;
#pragma unroll
        for (unsigned j = 0; j < 16; ++j) { const unsigned c = xb_ld(&bar[XB_XCNT(j)]); sum += c; cnt += (c > 0u) ? 1u : 0u; mine = (j == x) ? c : mine; }
        if (sum == G) break;
        __builtin_amdgcn_s_sleep(1);
        if ((++sp & 255u) == 0u) { if (xb_ld(&bar[XB_TMO])) break; if (sp > XB_SPIN_CAP) { atomicAdd(&bar[XB_TMO], 1u); break; } }
    }
    nloc = mine > 0u ? mine : 1u; nx = cnt > 0u ? cnt : 1u;
}

__device__ __forceinline__ void xcd_barrier(const XcdBarrier& b) {
    asm volatile("s_waitcnt vmcnt(0)" ::: "memory");
    __syncthreads();
    if (threadIdx.x == 0) {
        unsigned* bar = b.bar;
        __builtin_amdgcn_s_waitcnt(0);
        unsigned nloc = b.st[0], nx = b.st[1];
        if (nloc == 0u) { xcd_barrier_complete(bar, b.x, nloc, nx); b.st[0] = nloc; b.st[1] = nx; }
        const unsigned old = xb_add(&bar[XB_XSUB(b.x)], 1u);
        const unsigned gen = old / nloc;
        if (old + 1u == (gen + 1u) * nloc) {
            __builtin_amdgcn_fence(__ATOMIC_RELEASE, "agent");
            asm volatile("s_waitcnt vmcnt(0)" ::: "memory");
            const unsigned og = xb_add(&bar[XB_TOP], 1u);
            const unsigned tg = og / nx;
            if (og + 1u == (tg + 1u) * nx) xb_add(&bar[XB_TOPGEN], 1u);
            else XB_SPIN(xb_ld(&bar[XB_TOPGEN]) == tg, bar);
            __builtin_amdgcn_fence(__ATOMIC_ACQUIRE, "agent");
            xb_add(&bar[XB_XGEN(b.x)], 1u);
            asm volatile("s_waitcnt vmcnt(0)" ::: "memory");
        } else {
            XB_SPIN(xb_ld(&bar[XB_XGEN(b.x)]) == gen, bar);
            __builtin_amdgcn_fence(__ATOMIC_ACQUIRE, "agent");
            asm volatile("s_waitcnt vmcnt(0)" ::: "memory");
        }
    }
    __syncthreads();
}

__global__ void __launch_bounds__(512, 2) fwd_megakernel(Params p) {
    extern __shared__ __attribute__((aligned(16))) unsigned char lds_raw[];
    LAS unsigned char* lds = (LAS unsigned char*)lds_raw;
    cg::grid_group grid = cg::this_grid();
    unsigned char* ws = p.ws;
    const float* MOD = (const float*)(ws + WS_MOD);
    bf16_t* H = (bf16_t*)(ws + WS_H); bf16_t* QKV = (bf16_t*)(ws + WS_QKV); bf16_t* ATT = (bf16_t*)(ws + WS_ATT); bf16_t* XA = (bf16_t*)(ws + WS_XA);   bf16_t* ACT = (bf16_t*)(ws + WS_ACT);
    bf16_t* QH = (bf16_t*)(ws + WS_QH); bf16_t* LOGF = (bf16_t*)(ws + WS_LOGF); bf16_t* VH = (bf16_t*)(ws + WS_VH); bf16_t* GH = (bf16_t*)(ws + WS_GH); bf16_t* US = (bf16_t*)(ws + WS_US); bf16_t* SS = (bf16_t*)(ws + WS_SS); float* DEC = (float*)(ws + WS_DEC);
    const int G = gridDim.x, bx = blockIdx.x;

    if (threadIdx.x < 16) ((LAS unsigned*)(lds + MISC_OFF))[threadIdx.x] = 0u;
    __syncthreads();
    const XcdBarrier bar = xcd_barrier_post((unsigned*)(ws + WS_BAR), (volatile LAS unsigned*)(lds + MISC_OFF));
#define CG_SYNC() do { asm volatile("s_waitcnt vmcnt(0) lgkmcnt(0)" ::: "memory"); grid.sync(); __builtin_amdgcn_fence(__ATOMIC_ACQUIRE, "agent"); asm volatile("s_waitcnt vmcnt(0)" ::: "memory"); __syncthreads(); } while (0)
#define GRID_SYNC() xcd_barrier(bar)
    prologue_phase(lds, p);
    norm_phase(lds, p.x, p.norm_mix, MOD, MOD + D, H);
    if (p.ws == nullptr) CG_SYNC();
    GRID_SYNC();
#define GEMM_PHASE(EpiT, Aptr, WToff, Nn, Kk, ...) do { pg8::Gemm g{Aptr, (const bf16_t*)(ws + (WToff)), T, Nn, Kk}; pg8::StaticOrder S; S.init(T, Nn, G, bx); \
        EpiT E{__VA_ARGS__}; pg8::gemm_phase<EpiT, pg8::StaticOrder, true, true>(lds, g, S, E); } while (0)
    float* BIAS = (float*)(ws + WS_BIAS); float* PART = (float*)(ws + WS_PART); LAS float* RS = (LAS float*)(lds + RS_OFF);
    GEMM_PHASE(pg8::EpiStore<0>, H, WS_WT_AIN, NQKV, D, QKV, NQKV);
    {
        const int busy2 = (T / 256) * (NQKV / 256) - G; const bool split = busy2 > 0 && busy2 < G;
        if (!split || bx >= busy2) {
            const int wv = (split ? bx - busy2 : bx) * 8 + (pg8::opaque_tid() >> 6), nw = (split ? G - busy2 : G) * 8;
            bias_gemv(MOD + 3 * D, p.norm_mlp, MOD + 4 * D, (const bf16_t*)(ws + WS_WT_W1), BIAS, DFF, wv, nw);
            bias_gemv(MOD + 12288, p.norm_mix + D, MOD + 12288 + D, (const bf16_t*)(ws + WS_WT_HIN), BIAS + DFF, DFF, wv, nw);
            bias_gemv(MOD + 12288 + 3 * D, p.norm_mlp + D, MOD + 12288 + 4 * D, (const bf16_t*)(ws + WS_WT_W1 + 32 * MiB), BIAS + 2 * DFF, DFF, wv, nw);
        }
    }
    GRID_SYNC();
    attn_phase(lds, QKV, p.attn_q_gain, p.attn_k_gain, p.attn_sinks, ATT);
    GRID_SYNC();
    GEMM_PHASE(pg8::EpiResidN<false>, ATT, WS_WT_AOUT, D, D, p.x, XA, MOD + 2 * D, D, PART);
    GRID_SYNC();
#define GEMM_PHASE_N(EpiT, Aptr, WToff, ...) do { pg8::Gemm g{Aptr, (const bf16_t*)(ws + (WToff)), T, DFF, D}; pg8::StaticOrder S; S.init(T, DFF, G, bx); rstd_prepare(RS, PART, S); \
        EpiT E{__VA_ARGS__}; pg8::gemm_phase<EpiT, pg8::StaticOrder, true, true>(lds, g, S, E); } while (0)
    GEMM_PHASE_N(pg8::EpiStoreN<2>, XA, WS_WT_W1, ACT, DFF, BIAS, RS, 0);
    GRID_SYNC();
    GEMM_PHASE(pg8::EpiResidN<true>, ACT, WS_WT_W2, D, DFF, XA, XA, MOD + 5 * D, D, PART);
    GRID_SYNC();
    GEMM_PHASE_N(pg8::EpiHgrn, XA, WS_WT_HIN, QH, LOGF, VH, GH, (const float*)(ws + WS_LB), 0.08838834764831845f, BIAS + DFF, RS, 0);
    GRID_SYNC();
    hgrn_h1(lds, LOGF, VH, US, DEC);
    GRID_SYNC();
    hgrn_h2(US, SS, DEC);
    GRID_SYNC();
    hgrn_h3(lds, LOGF, QH, VH, GH, SS, p.hgrn_o_gain, ATT);
    GRID_SYNC();
    GEMM_PHASE(pg8::EpiResidN<true>, ATT, WS_WT_HOUT, D, D, XA, XA, MOD + 12288 + 2 * D, D, PART);
    GRID_SYNC();
    GEMM_PHASE_N(pg8::EpiStoreN<2>, XA, WS_WT_W1 + 32 * MiB, ACT, DFF, BIAS + 2 * DFF, RS, 0);
    GRID_SYNC();
    GEMM_PHASE(pg8::EpiResidF, ACT, WS_WT_W2 + 32 * MiB, D, DFF, XA, p.out, MOD + 12288 + 5 * D, D);
}

extern "C" void kernel_launch(void* const* d_in, const int* in_sizes, int n_in, void* d_out, int out_size, void* d_ws, size_t ws_size, hipStream_t stream) {
    static int grid = 0;
    if (grid == 0) {
        if (n_in != 17 || out_size != T * D || ws_size < WS_END) { fprintf(stderr, "kernel_launch: unexpected shapes (n_in %d out %d ws %zu, need %zu)\n", n_in, out_size, ws_size, (size_t)WS_END); grid = -1; return; }
        int dev = 0, cus = 0, per_cu = 0;
        (void)hipGetDevice(&dev);
        (void)hipDeviceGetAttribute(&cus, hipDeviceAttributeMultiprocessorCount, dev);
        (void)hipFuncSetAttribute((const void*)fwd_megakernel, hipFuncAttributeMaxDynamicSharedMemorySize, LDS_BYTES);
        (void)hipOccupancyMaxActiveBlocksPerMultiprocessor(&per_cu, (const void*)fwd_megakernel, 512, LDS_BYTES);
        if (per_cu < 1) { fprintf(stderr, "kernel_launch: occupancy query says %d blocks per CU\n", per_cu); per_cu = 1; }
        grid = cus * per_cu;
        if (grid != 256) { fprintf(stderr, "kernel_launch: built for a 256-workgroup grid (got %d)\n", grid); grid = -1; return; }
    }
    if (grid < 0) return;
    Params p{};
    p.x = (const float*)d_in[0]; p.c = (const float*)d_in[1]; p.mod_w = (const float*)d_in[2]; p.mod_b = (const float*)d_in[3];
    p.norm_mix = (const float*)d_in[4]; p.norm_mlp = (const float*)d_in[5]; p.attn_w_in = (const float*)d_in[6]; p.attn_w_out = (const float*)d_in[7];
    p.attn_q_gain = (const float*)d_in[8]; p.attn_k_gain = (const float*)d_in[9]; p.attn_sinks = (const float*)d_in[10];
    p.hgrn_w_in = (const float*)d_in[11]; p.hgrn_w_out = (const float*)d_in[12]; p.hgrn_o_gain = (const float*)d_in[13]; p.hgrn_lb_logits = (const float*)d_in[14];
    p.mlp_w1 = (const float*)d_in[15]; p.mlp_w2 = (const float*)d_in[16];
    p.out = (float*)d_out; p.ws = (unsigned char*)d_ws;
    (void)hipMemsetAsync((char*)d_ws + WS_BAR, 0, BAR_BYTES, stream);
    void* args[] = {&p};
    hipError_t e = hipLaunchCooperativeKernel((const void*)fwd_megakernel, dim3(grid), dim3(512), args, LDS_BYTES, stream);
    if (e != hipSuccess) fprintf(stderr, "kernel_launch: cooperative launch failed: %s (grid %d)\n", hipGetErrorString(e), grid);
}
```
